# Optimizing an MI355X kernel written in HIP

```python
import math
import jax, jax.numpy as jnp
from jax import lax
import numpy as np

D_MODEL = 1024
BATCH = 2
SEQ = 16384
DEPTH = 1
DEC_BATCH = 8
DEC_SEQ = 4096
PAST_LEN = 128

MIX_WIDTH = D_MODEL
ATT_HEADS = 8
ATT_HEAD_DIM = 64
ATT_WIDTH = ATT_HEADS * ATT_HEAD_DIM
DILATED_BRANCHES = ((128, 1), (512, 4), (2048, 16))
ATT_BLOCK = 64
ROT_DIM = ATT_HEAD_DIM // 4
ROPE_THETA = 500000.0
HG_HEADS = 4
HG_DK = 128
HG_DV = 128
HG_WIDTH = HG_HEADS * HG_DV
HG_CHUNK = 64
IN_WIDTH = 3 * ATT_WIDTH + 5 * HG_WIDTH
D_FF = ((8 * D_MODEL // 3 + 255) // 256) * 256
NORM_EPS = 1e-6
NEG_FILL = -1e30

kernel_name = "hybrid_dilated_attn_hgrn2_encoder"


def rmsnorm(x, g):
    x32 = x.astype(jnp.float32)
    y = x32 * lax.rsqrt(jnp.mean(x32 * x32, axis=-1, keepdims=True) + NORM_EPS)
    return (y * g.astype(jnp.float32)).astype(x.dtype)


def partial_rope(t, pos):
    t32 = t.astype(jnp.float32)
    inv_freq = ROPE_THETA ** (-jnp.arange(0, ROT_DIM, 2, dtype=jnp.float32) / ROT_DIM)
    ang = pos[:, None] * inv_freq[None, :]
    cos = jnp.cos(ang)[None, :, None, :]
    sin = jnp.sin(ang)[None, :, None, :]
    half = ROT_DIM // 2
    x1 = t32[..., :half]
    x2 = t32[..., half:ROT_DIM]
    rot = jnp.concatenate([x1 * cos - x2 * sin, x2 * cos + x1 * sin, t32[..., ROT_DIM:]], axis=-1)
    return rot


def dilated_branch(q, k, v, window, dil):
    B, S, H, D = q.shape
    L = S // dil
    half = window // (2 * dil)
    assert half <= ATT_BLOCK
    nb = -(-L // ATT_BLOCK)
    Lp = nb * ATT_BLOCK

    def to_sub(t):
        return t.reshape(B, L, dil, H, D).transpose(0, 2, 1, 3, 4)

    qs = jnp.pad(to_sub(q), ((0, 0), (0, 0), (0, Lp - L), (0, 0), (0, 0)))
    qs = qs.reshape(B, dil, nb, ATT_BLOCK, H, D)

    def band(t):
        tp = jnp.pad(to_sub(t), ((0, 0), (0, 0), (ATT_BLOCK, Lp - L + ATT_BLOCK), (0, 0), (0, 0)))
        tp = tp.reshape(B, dil, nb + 2, ATT_BLOCK, H, D)
        return jnp.concatenate([tp[:, :, :-2], tp[:, :, 1:-1], tp[:, :, 2:]], axis=3)

    kb = band(k)
    vb = band(v)
    qi = jnp.arange(ATT_BLOCK)[:, None]
    kj = jnp.arange(3 * ATT_BLOCK)[None, :]
    in_band = jnp.abs(kj - ATT_BLOCK - qi) <= half
    j_abs = jnp.arange(nb)[:, None, None] * ATT_BLOCK - ATT_BLOCK + kj[None]
    mask = in_band[None] & (j_abs >= 0) & (j_abs < L)

    s = jnp.einsum('bgnqhd,bgnkhd->bgnhqk', qs, kb) * (D ** -0.5)
    s = jnp.where(mask[None, None, :, None], s, NEG_FILL)
    m = jnp.max(s, axis=-1, keepdims=True)
    p = jnp.exp(s - m)
    l = jnp.sum(p, axis=-1)
    o = jnp.einsum('bgnhqk,bgnkhd->bgnqhd', p, vb) / l.transpose(0, 1, 2, 4, 3)[..., None]
    lse = (m[..., 0] + jnp.log(l)).transpose(0, 1, 2, 4, 3)
    o = o.reshape(B, dil, Lp, H, D)[:, :, :L].transpose(0, 2, 1, 3, 4).reshape(B, S, H, D)
    lse = lse.reshape(B, dil, Lp, H)[:, :, :L].transpose(0, 2, 1, 3).reshape(B, S, H)
    return o, lse


def dilated_attention(q, k, v):
    outs = []
    lses = []
    for window, dil in DILATED_BRANCHES:
        o, lse = dilated_branch(q, k, v, window, dil)
        outs.append(o)
        lses.append(lse)
    w = jax.nn.softmax(jnp.stack(lses, axis=0), axis=0)
    out = w[0][..., None] * outs[0]
    for b in range(1, len(outs)):
        out = out + w[b][..., None] * outs[b]
    return out


def hgrn2_chunk_scan(q, k, v, logf):
    B, S, H, DK = q.shape
    DV = v.shape[-1]
    N = S // HG_CHUNK

    def chunks(t):
        return t.reshape(B, N, HG_CHUNK, H, t.shape[-1]).transpose(1, 0, 3, 2, 4)

    tril = jnp.tril(jnp.ones((HG_CHUNK, HG_CHUNK), dtype=bool))[:, :, None]

    def step(state, xs):
        qc, kc, vc, gc = xs
        b = jnp.cumsum(gc, axis=2)
        o_inter = jnp.einsum('bhck,bhkv->bhcv', qc * jnp.exp(b), state)
        diff = b[:, :, :, None, :] - b[:, :, None, :, :]
        decay = jnp.where(tril, jnp.exp(jnp.minimum(diff, 0.0)), 0.0)
        a = jnp.einsum('bhtk,bhsk,bhtsk->bhts', qc, kc, decay)
        o = o_inter + jnp.einsum('bhts,bhsv->bhtv', a, vc)
        b_last = b[:, :, -1:, :]
        new_state = jnp.exp(b_last[:, :, 0, :])[..., None] * state + jnp.einsum(
            'bhck,bhcv->bhkv', kc * jnp.exp(b_last - b), vc)
        return new_state, o

    init = jnp.zeros((B, H, DK, DV), jnp.float32)
    _, o = lax.scan(step, init, (chunks(q), chunks(k), chunks(v), chunks(logf)))
    return o.transpose(1, 0, 3, 2, 4).reshape(B, S, H, DV)


def hgrn2_bidirectional(q_raw, i_raw, zf_fwd, zf_bwd, lb_f, lb_b, g_norm, gate):
    B, S, _ = q_raw.shape
    q = jax.nn.silu(q_raw.astype(jnp.float32)).reshape(B, S, HG_HEADS, HG_DK)
    v = i_raw.astype(jnp.float32).reshape(B, S, HG_HEADS, HG_DV)

    def gates(z, lb):
        f = lb + (1.0 - lb) * jax.nn.sigmoid(z.astype(jnp.float32))
        return (1.0 - f).reshape(B, S, HG_HEADS, HG_DK), jnp.log(f).reshape(B, S, HG_HEADS, HG_DK)

    k_f, g_f = gates(zf_fwd, lb_f)
    o_f = hgrn2_chunk_scan(q, k_f, v, g_f)
    k_b, g_b = gates(zf_bwd, lb_b)
    flip = lambda t: jnp.flip(t, axis=1)
    o_b = flip(hgrn2_chunk_scan(flip(q), flip(k_b), flip(v), flip(g_b)))
    o = o_f + o_b
    o = o * lax.rsqrt(jnp.mean(o * o, axis=-1, keepdims=True) + NORM_EPS) * g_norm.astype(jnp.float32)
    o = o * jax.nn.silu(gate.astype(jnp.float32)).reshape(B, S, HG_HEADS, HG_DV)
    return o.reshape(B, S, HG_WIDTH)


def trunk(x, w_in, w_out, lb_fwd, lb_bwd, g_hgrn_norm, g_pre_mix, g_post_mix,
          g_pre_ffn, g_post_ffn, w_gate, w_up, w_down):
    B, S, _ = x.shape
    pos = jnp.arange(S, dtype=jnp.float32)
    lb_all_f = jnp.cumsum(jax.nn.softmax(lb_fwd.astype(jnp.float32), axis=0), axis=0)
    lb_all_b = jnp.cumsum(jax.nn.softmax(lb_bwd.astype(jnp.float32), axis=0), axis=0)
    for layer in range(DEPTH):
        h = rmsnorm(x, g_pre_mix[layer])
        u = h @ w_in[layer]
        offs = np.cumsum([0, ATT_WIDTH, ATT_WIDTH, ATT_WIDTH, HG_WIDTH, HG_WIDTH, HG_WIDTH, HG_WIDTH, HG_WIDTH])
        q_a, k_a, v_a, q_h, zf_f, zf_b, i_h, g_h = [u[..., int(offs[j]):int(offs[j + 1])] for j in range(8)]
        qa = partial_rope(q_a.reshape(B, S, ATT_HEADS, ATT_HEAD_DIM), pos)
        ka = partial_rope(k_a.reshape(B, S, ATT_HEADS, ATT_HEAD_DIM), pos)
        va = v_a.reshape(B, S, ATT_HEADS, ATT_HEAD_DIM).astype(jnp.float32)
        att = dilated_attention(qa, ka, va).reshape(B, S, ATT_WIDTH)
        hg = hgrn2_bidirectional(q_h, i_h, zf_f, zf_b, lb_all_f[layer], lb_all_b[layer],
                                 g_hgrn_norm[layer], g_h)
        mix = jnp.concatenate([att, hg], axis=-1).astype(x.dtype) @ w_out[layer]
        x = x + rmsnorm(mix, g_post_mix[layer])
        h = rmsnorm(x, g_pre_ffn[layer])
        ff = (jax.nn.silu(h @ w_gate[layer]) * (h @ w_up[layer])) @ w_down[layer]
        x = x + rmsnorm(ff, g_post_ffn[layer])
    return x


def setup_inputs(seed: int = 0) -> dict:
    key = jax.random.key(seed)
    ks = jax.random.split(key, 16)
    f32 = jnp.float32

    def nrm(k, shape, scale):
        return jax.random.normal(k, shape, f32) * scale

    def gain(k, shape):
        return 1.0 + 0.05 * jax.random.normal(k, shape, f32)

    return {
        "x_prompt": nrm(ks[0], (BATCH, SEQ, D_MODEL), 1.0),
        "x_sample": nrm(ks[1], (DEC_BATCH, DEC_SEQ, D_MODEL), 1.0),
        "w_in": nrm(ks[2], (DEPTH, D_MODEL, IN_WIDTH), D_MODEL ** -0.5),
        "w_out": nrm(ks[3], (DEPTH, MIX_WIDTH, D_MODEL), MIX_WIDTH ** -0.5),
        "lb_fwd": nrm(ks[4], (DEPTH + 1, HG_WIDTH), 0.5),
        "lb_bwd": nrm(ks[5], (DEPTH + 1, HG_WIDTH), 0.5),
        "g_hgrn_norm": gain(ks[6], (DEPTH, HG_DV)),
        "g_pre_mix": gain(ks[7], (DEPTH, D_MODEL)),
        "g_post_mix": gain(ks[8], (DEPTH, D_MODEL)),
        "g_pre_ffn": gain(ks[9], (DEPTH, D_MODEL)),
        "g_post_ffn": gain(ks[10], (DEPTH, D_MODEL)),
        "w_gate": nrm(ks[11], (DEPTH, D_MODEL, D_FF), D_MODEL ** -0.5),
        "w_up": nrm(ks[12], (DEPTH, D_MODEL, D_FF), D_MODEL ** -0.5),
        "w_down": nrm(ks[13], (DEPTH, D_FF, D_MODEL), D_FF ** -0.5),
    }


def reference(x_prompt, x_sample, w_in, w_out, lb_fwd, lb_bwd, g_hgrn_norm, g_pre_mix,
              g_post_mix, g_pre_ffn, g_post_ffn, w_gate, w_up, w_down):
    y_prompt = trunk(x_prompt, w_in, w_out, lb_fwd, lb_bwd, g_hgrn_norm, g_pre_mix, g_post_mix,
                     g_pre_ffn, g_post_ffn, w_gate, w_up, w_down)
    y_sample = trunk(x_sample, w_in, w_out, lb_fwd, lb_bwd, g_hgrn_norm, g_pre_mix, g_post_mix,
                     g_pre_ffn, g_post_ffn, w_gate, w_up, w_down)
    return (y_prompt, y_sample)
```

```cpp
#include <hip/hip_runtime.h>
#include <hip/hip_cooperative_groups.h>
#include <cstdio>
#include <cstdint>
namespace cg = cooperative_groups;
namespace pg8 {
#define PG8_LAS __attribute__((address_space(3)))
typedef unsigned short bf16_t;
typedef short bf16x8 __attribute__((ext_vector_type(8)));
typedef float f32x4 __attribute__((ext_vector_type(4)));
typedef unsigned u32x4 __attribute__((ext_vector_type(4)));
constexpr int BM = 256, BK = 64, HALF = 128, HTB = HALF * BK * 2  , STAGE_BYTES = 8 * HTB, NXCD = 8, WGM = 8;

__host__ __device__ __forceinline__ int lds_byte(int r, int c) { const int st = (r >> 4) * 2 + (c >> 5), rr = r & 15, cc = c & 31, ob = rr * 64 + cc * 2; return st * 1024 + (ob ^ (((ob >> 9) & 1) << 5)); }
__host__ __device__ __forceinline__ void stage_rc(int b, int& R, int& C) { const int st = b / 1024, sb = b % 1024, swz = sb ^ (((sb >> 9) & 1) << 5); R = (st >> 1) * 16 + swz / 64; C = (st & 1) * 32 + (swz % 64) / 2; }
__host__ __device__ __forceinline__ int perm32(int rho) { const int n = rho >> 4, i = rho & 15; return 8 * (i >> 2) + 4 * n + (i & 3); }

struct Unit { int pm, pn; };
struct Gemm { const bf16_t* A; const bf16_t* Bt; int M, N, K; };

struct StaticOrder {
    int nM, nN, nwg, G, c;
    __host__ __device__ void init(int M, int N, int G_, int c_) { nM = M / BM; nN = N / BM; nwg = nM * nN; G = G_; c = c_; }
    __host__ __device__ bool next(int i, Unit& u) const {
        const long L = (long)i * G + c; if (L >= nwg) return false;
        int wgid = (int)L; { const int q = nwg / NXCD, r = nwg % NXCD, xcd = wgid % NXCD, off = wgid / NXCD; wgid = (xcd < r ? xcd * (q + 1) : r * (q + 1) + (xcd - r) * q) + off; }
        const int nig = WGM * nN, gid = wgid / nig, fm = gid * WGM, gsz = (nM - fm) < WGM ? (nM - fm) : WGM;
        u.pm = fm + ((wgid % nig) % gsz); u.pn = (wgid % nig) / gsz; return true;
    }
    __device__ __forceinline__ void a_ready(const Unit&) const {}
    __device__ __forceinline__ void done(const Unit&) const {}
};

typedef __bf16 bf16x2_t __attribute__((ext_vector_type(2)));
typedef float f32x2_t __attribute__((ext_vector_type(2)));
__device__ __forceinline__ unsigned cvt_pk_bf16(float lo, float hi) { f32x2_t v = {lo, hi}; bf16x2_t b = __builtin_convertvector(v, bf16x2_t); return __builtin_bit_cast(unsigned, b); }
typedef float f32x2 __attribute__((ext_vector_type(2)));
template <class Epi, class Sched, bool ALIGN_EPI = false, bool SP2 = false>
__device__ __forceinline__ void gemm_phase(PG8_LAS unsigned char* lds, const Gemm g, const Sched& S, const Epi& E) {
    const int tid = threadIdx.x, wid = __builtin_amdgcn_readfirstlane(tid >> 6), lane = tid & 63, wr = wid >> 2, wc = wid & 3, fr = lane & 15, fq = lane >> 4;
    const int K = g.K, nt = K / BK;
    unsigned voffA[2], voffB[2];
#pragma unroll
    for (int i = 0; i < 2; ++i) { int R, C; stage_rc(tid * 16 + i * 8192, R, C); const int Rb = Epi::PERM ? ((R & ~31) + perm32(R & 31)) : R;
        voffA[i] = (unsigned)(R * K + C) * 2u; voffB[i] = (unsigned)(Rb * K + C) * 2u; }
    const size_t kstep = (size_t)(BK * 2);
    const size_t hstep = (size_t)HALF * K * 2;
    const size_t tstep = 2 * hstep;
    const unsigned ldsw = (unsigned)wid * 1024u;
    const int aoff = lds_byte(wr * 64 + fr, fq * 8), boff = lds_byte(wc * 32 + fr, fq * 8);
#define PG8_SA(b, h) (((b) * 2 + (h)) * HTB)
#define PG8_SB(b, h) ((4 + (b) * 2 + (h)) * HTB)
#define PG8_STAGE(bufoff, gbase, voff) do { _Pragma("unroll") for (int _i = 0; _i < 2; ++_i) \
        __builtin_amdgcn_global_load_lds((const unsigned*)((const char*)(gbase) + (voff)[_i]), (PG8_LAS unsigned*)(lds + (bufoff) + ldsw + _i * 8192), 16, 0, 0); } while (0)
#define PG8_LDA(dst, b, h) do { _Pragma("unroll") for (int m = 0; m < 4; ++m) _Pragma("unroll") for (int k = 0; k < 2; ++k) dst[m][k] = *(const PG8_LAS bf16x8*)(lds + PG8_SA(b, h) + aoff + m * 2048 + k * 1024); } while (0)
#define PG8_LDB(dst, b, h) do { _Pragma("unroll") for (int n = 0; n < 2; ++n) _Pragma("unroll") for (int k = 0; k < 2; ++k) dst[n][k] = *(const PG8_LAS bf16x8*)(lds + PG8_SB(b, h) + boff + n * 2048 + k * 1024); } while (0)
#define PG8_MMA(ai, bj, At, Bt) do { __builtin_amdgcn_s_setprio(1); _Pragma("unroll") for (int m = 0; m < 4; ++m) _Pragma("unroll") for (int n = 0; n < 2; ++n) _Pragma("unroll") for (int k = 0; k < 2; ++k) \
        acc[ai][bj][m][n] = __builtin_amdgcn_mfma_f32_16x16x32_bf16(Bt[n][k], At[m][k], acc[ai][bj][m][n], 0, 0, 0); __builtin_amdgcn_s_setprio(0); } while (0)
#define PG8_WAIT_V(n) asm volatile("s_waitcnt vmcnt(" #n ")" ::: "memory")
#define PG8_WAIT_L(n) asm volatile("s_waitcnt lgkmcnt(" #n ")" ::: "memory")
#define PG8_BAR __builtin_amdgcn_s_barrier()
#define PG8_SCHED __builtin_amdgcn_sched_barrier(0)
    Unit cur, nxt; int ui = 0;
    if (!S.next(0, cur)) return;
    f32x4 acc[2][2][4][2];
#pragma unroll
    for (int a = 0; a < 2; ++a)
#pragma unroll
        for (int b = 0; b < 2; ++b)
#pragma unroll
            for (int m = 0; m < 4; ++m)
#pragma unroll
                for (int n = 0; n < 2; ++n) acc[a][b][m][n] = (f32x4){0.f, 0.f, 0.f, 0.f};
    bf16x8 At[4][2], B0[2][2], B1[2][2];
    const char* cA = (const char*)g.A + (size_t)cur.pm * tstep; const char* cB = (const char*)g.Bt + (size_t)cur.pn * tstep;
    S.a_ready(cur);
    if constexpr (SP2) {
        PG8_STAGE(PG8_SB(0, 0), cB, voffB); PG8_STAGE(PG8_SB(0, 1), cB + hstep, voffB); PG8_STAGE(PG8_SA(0, 0), cA, voffA); PG8_STAGE(PG8_SA(0, 1), cA + hstep, voffA);
        if (wr == 1) PG8_BAR;
        PG8_WAIT_V(2); PG8_BAR;
        PG8_STAGE(PG8_SB(1, 0), cB + kstep, voffB); PG8_STAGE(PG8_SA(1, 0), cA + kstep, voffA); PG8_STAGE(PG8_SB(1, 1), cB + hstep + kstep, voffB);
        PG8_WAIT_V(6); PG8_BAR;
    } else {
        PG8_STAGE(PG8_SB(0, 0), cB, voffB); PG8_STAGE(PG8_SA(0, 0), cA, voffA); PG8_STAGE(PG8_SB(0, 1), cB + hstep, voffB); PG8_STAGE(PG8_SA(0, 1), cA + hstep, voffA);
        if (wr == 1) PG8_BAR;
        PG8_WAIT_V(4); PG8_BAR;
        PG8_STAGE(PG8_SB(1, 0), cB + kstep, voffB); PG8_STAGE(PG8_SA(1, 0), cA + kstep, voffA); PG8_STAGE(PG8_SB(1, 1), cB + hstep + kstep, voffB);
        PG8_WAIT_V(6); PG8_BAR;
    }
    for (;;) {
        const bool has_next = S.next(ui + 1, nxt);
        const char* nA = has_next ? (const char*)g.A + (size_t)nxt.pm * tstep : cA; const char* nB = has_next ? (const char*)g.Bt + (size_t)nxt.pn * tstep : cB;
        for (int t = 0; t < nt; t += 2) {
            const bool last = (t == nt - 2);
            const char* a1 = cA + (size_t)(t + 1) * kstep;
            const char* a2 = last ? nA : cA + (size_t)(t + 2) * kstep; const char* b2 = last ? nB : cB + (size_t)(t + 2) * kstep;
            const char* a3 = a2 + kstep; const char* b3 = b2 + kstep;
            if (last && has_next) S.a_ready(nxt);
            if constexpr (SP2) {
            PG8_LDB(B0, 0, 0); PG8_LDB(B1, 0, 1); PG8_SCHED; PG8_LDA(At, 0, 0); PG8_STAGE(PG8_SA(1, 1), a1 + hstep, voffA);
            PG8_WAIT_V(8); PG8_WAIT_L(0); PG8_BAR; PG8_MMA(0, 0, At, B0); PG8_MMA(0, 1, At, B1); PG8_BAR; PG8_SCHED;
            PG8_LDA(At, 0, 1); PG8_STAGE(PG8_SB(0, 0), b2, voffB); PG8_STAGE(PG8_SB(0, 1), b2 + hstep, voffB); PG8_STAGE(PG8_SA(0, 0), a2, voffA);
            PG8_WAIT_V(8); PG8_WAIT_L(0); PG8_BAR; PG8_MMA(1, 0, At, B0); PG8_MMA(1, 1, At, B1); PG8_BAR; PG8_SCHED;
            PG8_LDB(B0, 1, 0); PG8_LDB(B1, 1, 1); PG8_SCHED; PG8_LDA(At, 1, 0); PG8_STAGE(PG8_SA(0, 1), a2 + hstep, voffA);
            PG8_WAIT_V(8); PG8_WAIT_L(0); PG8_BAR; PG8_MMA(0, 0, At, B0); PG8_MMA(0, 1, At, B1); PG8_BAR; PG8_SCHED;
            PG8_LDA(At, 1, 1); PG8_STAGE(PG8_SB(1, 0), b3, voffB); PG8_STAGE(PG8_SB(1, 1), b3 + hstep, voffB); PG8_STAGE(PG8_SA(1, 0), a3, voffA);
            PG8_WAIT_V(8); PG8_WAIT_L(0); PG8_BAR; PG8_MMA(1, 0, At, B0); PG8_MMA(1, 1, At, B1); PG8_BAR; PG8_SCHED;
            } else {
            PG8_LDB(B0, 0, 0); PG8_SCHED; PG8_LDA(At, 0, 0); PG8_STAGE(PG8_SA(1, 1), a1 + hstep, voffA);
            PG8_WAIT_L(8); PG8_BAR; PG8_WAIT_L(0); PG8_MMA(0, 0, At, B0); PG8_BAR; PG8_SCHED;
            PG8_LDB(B1, 0, 1); PG8_STAGE(PG8_SB(0, 0), b2, voffB);
            PG8_BAR; PG8_WAIT_L(0); PG8_MMA(0, 1, At, B1); PG8_BAR;
            PG8_LDA(At, 0, 1); PG8_STAGE(PG8_SA(0, 0), a2, voffA);
            PG8_BAR; PG8_WAIT_L(0); PG8_MMA(1, 0, At, B0); PG8_BAR; PG8_SCHED;
            PG8_STAGE(PG8_SB(0, 1), b2 + hstep, voffB);
            PG8_WAIT_V(6); PG8_BAR; PG8_MMA(1, 1, At, B1); PG8_BAR;
            PG8_LDB(B0, 1, 0); PG8_SCHED; PG8_LDA(At, 1, 0); PG8_STAGE(PG8_SA(0, 1), a2 + hstep, voffA);
            PG8_WAIT_L(8); PG8_BAR; PG8_WAIT_L(0); PG8_MMA(0, 0, At, B0); PG8_BAR; PG8_SCHED;
            PG8_LDB(B1, 1, 1); PG8_STAGE(PG8_SB(1, 0), b3, voffB);
            PG8_BAR; PG8_WAIT_L(0); PG8_MMA(0, 1, At, B1); PG8_BAR;
            PG8_LDA(At, 1, 1); PG8_STAGE(PG8_SA(1, 0), a3, voffA);
            PG8_BAR; PG8_WAIT_L(0); PG8_MMA(1, 0, At, B0); PG8_BAR; PG8_SCHED;
            PG8_STAGE(PG8_SB(1, 1), b3 + hstep, voffB);
            PG8_WAIT_V(6); PG8_BAR; PG8_MMA(1, 1, At, B1); PG8_BAR;
            }
        }
        if constexpr (ALIGN_EPI) { if (wr == 0) PG8_BAR; }
        if constexpr (!Epi::AFTER_DRAIN) { E(acc, cur, wr, wc, fr, fq); S.done(cur); }
        if (!has_next) break;
#pragma unroll
        for (int a = 0; a < 2; ++a)
#pragma unroll
            for (int b = 0; b < 2; ++b)
#pragma unroll
                for (int m = 0; m < 4; ++m)
#pragma unroll
                    for (int n = 0; n < 2; ++n) acc[a][b][m][n] = (f32x4){0.f, 0.f, 0.f, 0.f};
        cur = nxt; cA = nA; cB = nB; ++ui;
        if constexpr (ALIGN_EPI) { if (wr == 1) PG8_BAR; }
    }
    PG8_WAIT_V(0);
    if constexpr (!ALIGN_EPI) { if (wr == 0) PG8_BAR; }
    PG8_BAR;
    if constexpr (Epi::AFTER_DRAIN) { E.fused(acc, cur, wr, wc, fr, fq, lds, wid, lane); S.done(cur); }
#undef PG8_SA
#undef PG8_SB
#undef PG8_STAGE
#undef PG8_LDA
#undef PG8_LDB
#undef PG8_MMA
#undef PG8_WAIT_V
#undef PG8_WAIT_L
#undef PG8_BAR
#undef PG8_SCHED
}
}

#define LAS __attribute__((address_space(3)))
typedef unsigned short bf16_t;
using pg8::f32x4; using pg8::u32x4; using pg8::Unit; using pg8::cvt_pk_bf16;
typedef float f32x2v __attribute__((ext_vector_type(2)));
typedef unsigned u32x2v __attribute__((ext_vector_type(2)));

constexpr int T_ = 65536, DM = 1024, NIN = 4096, DFF = 2816, ROWS_P = 32768;
constexpr size_t MiB = 1u << 20;
constexpr float EPS = 1e-6f;
constexpr int LDS_BYTES = 147456;
constexpr size_t DO_XN = 0, DO_MIXIN = 0, DO_WIN = 128 * MiB, DO_ROPE = 136 * MiB, DO_WOUT = 137 * MiB;
constexpr size_t WS_U = 0;
constexpr size_t WS_MIX = 0;
constexpr size_t WS_WGU = 128 * MiB, WS_WDN = 139 * MiB, WS_SS1 = 145 * MiB, WS_SS2 = 149 * MiB, WS_HFF = 160 * MiB;
constexpr int UC_QA = 0, UC_KA = 512, UC_VA = 1024, UC_QH = 1536, UC_ZF = 2048, UC_ZB = 2560, UC_IH = 3072, UC_GH = 3584;

__device__ __forceinline__ float bf2f(unsigned short h) { return __uint_as_float((unsigned)h << 16); }
__device__ __forceinline__ unsigned short f2bf(float f) { unsigned u = __float_as_uint(f); return (unsigned short)((u + 0x7fffu + ((u >> 16) & 1u)) >> 16); }
__device__ __forceinline__ unsigned pk2(float lo, float hi) { return (unsigned)f2bf(lo) | ((unsigned)f2bf(hi) << 16); }
__device__ __forceinline__ float silu_f(float x) { return x / (1.f + __expf(-x)); }
__device__ __forceinline__ float sigmoid_f(float x) { return 1.f / (1.f + __expf(-x)); }
__device__ __forceinline__ int row_pos(int row) { return row < ROWS_P ? (row & 16383) : (row & 4095); }
__device__ __forceinline__ int row_S(int row) { return row < ROWS_P ? 16384 : 4096; }
__device__ __forceinline__ float wave_sum(float v) {
#pragma unroll
    for (int o = 1; o < 64; o <<= 1) v += __shfl_xor(v, o);
    return v;
}
__device__ __forceinline__ float wave_max(float v) {
#pragma unroll
    for (int o = 1; o < 64; o <<= 1) v = fmaxf(v, __shfl_xor(v, o));
    return v;
}
#define LDS_WAIT() asm volatile("s_waitcnt lgkmcnt(0)" ::: "memory")
__device__ __forceinline__ int otid() { int t; asm volatile("v_mov_b32 %0, %1" : "=v"(t) : "v"((int)threadIdx.x)); return t; }


__device__ unsigned g_bar[3456];
struct XcdBarrier { unsigned* bar; unsigned x; volatile LAS unsigned* st; };
#define XB_TMO      128
#define XB_XCNT(j)  (256  + 64 * (j))
#define XB_XSUB(j)  (1280 + 64 * (j))
#define XB_XGEN(j)  (2304 + 64 * (j))
#define XB_TOP      3328
#define XB_TOPGEN   3392
#define XCD_BAR_WORDS 3456
#define XB_SPIN_CAP (1u << 18)

__device__ __forceinline__ unsigned xb_ld(unsigned* p)              { return __hip_atomic_load(p, __ATOMIC_RELAXED, __HIP_MEMORY_SCOPE_AGENT); }
__device__ __forceinline__ unsigned xb_add(unsigned* p, unsigned v) { return __hip_atomic_fetch_add(p, v, __ATOMIC_RELAXED, __HIP_MEMORY_SCOPE_AGENT); }
__device__ __forceinline__ unsigned xb_xcc_id() { return (unsigned)__builtin_amdgcn_s_getreg((3 << 11) | 20) & 0xFu; }
#define XB_SPIN(cond, bar) do { unsigned _sp = 0; while (cond) { __builtin_amdgcn_s_sleep(1); \
    if ((++_sp & 255u) == 0u) { if (xb_ld(&(bar)[XB_TMO])) break; if (_sp > XB_SPIN_CAP) { atomicAdd(&(bar)[XB_TMO], 1u); break; } } } } while (0)
__device__ __forceinline__ XcdBarrier xcd_barrier_post(unsigned* bar, volatile LAS unsigned* st) {
    XcdBarrier b; b.bar = bar; b.x = xb_xcc_id(); b.st = st;
    if (threadIdx.x == 0) (void)xb_add(&bar[XB_XCNT(b.x)], 1u);
    return b;
}
__device__ __forceinline__ void xcd_barrier_complete(unsigned* bar, unsigned x, unsigned& nloc, unsigned& nx) {
    const unsigned G = gridDim.x * gridDim.y * gridDim.z;
    unsigned sum, cnt, mine, sp = 0u;
    for (;;) {
        sum = 0u; cnt = 0u; mine = 0u;
#pragma unroll
        for (unsigned j = 0; j < 16; ++j) { const unsigned c = xb_ld(&bar[XB_XCNT(j)]); sum += c; cnt += (c > 0u) ? 1u : 0u; mine = (j == x) ? c : mine; }
        if (sum == G) break;
        __builtin_amdgcn_s_sleep(1);
        if ((++sp & 255u) == 0u) { if (xb_ld(&bar[XB_TMO])) break; if (sp > XB_SPIN_CAP) { atomicAdd(&bar[XB_TMO], 1u); break; } }
    }
    nloc = mine > 0u ? mine : 1u; nx = cnt > 0u ? cnt : 1u;
}

__device__ __forceinline__ void xcd_barrier(const XcdBarrier& b) {
    asm volatile("s_waitcnt vmcnt(0)" ::: "memory");
    __syncthreads();
    if (threadIdx.x == 0) {
        unsigned* bar = b.bar;
        __builtin_amdgcn_s_waitcnt(0);
        unsigned nloc = b.st[0], nx = b.st[1];
        if (nloc == 0u) { xcd_barrier_complete(bar, b.x, nloc, nx); b.st[0] = nloc; b.st[1] = nx; }
        const unsigned old = xb_add(&bar[XB_XSUB(b.x)], 1u);
        const unsigned gen = old / nloc;
        if (old + 1u == (gen + 1u) * nloc) {
            __builtin_amdgcn_fence(__ATOMIC_RELEASE, "agent");
            asm volatile("s_waitcnt vmcnt(0)" ::: "memory");
            const unsigned og = xb_add(&bar[XB_TOP], 1u);
            const unsigned tg = og / nx;
            if (og + 1u == (tg + 1u) * nx) xb_add(&bar[XB_TOPGEN], 1u);
            else XB_SPIN(xb_ld(&bar[XB_TOPGEN]) == tg, bar);
            __builtin_amdgcn_fence(__ATOMIC_ACQUIRE, "agent");
            xb_add(&bar[XB_XGEN(b.x)], 1u);
            asm volatile("s_waitcnt vmcnt(0)" ::: "memory");
        } else {
            XB_SPIN(xb_ld(&bar[XB_XGEN(b.x)]) == gen, bar);
            __builtin_amdgcn_fence(__ATOMIC_ACQUIRE, "agent");
            asm volatile("s_waitcnt vmcnt(0)" ::: "memory");
        }
    }
    __syncthreads();
}

struct EpiU {
    static constexpr bool PERM = true, AFTER_DRAIN = false;
    bf16_t* U; const float* rope;
    __device__ __forceinline__ void operator()(const f32x4 (&acc)[2][2][4][2], const Unit& u, int wr, int wc, int fr, int fq) const {
        const int row0 = u.pm * 256 + wr * 64 + fr, col0 = u.pn * 256 + wc * 32 + 8 * fq;
        const bool rope_tile = (u.pn < 4) && ((wc & 1) == 0);
        const float sc = (u.pn < 2) ? 0.125f : 1.0f;
        const float sgn = (fq == 0) ? -1.f : 1.f;
#pragma unroll
        for (int ai = 0; ai < 2; ++ai)
#pragma unroll
            for (int m = 0; m < 4; ++m) {
                const int row = row0 + ai * 128 + m * 16;
                bf16_t* rowp = U + (size_t)row * NIN + col0;
                f32x4 r0 = {1.f, 0.f, 1.f, 0.f}, r1 = r0, r2 = r0, r3 = r0;
                if (rope_tile) { const f32x4* rp = (const f32x4*)(rope + (size_t)row_pos(row) * 16); r0 = rp[0]; r1 = rp[1]; r2 = rp[2]; r3 = rp[3]; }
#pragma unroll
                for (int bj = 0; bj < 2; ++bj) {
                    f32x4 v0 = acc[ai][bj][m][0], v1 = acc[ai][bj][m][1];
                    if (rope_tile) {
                        f32x4 p0, p1;
#pragma unroll
                        for (int j = 0; j < 4; ++j) { p0[j] = __shfl_xor(v0[j], 16); p1[j] = __shfl_xor(v1[j], 16); }
                        if (fq < 2) {
                            v0[0] = v0[0] * r0[0] + sgn * p0[0] * r0[1]; v0[1] = v0[1] * r0[2] + sgn * p0[1] * r0[3];
                            v0[2] = v0[2] * r1[0] + sgn * p0[2] * r1[1]; v0[3] = v0[3] * r1[2] + sgn * p0[3] * r1[3];
                            v1[0] = v1[0] * r2[0] + sgn * p1[0] * r2[1]; v1[1] = v1[1] * r2[2] + sgn * p1[1] * r2[3];
                            v1[2] = v1[2] * r3[0] + sgn * p1[2] * r3[1]; v1[3] = v1[3] * r3[2] + sgn * p1[3] * r3[3];
                        }
                    }
                    v0 = v0 * sc; v1 = v1 * sc;
                    u32x4 w; w.x = cvt_pk_bf16(v0[0], v0[1]); w.y = cvt_pk_bf16(v0[2], v0[3]); w.z = cvt_pk_bf16(v1[0], v1[1]); w.w = cvt_pk_bf16(v1[2], v1[3]);
                    *(u32x4*)(rowp + bj * 128) = w;
                }
            }
    }
};
struct EpiRowSS {
    static constexpr bool PERM = true, AFTER_DRAIN = false;
    bf16_t* O; float* SS;
    __device__ __forceinline__ void operator()(const f32x4 (&acc)[2][2][4][2], const Unit& u, int wr, int wc, int fr, int fq) const {
        const int row0 = u.pm * 256 + wr * 64 + fr, col0 = u.pn * 256 + wc * 32 + 8 * fq;
#pragma unroll
        for (int ai = 0; ai < 2; ++ai)
#pragma unroll
            for (int m = 0; m < 4; ++m) {
                const int row = row0 + ai * 128 + m * 16;
                bf16_t* rowp = O + (size_t)row * DM + col0;
                float s = 0.f;
#pragma unroll
                for (int bj = 0; bj < 2; ++bj) {
                    const f32x4 v0 = acc[ai][bj][m][0], v1 = acc[ai][bj][m][1];
                    s += (v0[0] * v0[0] + v0[1] * v0[1]) + (v0[2] * v0[2] + v0[3] * v0[3]) + (v1[0] * v1[0] + v1[1] * v1[1]) + (v1[2] * v1[2] + v1[3] * v1[3]);
                    u32x4 w; w.x = cvt_pk_bf16(v0[0], v0[1]); w.y = cvt_pk_bf16(v0[2], v0[3]); w.z = cvt_pk_bf16(v1[0], v1[1]); w.w = cvt_pk_bf16(v1[2], v1[3]);
                    *(u32x4*)(rowp + bj * 128) = w;
                }
                s += __shfl_xor(s, 16); s += __shfl_xor(s, 32);
                if (fq == 0) SS[(size_t)row * 16 + u.pn * 4 + wc] = s;
            }
    }
};
struct EpiSwiGLU {
    static constexpr bool PERM = true, AFTER_DRAIN = false;
    bf16_t* H;
    __device__ __forceinline__ void operator()(const f32x4 (&acc)[2][2][4][2], const Unit& u, int wr, int wc, int fr, int fq) const {
        const int row0 = u.pm * 256 + wr * 64 + fr, col0 = u.pn * 128 + wc * 32 + 8 * fq;
#pragma unroll
        for (int ai = 0; ai < 2; ++ai)
#pragma unroll
            for (int m = 0; m < 4; ++m) {
                const int row = row0 + ai * 128 + m * 16;
                const f32x4 g0 = acc[ai][0][m][0], g1 = acc[ai][0][m][1], u0 = acc[ai][1][m][0], u1 = acc[ai][1][m][1];
                f32x4 h0, h1;
#pragma unroll
                for (int j = 0; j < 4; ++j) { h0[j] = silu_f(g0[j]) * u0[j]; h1[j] = silu_f(g1[j]) * u1[j]; }
                u32x4 w; w.x = cvt_pk_bf16(h0[0], h0[1]); w.y = cvt_pk_bf16(h0[2], h0[3]); w.z = cvt_pk_bf16(h1[0], h1[1]); w.w = cvt_pk_bf16(h1[2], h1[3]);
                *(u32x4*)(H + (size_t)row * DFF + col0) = w;
            }
    }
};

template <class RowMap>
__device__ __forceinline__ void transpose_item(const float* W, int N, int k0, int n0, const float* kscale, bf16_t* WT, int K, RowMap rowmap, LAS float* scr, int lane) {
#pragma unroll 8
    for (int i = 0; i < 32; ++i) { const int kk = 2 * i + (lane >> 5); float w = W[(size_t)(k0 + kk) * N + n0 + (lane & 31)]; if (kscale) w *= kscale[k0 + kk]; scr[kk * 33 + (lane & 31)] = w; }
    LDS_WAIT();
    const int c = lane & 7;
#pragma unroll
    for (int j = 0; j < 4; ++j) { const int n = (lane >> 3) + 8 * j; const LAS float* s = scr + (8 * c) * 33 + n;
        u32x4 o; o.x = pk2(s[0 * 33], s[1 * 33]); o.y = pk2(s[2 * 33], s[3 * 33]); o.z = pk2(s[4 * 33], s[5 * 33]); o.w = pk2(s[6 * 33], s[7 * 33]);
        *(u32x4*)(WT + (size_t)rowmap(n0 + n) * K + k0 + 8 * c) = o; }
    LDS_WAIT();
}
struct RowId { __device__ __forceinline__ int operator()(int n) const { return n; } };
struct RowGU { int half; __device__ __forceinline__ int operator()(int n) const { return (n >> 7) * 256 + half * 128 + (n & 127); } };

struct Params {
    const float* xp; const float* xs; const float* w_in; const float* w_out; const float* lb_fwd; const float* lb_bwd; const float* g_hgrn;
    const float* g_pre_mix; const float* g_post_mix; const float* g_pre_ffn; const float* g_post_ffn; const float* w_gate; const float* w_up; const float* w_down;
    float* out; unsigned char* ws;
};
__device__ __forceinline__ const float* xrow_ptr(const Params& p, int row) { return row < ROWS_P ? p.xp + (size_t)row * DM : p.xs + (size_t)(row - ROWS_P) * DM; }

__device__ __forceinline__ void p0_prologue(const Params& p, LAS unsigned char* lds, int gw, int ngw, int wave, int lane) {
    unsigned char* dob = (unsigned char*)p.out;
    bf16_t* WIN = (bf16_t*)(dob + DO_WIN); bf16_t* WOUT = (bf16_t*)(dob + DO_WOUT); float* rope = (float*)(dob + DO_ROPE); bf16_t* XN = (bf16_t*)(dob + DO_XN);
    LAS float* scr = (LAS float*)(lds + wave * 16384);
    constexpr int I_IN = 16 * 128, I_OUT = 16 * 32;
    for (int it = gw; it < I_IN + I_OUT; it += ngw) {
        if (it < I_IN) transpose_item(p.w_in, NIN, 64 * (it / 128), 32 * (it % 128), p.g_pre_mix, WIN, DM, RowId{}, scr, lane);
        else { const int r = it - I_IN; transpose_item(p.w_out, DM, 64 * (r / 32), 32 * (r % 32), nullptr, WOUT, DM, RowId{}, scr, lane); }
    }
    {
        const int gt = gw * 64 + lane, ngt = ngw * 64;
        for (int e = gt; e < 16384 * 8; e += ngt) {
            const int pos = e >> 3, i = e & 7;
            const double rv = i == 0 ? 0.15915494309189535 : i == 1 ? 0.03086376340470123 : i == 2 ? 0.005985185712713705 : i == 3 ? 0.001160663641240061
                            : i == 4 ? 0.00022507907903927653 : i == 5 ? 4.364795279280289e-05 : i == 6 ? 8.464330808241401e-06 : 1.6414262627950345e-06;
            double a = (double)pos * rv; a -= floor(a);
            const float af = (float)a;
            rope[2 * e] = __builtin_amdgcn_cosf(af); rope[2 * e + 1] = __builtin_amdgcn_sinf(af);
        }
    }
    for (int m0 = gw * 4; m0 < T_; m0 += ngw * 4) {
        f32x4 v[4][4]; float s[4];
#pragma unroll
        for (int k = 0; k < 4; ++k) { const f32x4* xr = (const f32x4*)xrow_ptr(p, m0 + k) + lane;
#pragma unroll
            for (int j = 0; j < 4; ++j) v[k][j] = xr[64 * j]; }
#pragma unroll
        for (int k = 0; k < 4; ++k) { s[k] = 0.f;
#pragma unroll
            for (int j = 0; j < 4; ++j) s[k] += (v[k][j][0] * v[k][j][0] + v[k][j][1] * v[k][j][1]) + (v[k][j][2] * v[k][j][2] + v[k][j][3] * v[k][j][3]); }
#pragma unroll
        for (int k = 0; k < 4; ++k) {
            const float rstd = rsqrtf(wave_sum(s[k]) * (1.f / DM) + EPS);
            u32x2v* o8 = (u32x2v*)(XN + (size_t)(m0 + k) * DM) + lane;
#pragma unroll
            for (int j = 0; j < 4; ++j) { u32x2v w; w.x = cvt_pk_bf16(v[k][j][0] * rstd, v[k][j][1] * rstd); w.y = cvt_pk_bf16(v[k][j][2] * rstd, v[k][j][3] * rstd); o8[64 * j] = w; }
        }
    }
}

__device__ __forceinline__ void attn_simple(const bf16_t* U, bf16_t* MIXIN, int gw, int ngw, int lane) {
    for (int item = gw; item < T_ * 8; item += ngw) {
        const int row = item >> 3, h = item & 7;
        const int pos = row_pos(row), S = row_S(row), base = row - pos;
        float q[64];
        { const u32x4* qp = (const u32x4*)(U + (size_t)row * NIN + UC_QA + h * 64);
#pragma unroll
          for (int c = 0; c < 8; ++c) { const u32x4 w = qp[c];
              q[8 * c + 0] = __uint_as_float(w.x << 16); q[8 * c + 1] = __uint_as_float(w.x & 0xffff0000u);
              q[8 * c + 2] = __uint_as_float(w.y << 16); q[8 * c + 3] = __uint_as_float(w.y & 0xffff0000u);
              q[8 * c + 4] = __uint_as_float(w.z << 16); q[8 * c + 5] = __uint_as_float(w.z & 0xffff0000u);
              q[8 * c + 6] = __uint_as_float(w.w << 16); q[8 * c + 7] = __uint_as_float(w.w & 0xffff0000u); } }
        float s[9];
#pragma unroll
        for (int b = 0; b < 3; ++b)
#pragma unroll
            for (int r = 0; r < 3; ++r) {
                const int dil = 1 << (2 * b), j = -64 + 64 * r + lane, kp = pos + j * dil;
                const bool valid = (r < 2 || lane == 0) && kp >= 0 && kp < S;
                float d = -1e30f;
                if (valid) {
                    const u32x4* kq = (const u32x4*)(U + (size_t)(base + kp) * NIN + UC_KA + h * 64);
                    float a = 0.f;
#pragma unroll
                    for (int c = 0; c < 8; ++c) { const u32x4 w = kq[c];
                        a += q[8 * c + 0] * __uint_as_float(w.x << 16) + q[8 * c + 1] * __uint_as_float(w.x & 0xffff0000u)
                           + q[8 * c + 2] * __uint_as_float(w.y << 16) + q[8 * c + 3] * __uint_as_float(w.y & 0xffff0000u)
                           + q[8 * c + 4] * __uint_as_float(w.z << 16) + q[8 * c + 5] * __uint_as_float(w.z & 0xffff0000u)
                           + q[8 * c + 6] * __uint_as_float(w.w << 16) + q[8 * c + 7] * __uint_as_float(w.w & 0xffff0000u); }
                    d = a;
                }
                s[b * 3 + r] = d;
            }
        float mx = s[0];
#pragma unroll
        for (int i = 1; i < 9; ++i) mx = fmaxf(mx, s[i]);
        mx = wave_max(mx);
        float l = 0.f;
#pragma unroll
        for (int i = 0; i < 9; ++i) { s[i] = __expf(s[i] - mx); l += s[i]; }
        l = wave_sum(l);
        float o = 0.f;
        const bf16_t* vbase = U + UC_VA + h * 64 + lane;
#pragma unroll
        for (int b = 0; b < 3; ++b)
#pragma unroll
            for (int r = 0; r < 3; ++r) {
                const int dil = 1 << (2 * b), cnt = (r < 2) ? 64 : 1;
                for (int jj = 0; jj < cnt; ++jj) {
                    const float pj = __shfl(s[b * 3 + r], jj);
                    const int kp = pos + (-64 + 64 * r + jj) * dil;
                    if (kp >= 0 && kp < S) o += pj * bf2f(vbase[(size_t)(base + kp) * NIN]);
                }
            }
        MIXIN[(size_t)row * DM + h * 64 + lane] = f2bf(o / l);
    }
}

namespace at {
typedef short bf16x8 __attribute__((ext_vector_type(8)));
typedef short s16x4 __attribute__((ext_vector_type(4)));
constexpr int OS = 65;
constexpr int L_OUT = 0, L_L = 272 * OS * 4, L_VS = L_L + 1024, VS_STRIDE = 144, VS_WAVE = 32 * VS_STRIDE, L_END = L_VS + 8 * VS_WAVE;
static_assert(L_END <= LDS_BYTES, "attention LDS map");

template <bool INTERIOR>
__device__ __forceinline__ void wave_tile_t(const bf16_t* U, LAS unsigned char* lds, int w, int lane, int base, int S, int P0, int h, int idx) {
    const int n = lane & 15, quad = lane >> 4;
    const int br = idx >> 4, sub = idx & 15;
    const int dsh = 2 * br, dil = 1 << dsh;
    const int r = br == 0 ? 0 : (br == 1 ? (sub & 3) : sub);
    const int mt = br == 0 ? sub : (br == 1 ? (sub >> 2) : 0);
    const int Lsub = S >> dsh, m0 = (P0 >> dsh) + 16 * mt;
    const bf16_t* Ub = U + (size_t)base * NIN + h * 64;
    bf16x8 qf[2];
    { const bf16_t* qp = Ub + (size_t)((m0 + n) * dil + r) * NIN + UC_QA + 8 * quad; qf[0] = *(const bf16x8*)qp; qf[1] = *(const bf16x8*)(qp + 32); }
    bf16x8 kf[9][2];
#pragma unroll
    for (int kt = 0; kt < 9; ++kt) {
        int mk = m0 - 64 + 16 * kt + n; if (!INTERIOR) mk = mk < 0 ? 0 : (mk >= Lsub ? Lsub - 1 : mk);
        const bf16_t* kp = Ub + (size_t)(mk * dil + r) * NIN + UC_KA + 8 * quad; kf[kt][0] = *(const bf16x8*)kp; kf[kt][1] = *(const bf16x8*)(kp + 32);
    }
    u32x4 vr[5][4];
#pragma unroll
    for (int t = 0; t < 5; ++t)
#pragma unroll
        for (int e = 0; e < 4; ++e) {
            const int id = lane + 64 * e, rho = id >> 3, ch = id & 7;
            int mk = m0 - 64 + 32 * t + rho; if (!INTERIOR || t == 4) mk = mk < 0 ? 0 : (mk >= Lsub ? Lsub - 1 : mk);
            vr[t][e] = *(const u32x4*)(Ub + (size_t)(mk * dil + r) * NIN + UC_VA + 8 * ch);
        }
    unsigned pk[10][2];
    float lsum = 0.f;
#pragma unroll
    for (int kt = 0; kt < 9; ++kt) {
        f32x4 sc = {0.f, 0.f, 0.f, 0.f};
        sc = __builtin_amdgcn_mfma_f32_16x16x32_bf16(kf[kt][0], qf[0], sc, 0, 0, 0);
        sc = __builtin_amdgcn_mfma_f32_16x16x32_bf16(kf[kt][1], qf[1], sc, 0, 0, 0);
        float pv[4];
#pragma unroll
        for (int j = 0; j < 4; ++j) {
            const int ko = 16 * kt + 4 * quad + j, mk = m0 - 64 + ko;
            const bool valid = INTERIOR ? ((kt != 0 || ko >= n) && (kt != 8 || ko <= n + 128)) : ((ko >= n) && (ko <= n + 128) && (mk >= 0) && (mk < Lsub));
            const float e = __expf(fminf(sc[j], 80.f));
            pv[j] = valid ? e : 0.f; lsum += pv[j];
        }
        pk[kt][0] = cvt_pk_bf16(pv[0], pv[1]); pk[kt][1] = cvt_pk_bf16(pv[2], pv[3]);
    }
    pk[9][0] = 0u; pk[9][1] = 0u;
    lsum += __shfl_xor(lsum, 16); lsum += __shfl_xor(lsum, 32);
    f32x4 ot[4];
#pragma unroll
    for (int dt = 0; dt < 4; ++dt) ot[dt] = (f32x4){0.f, 0.f, 0.f, 0.f};
    LAS unsigned char* vs = lds + L_VS + w * VS_WAVE;
#pragma unroll
    for (int t = 0; t < 5; ++t) {
#pragma unroll
        for (int e = 0; e < 4; ++e) { const int id = lane + 64 * e, rho = id >> 3, ch = id & 7; *(LAS u32x4*)(vs + rho * VS_STRIDE + ch * 16) = vr[t][e]; }
        bf16x8 pf; { u32x4 pw = {pk[2 * t][0], pk[2 * t][1], pk[2 * t + 1][0], pk[2 * t + 1][1]}; pf = __builtin_bit_cast(bf16x8, pw); }
#pragma unroll
        for (int dt = 0; dt < 4; ++dt) {
            const int q = (lane & 15) >> 2, pp = lane & 3;
            const s16x4 lo = __builtin_amdgcn_ds_read_tr16_b64_v4i16((LAS s16x4*)(vs + (4 * quad + q) * VS_STRIDE + (16 * dt + 4 * pp) * 2));
            const s16x4 hi = __builtin_amdgcn_ds_read_tr16_b64_v4i16((LAS s16x4*)(vs + (16 + 4 * quad + q) * VS_STRIDE + (16 * dt + 4 * pp) * 2));
            const bf16x8 vf = {lo[0], lo[1], lo[2], lo[3], hi[0], hi[1], hi[2], hi[3]};
            ot[dt] = __builtin_amdgcn_mfma_f32_16x16x32_bf16(vf, pf, ot[dt], 0, 0, 0);
        }
    }
    const int posl = ((m0 + n) * dil + r) - P0;
    LAS float* op = (LAS float*)(lds + L_OUT) + (posl + (posl >> 4)) * OS + 4 * quad;
    LAS float* lp = (LAS float*)(lds + L_L) + posl;
    if (br == 0) {
#pragma unroll
        for (int dt = 0; dt < 4; ++dt)
#pragma unroll
            for (int j = 0; j < 4; ++j) op[16 * dt + j] = ot[dt][j];
        if (quad == 0) *lp = lsum;
    } else {
        float old[16];
#pragma unroll
        for (int dt = 0; dt < 4; ++dt)
#pragma unroll
            for (int j = 0; j < 4; ++j) old[4 * dt + j] = op[16 * dt + j];
        const float lo = *lp;
#pragma unroll
        for (int dt = 0; dt < 4; ++dt)
#pragma unroll
            for (int j = 0; j < 4; ++j) op[16 * dt + j] = old[4 * dt + j] + ot[dt][j];
        if (quad == 0) *lp = lo + lsum;
    }
}

__device__ __forceinline__ void wave_tile(const bf16_t* U, LAS unsigned char* lds, int w, int lane, int base, int S, int P0, int h, int idx) {
    const int br = idx >> 4, sub = idx & 15, dsh = 2 * br, mt = br == 0 ? sub : (br == 1 ? (sub >> 2) : 0);
    const int Lsub = S >> dsh, m0 = (P0 >> dsh) + 16 * mt;
    if (m0 >= 64 && m0 + 96 <= Lsub) wave_tile_t<true>(U, lds, w, lane, base, S, P0, h, idx);
    else wave_tile_t<false>(U, lds, w, lane, base, S, P0, h, idx);
}
__device__ __forceinline__ void attn_phase(const bf16_t* U, bf16_t* MIXIN, LAS unsigned char* lds, int blk, int G) {
    const int tid = otid(), lane = tid & 63, w = __builtin_amdgcn_readfirstlane(tid >> 6);
    __syncthreads();
    for (int u = blk; u < 2048; u += G) {
        int grp = u >> 3, h = u & 7;
        if (G == 256) { const int x = u & 7, j = (u >> 3) & 31, e8 = u >> 8; h = j & 7; grp = 32 * x + 4 * e8 + (j >> 3); }
        const int row0 = grp * 256;
        const int base = row0 < ROWS_P ? (row0 & ~16383) : (ROWS_P + ((row0 - ROWS_P) & ~4095)), S = row0 < ROWS_P ? 16384 : 4096, P0 = row0 - base;
        for (int br = 0; br < 3; ++br) {
            wave_tile(U, lds, w, lane, base, S, P0, h, 16 * br + w);
            wave_tile(U, lds, w, lane, base, S, P0, h, 16 * br + w + 8);
            __syncthreads();
        }
        {
            const int pos = tid >> 1, half = tid & 1;
            const LAS float* op = (const LAS float*)(lds + L_OUT) + (pos + (pos >> 4)) * OS + 32 * half;
            const float inv = 1.f / ((const LAS float*)(lds + L_L))[pos];
            unsigned wv[16];
#pragma unroll
            for (int d = 0; d < 16; ++d) wv[d] = cvt_pk_bf16(op[2 * d] * inv, op[2 * d + 1] * inv);
            u32x4* gp = (u32x4*)(MIXIN + (size_t)(row0 + pos) * DM + h * 64 + 32 * half);
#pragma unroll
            for (int c = 0; c < 4; ++c) gp[c] = (u32x4){wv[4 * c], wv[4 * c + 1], wv[4 * c + 2], wv[4 * c + 3]};
        }
        __syncthreads();
    }
}
}

__device__ __forceinline__ void hgrn_simple(const Params& p, const bf16_t* U, bf16_t* MIXIN, LAS unsigned char* lds, int blk, int nblk) {
    LAS f32x2v* fqb = (LAS f32x2v*)lds;
    LAS float* po = (LAS float*)(lds + 2048);
    const int tid = threadIdx.x, vcol = tid & 127, kq = tid >> 7;
    for (int item = blk; item < 40; item += nblk) {
        const int sb = item >> 2, hh = item & 3;
        const int base = sb < 2 ? sb * 16384 : ROWS_P + (sb - 2) * 4096, S = sb < 2 ? 16384 : 4096;
        for (int dir = 1; dir >= 0; --dir) {
            const float* lbr = dir ? p.lb_bwd : p.lb_fwd;
            float lb = 0.f;
            if (tid < 128) { const int c = hh * 128 + tid; lb = 1.f / (1.f + __expf(lbr[512 + c] - lbr[c])); }
            const int zcol = (dir ? UC_ZB : UC_ZF) + hh * 128;
            float St[32];
#pragma unroll
            for (int k = 0; k < 32; ++k) St[k] = 0.f;
            int buf = 0;
            __syncthreads();
            for (int i = 0; i < S; ++i) {
                const int t = dir ? (S - 1 - i) : i;
                const size_t ro = (size_t)(base + t) * NIN;
                if (tid < 128) { const float z = bf2f(U[ro + zcol + tid]), qr = bf2f(U[ro + UC_QH + hh * 128 + tid]);
                    const float f = lb + (1.f - lb) * sigmoid_f(z); fqb[buf * 128 + tid] = (f32x2v){f, silu_f(qr)}; }
                const float v = bf2f(U[ro + UC_IH + hh * 128 + vcol]);
                __syncthreads();
                if (kq == 0 && i > 0) {
                    const LAS float* pp = po + (buf ^ 1) * 512 + vcol; const float o = (pp[0] + pp[128]) + (pp[256] + pp[384]);
                    const int tp = dir ? (S - i) : (i - 1);
                    const size_t mo = (size_t)(base + tp) * DM + 512 + hh * 128 + vcol;
                    if (dir) MIXIN[mo] = f2bf(o); else MIXIN[mo] = f2bf(o + bf2f(MIXIN[mo]));
                }
                float part = 0.f;
#pragma unroll
                for (int kk = 0; kk < 32; ++kk) { const f32x2v fq = fqb[buf * 128 + kq * 32 + kk]; St[kk] = fq.x * St[kk] + (1.f - fq.x) * v; part += fq.y * St[kk]; }
                po[buf * 512 + kq * 128 + vcol] = part;
                buf ^= 1;
            }
            __syncthreads();
            if (kq == 0) {
                const LAS float* pp = po + (buf ^ 1) * 512 + vcol; const float o = (pp[0] + pp[128]) + (pp[256] + pp[384]);
                const int tp = dir ? 0 : (S - 1);
                const size_t mo = (size_t)(base + tp) * DM + 512 + hh * 128 + vcol;
                if (dir) MIXIN[mo] = f2bf(o); else MIXIN[mo] = f2bf(o + bf2f(MIXIN[mo]));
            }
        }
    }
}


namespace hg {
typedef short bf16x8 __attribute__((ext_vector_type(8)));
constexpr int SEG = 1024, NCH = 16, NITEM = 512;
constexpr int RS = 272, TS = 144;
constexpr int L_QT = 0, L_QR = 17408, L_KR = 34816, L_K0 = 52224, L_Q4 = 56576, L_KT = 60928, L_VT = 79360, L_ST = 97792, L_AB = 132608, L_TOT = 141824, L_BV = 143872, L_END = 144384;
static_assert(L_END <= LDS_BYTES, "hgrn LDS map");
constexpr size_t DO_STATE = 140 * MiB, DO_DEC = 172 * MiB, DO_OB = 176 * MiB, DO_INIT = 240 * MiB;

__device__ __forceinline__ int phys_row(int g, int dir, int lt) { return dir ? (g * SEG + SEG - 1 - lt) : (g * SEG + lt); }
__device__ __forceinline__ unsigned short bf1(float x) { __bf16 b = (__bf16)x; return __builtin_bit_cast(unsigned short, b); }
__device__ __forceinline__ bf16x8 ldfrag(LAS unsigned char* lds, int off, int stride, int row0, int kel, int lane) {
    return *(const LAS bf16x8*)(lds + off + (row0 + (lane & 15)) * stride + (kel + 8 * (lane >> 4)) * 2);
}
template <bool FULL>
__device__ __forceinline__ void load_raw(const bf16_t* U, int g, int dir, int ch, int i, int zcol, int qcol, int vcol, unsigned short (&rz)[16], unsigned short (&rq)[16], unsigned short (&rv)[16]) {
#pragma unroll
    for (int r = 0; r < 16; ++r) {
        const bf16_t* pr = U + (size_t)phys_row(g, dir, 64 * ch + 16 * i + r) * NIN;
        rz[r] = pr[zcol]; if (FULL) rq[r] = pr[qcol]; rv[r] = pr[vcol];
    }
}
template <bool FULL>
__device__ __forceinline__ void prep(LAS unsigned char* lds, int i, int c, float lb, const unsigned short (&rz)[16], const unsigned short (&rq)[16], const unsigned short (&rv)[16], float& bdec) {
    float f[16], e1[16], qs[16];
    float run = 1.f;
#pragma unroll
    for (int r = 0; r < 16; ++r) {
        const float fr = lb + (1.f - lb) * sigmoid_f(bf2f(rz[r]));
        f[r] = fr; run *= fr; e1[r] = run;
        if (FULL) qs[r] = silu_f(bf2f(rq[r])); else qs[r] = 0.f;
    }
    ((LAS float*)(lds + L_TOT))[i * 128 + c] = run;
    {
        u32x4 a, b;
        a.x = rv[0] | ((unsigned)rv[1] << 16); a.y = rv[2] | ((unsigned)rv[3] << 16); a.z = rv[4] | ((unsigned)rv[5] << 16); a.w = rv[6] | ((unsigned)rv[7] << 16);
        b.x = rv[8] | ((unsigned)rv[9] << 16); b.y = rv[10] | ((unsigned)rv[11] << 16); b.z = rv[12] | ((unsigned)rv[13] << 16); b.w = rv[14] | ((unsigned)rv[15] << 16);
        LAS u32x4* vp = (LAS u32x4*)(lds + L_VT + c * TS + 32 * i); vp[0] = a; vp[1] = b;
    }
    __syncthreads();
    const LAS float* tp = (const LAS float*)(lds + L_TOT) + c;
    const float p0 = tp[0], p1 = tp[128], p2 = tp[256], p3 = tp[384];
    const float cQT = i == 0 ? 1.f : i == 1 ? p0 : i == 2 ? p0 * p1 : p0 * p1 * p2;
    const float cKT = i == 0 ? p1 * p2 * p3 : i == 1 ? p2 * p3 : i == 2 ? p3 : 1.f;
    const float cQR = i == 0 ? 1.f : i == 1 ? 1.f / p1 : i == 2 ? 1.f : p2;
    const float cKR = i == 0 ? p1 : i == 1 ? 1.f : i == 2 ? 1.f / p2 : 1.f;
    const float cK0 = 1.f / p0, cQ4 = 1.f / p3;
    bdec = (p0 * p1) * (p2 * p3);
    if (i == 0) ((LAS float*)(lds + L_BV))[c] = bdec;
    unsigned short kt[16];
    float e2 = 1.f;
#pragma unroll
    for (int r = 15; r >= 0; --r) {
        const float kb = (1.f - f[r]) * e2;
        kt[r] = bf1(kb * cKT);
        if (FULL) {
            *(LAS unsigned short*)(lds + L_KR + (16 * i + r) * RS + c * 2) = bf1(kb * cKR);
            if (i == 0) *(LAS unsigned short*)(lds + L_K0 + r * RS + c * 2) = bf1(kb * cK0);
        }
        e2 *= f[r];
    }
    {
        u32x4 a, b;
        a.x = kt[0] | ((unsigned)kt[1] << 16); a.y = kt[2] | ((unsigned)kt[3] << 16); a.z = kt[4] | ((unsigned)kt[5] << 16); a.w = kt[6] | ((unsigned)kt[7] << 16);
        b.x = kt[8] | ((unsigned)kt[9] << 16); b.y = kt[10] | ((unsigned)kt[11] << 16); b.z = kt[12] | ((unsigned)kt[13] << 16); b.w = kt[14] | ((unsigned)kt[15] << 16);
        LAS u32x4* kp = (LAS u32x4*)(lds + L_KT + c * TS + 32 * i); kp[0] = a; kp[1] = b;
    }
    if (FULL) {
#pragma unroll
        for (int r = 0; r < 16; ++r) {
            const float qe = qs[r] * e1[r];
            *(LAS unsigned short*)(lds + L_QT + (16 * i + r) * RS + c * 2) = bf1(qe * cQT);
            *(LAS unsigned short*)(lds + L_QR + (16 * i + r) * RS + c * 2) = bf1(qe * cQR);
            if (i == 3) *(LAS unsigned short*)(lds + L_Q4 + r * RS + c * 2) = bf1(qe * cQ4);
        }
    }
}
__device__ __forceinline__ void state_update(LAS unsigned char* lds, f32x4 (&S)[8], int w, int gq, int lane) {
    bf16x8 ktf[2];
#pragma unroll
    for (int k2 = 0; k2 < 2; ++k2) ktf[k2] = ldfrag(lds, L_KT, TS, 16 * w, 32 * k2, lane);
    const f32x4 dk = *(const LAS f32x4*)(lds + L_BV + (16 * w + 4 * gq) * 4);
#pragma unroll
    for (int n = 0; n < 8; ++n) {
        S[n] = S[n] * dk;
#pragma unroll
        for (int k2 = 0; k2 < 2; ++k2) S[n] = __builtin_amdgcn_mfma_f32_16x16x32_bf16(ktf[k2], ldfrag(lds, L_VT, TS, 16 * n, 32 * k2, lane), S[n], 0, 0, 0);
    }
}
__device__ __forceinline__ int item_of(int lin, int G) {
    if (G != 256) return lin;
    const int x = lin & 7, j = (lin >> 3) & 31, e = lin >> 8, g = 8 * x + 2 * (j >> 3) + e, hd = j & 7;
    return g * 8 + hd;
}
__device__ __forceinline__ float lb_of(const Params& p, int dir, int col) { const float* lbr = dir ? p.lb_bwd : p.lb_fwd; return 1.f / (1.f + __expf(lbr[512 + col] - lbr[col])); }

__device__ __forceinline__ void pass1(const Params& p, const bf16_t* U, LAS unsigned char* lds, int item) {
    const int tid = otid(), lane = tid & 63, w = __builtin_amdgcn_readfirstlane(tid >> 6), i = w >> 1, c = tid & 127, gq = lane >> 4;
    const int dir = item & 1, hh = (item >> 1) & 3, g = item >> 3;
    float* STATE = (float*)((unsigned char*)p.out + DO_STATE); float* DEC = (float*)((unsigned char*)p.out + DO_DEC);
    const float lb = lb_of(p, dir, hh * 128 + c);
    const int zcol = (dir ? UC_ZB : UC_ZF) + hh * 128 + c, qcol = UC_QH + hh * 128 + c, vcol = UC_IH + hh * 128 + c;
    f32x4 S[8];
#pragma unroll
    for (int n = 0; n < 8; ++n) S[n] = (f32x4){0.f, 0.f, 0.f, 0.f};
    float dtot = 1.f;
    unsigned short rz[16], rq[16], rv[16];
    load_raw<false>(U, g, dir, 0, i, zcol, qcol, vcol, rz, rq, rv);
    for (int ch = 0; ch < NCH; ++ch) {
        float bdec;
        prep<false>(lds, i, c, lb, rz, rq, rv, bdec);
        dtot *= bdec;
        if (ch + 1 < NCH) load_raw<false>(U, g, dir, ch + 1, i, zcol, qcol, vcol, rz, rq, rv);
        __syncthreads();
        state_update(lds, S, w, gq, lane);
        __syncthreads();
    }
    float* sp = STATE + (size_t)item * 16384 + (16 * w + 4 * gq) * 128 + (lane & 15);
#pragma unroll
    for (int n = 0; n < 8; ++n)
#pragma unroll
        for (int jj = 0; jj < 4; ++jj) sp[jj * 128 + 16 * n] = S[n][jj];
    if (i == 0) DEC[item * 128 + c] = dtot;
}
__device__ __forceinline__ void scan(const Params& p, int gt, int ngt) {
    const float* STATE = (const float*)((unsigned char*)p.out + DO_STATE); const float* DEC = (const float*)((unsigned char*)p.out + DO_DEC);
    bf16_t* INIT = (bf16_t*)((unsigned char*)p.out + DO_INIT);
    for (int e = gt; e < 80 * 4096; e += ngt) {
        const int chain = e >> 12, q4 = e & 4095, k = q4 >> 5;
        const int dir = chain & 1, hh = (chain >> 1) & 3, sb = chain >> 3;
        const int nseg = sb < 2 ? 16 : 4, g0 = sb < 2 ? sb * 16 : 32 + (sb - 2) * 4;
        f32x4 s = {0.f, 0.f, 0.f, 0.f};
        for (int j = 0; j < nseg; ++j) {
            const int g = dir ? (g0 + nseg - 1 - j) : (g0 + j), item = (g * 4 + hh) * 2 + dir;
            const f32x4 en = *((const f32x4*)(STATE + (size_t)item * 16384) + q4);
            u32x2v wv; wv.x = cvt_pk_bf16(s[0], s[1]); wv.y = cvt_pk_bf16(s[2], s[3]);
            *((u32x2v*)(INIT + (size_t)item * 16384) + q4) = wv;
            s = s * DEC[item * 128 + k] + en;
        }
    }
}
__device__ __forceinline__ void pass2(const Params& p, const bf16_t* U, bf16_t* MIXIN, LAS unsigned char* lds, int item) {
    const int tid = otid(), lane = tid & 63, w = __builtin_amdgcn_readfirstlane(tid >> 6), i = w >> 1, c = tid & 127, gq = lane >> 4;
    const int dir = item & 1, hh = (item >> 1) & 3, g = item >> 3;
    const bf16_t* INIT = (const bf16_t*)((unsigned char*)p.out + DO_INIT);
    bf16_t* OUT = dir ? (bf16_t*)((unsigned char*)p.out + DO_OB) + hh * 128 : MIXIN + 512 + hh * 128;
    const int opitch = dir ? 512 : DM;
    const float lb = lb_of(p, dir, hh * 128 + c);
    const int zcol = (dir ? UC_ZB : UC_ZF) + hh * 128 + c, qcol = UC_QH + hh * 128 + c, vcol = UC_IH + hh * 128 + c;
    for (int idx = tid; idx < 64 * TS / 4; idx += 512) ((LAS unsigned*)(lds + L_AB))[idx] = 0u;
    f32x4 S[8];
    {
        const bf16_t* sp = INIT + (size_t)item * 16384 + (16 * w + 4 * gq) * 128 + (lane & 15);
#pragma unroll
        for (int n = 0; n < 8; ++n)
#pragma unroll
            for (int jj = 0; jj < 4; ++jj) S[n][jj] = bf2f(sp[jj * 128 + 16 * n]);
    }
#define HG_ST_WRITE() do { _Pragma("unroll") for (int n = 0; n < 8; ++n) { u32x2v wv; wv.x = cvt_pk_bf16(S[n][0], S[n][1]); wv.y = cvt_pk_bf16(S[n][2], S[n][3]); \
        *(LAS u32x2v*)(lds + L_ST + (16 * n + (lane & 15)) * RS + (16 * w + 4 * gq) * 2) = wv; } } while (0)
    HG_ST_WRITE();
    unsigned short rz[16], rq[16], rv[16];
    load_raw<true>(U, g, dir, 0, i, zcol, qcol, vcol, rz, rq, rv);
    for (int ch = 0; ch < NCH; ++ch) {
        float bdec;
        prep<true>(lds, i, c, lb, rz, rq, rv, bdec);
        if (ch + 1 < NCH) load_raw<true>(U, g, dir, ch + 1, i, zcol, qcol, vcol, rz, rq, rv);
        __syncthreads();
        for (int bi = w; bi < 10; bi += 8) {
            const int ti = bi >= 6 ? 3 : bi >= 3 ? 2 : bi >= 1 ? 1 : 0, tj = bi - ti * (ti + 1) / 2;
            const int qoff = (bi == 9) ? L_Q4 : L_QR + 16 * ti * RS, koff = (bi == 0) ? L_K0 : L_KR + 16 * tj * RS;
            f32x4 a = {0.f, 0.f, 0.f, 0.f};
#pragma unroll
            for (int ks = 0; ks < 4; ++ks) a = __builtin_amdgcn_mfma_f32_16x16x32_bf16(ldfrag(lds, qoff, RS, 0, 32 * ks, lane), ldfrag(lds, koff, RS, 0, 32 * ks, lane), a, 0, 0, 0);
#pragma unroll
            for (int jj = 0; jj < 4; ++jj) {
                float val = a[jj];
                if (ti == tj && (lane & 15) > 4 * gq + jj) val = 0.f;
                *(LAS unsigned short*)(lds + L_AB + (16 * ti + 4 * gq + jj) * TS + (16 * tj + (lane & 15)) * 2) = bf1(val);
            }
        }
        __syncthreads();
        {
            bf16x8 stf[4], vtf[2];
#pragma unroll
            for (int ks = 0; ks < 4; ++ks) stf[ks] = ldfrag(lds, L_ST, RS, 16 * w, 32 * ks, lane);
#pragma unroll
            for (int k2 = 0; k2 < 2; ++k2) vtf[k2] = ldfrag(lds, L_VT, TS, 16 * w, 32 * k2, lane);
#pragma unroll
            for (int mt = 0; mt < 4; ++mt) {
                f32x4 o = {0.f, 0.f, 0.f, 0.f};
#pragma unroll
                for (int ks = 0; ks < 4; ++ks) o = __builtin_amdgcn_mfma_f32_16x16x32_bf16(ldfrag(lds, L_QT, RS, 16 * mt, 32 * ks, lane), stf[ks], o, 0, 0, 0);
#pragma unroll
                for (int k2 = 0; k2 < 2; ++k2) o = __builtin_amdgcn_mfma_f32_16x16x32_bf16(ldfrag(lds, L_AB, TS, 16 * mt, 32 * k2, lane), vtf[k2], o, 0, 0, 0);
#pragma unroll
                for (int jj = 0; jj < 4; ++jj) {
                    const int row = phys_row(g, dir, 64 * ch + 16 * mt + 4 * gq + jj);
                    OUT[(size_t)row * opitch + 16 * w + (lane & 15)] = bf1(o[jj]);
                }
            }
        }
        state_update(lds, S, w, gq, lane);
        __syncthreads();
        HG_ST_WRITE();
    }
#undef HG_ST_WRITE
}
}

__device__ __forceinline__ void hg_finalize(const Params& p, const bf16_t* U, bf16_t* MIXIN, int blk, int G, int wave, int lane) {
    const float gn0 = p.g_hgrn[2 * lane], gn1 = p.g_hgrn[2 * lane + 1];
    const bf16_t* OB = (const bf16_t*)((const unsigned char*)p.out + hg::DO_OB);
    const int gw = blk * 8 + wave, ngw = G * 8;
    for (int row = gw; row < T_; row += ngw) {
#pragma unroll
        for (int hh = 0; hh < 4; ++hh) {
            unsigned* mp = (unsigned*)(MIXIN + (size_t)row * DM + 512 + hh * 128) + lane;
            const unsigned w = *mp, gw2 = *((const unsigned*)(U + (size_t)row * NIN + UC_GH + hh * 128) + lane);
            const unsigned wb = *((const unsigned*)(OB + (size_t)row * 512 + hh * 128) + lane);
            const float o0 = __uint_as_float(w << 16) + __uint_as_float(wb << 16), o1 = __uint_as_float(w & 0xffff0000u) + __uint_as_float(wb & 0xffff0000u);
            const float g0 = __uint_as_float(gw2 << 16), g1 = __uint_as_float(gw2 & 0xffff0000u);
            const float rs = rsqrtf(wave_sum(o0 * o0 + o1 * o1) * (1.f / 128.f) + EPS);
            *mp = cvt_pk_bf16(o0 * rs * gn0 * silu_f(g0), o1 * rs * gn1 * silu_f(g1));
        }
    }
}

__device__ __forceinline__ void p6_rows(const Params& p, LAS unsigned char* lds, int gw, int ngw, int wave, int lane) {
    bf16_t* WGU = (bf16_t*)(p.ws + WS_WGU); bf16_t* WDN = (bf16_t*)(p.ws + WS_WDN);
    LAS float* scr = (LAS float*)(lds + wave * 16384);
    constexpr int I_G = 16 * 88, I_D = 44 * 32;
    for (int it = gw; it < 2 * I_G + I_D; it += ngw) {
        if (it < I_G) transpose_item(p.w_gate, DFF, 64 * (it / 88), 32 * (it % 88), p.g_pre_ffn, WGU, DM, RowGU{0}, scr, lane);
        else if (it < 2 * I_G) { const int r = it - I_G; transpose_item(p.w_up, DFF, 64 * (r / 88), 32 * (r % 88), p.g_pre_ffn, WGU, DM, RowGU{1}, scr, lane); }
        else { const int r = it - 2 * I_G; transpose_item(p.w_down, DM, 64 * (r / 32), 32 * (r % 32), nullptr, WDN, DFF, RowId{}, scr, lane); }
    }
    bf16_t* MIX = (bf16_t*)(p.ws + WS_MIX); const float* SS = (const float*)(p.ws + WS_SS1);
    f32x4 gp[4];
#pragma unroll
    for (int j = 0; j < 4; ++j) gp[j] = ((const f32x4*)p.g_post_mix)[lane + 64 * j];
    for (int m0 = gw * 4; m0 < T_; m0 += ngw * 4) {
        f32x4 xv[4][4]; u32x2v mw[4][4]; float r1[4];
#pragma unroll
        for (int k = 0; k < 4; ++k) {
            const int m = m0 + k;
            const f32x4* ssp = (const f32x4*)(SS + (size_t)m * 16);
            const f32x4 a = ssp[0], b = ssp[1], c = ssp[2], d = ssp[3];
            const float ss = ((a[0] + a[1]) + (a[2] + a[3])) + ((b[0] + b[1]) + (b[2] + b[3])) + ((c[0] + c[1]) + (c[2] + c[3])) + ((d[0] + d[1]) + (d[2] + d[3]));
            r1[k] = rsqrtf(ss * (1.f / DM) + EPS);
            const f32x4* xr = (const f32x4*)xrow_ptr(p, m) + lane;
            const u32x2v* mx = (const u32x2v*)(MIX + (size_t)m * DM) + lane;
#pragma unroll
            for (int jj = 0; jj < 4; ++jj) { xv[k][jj] = xr[64 * jj]; mw[k][jj] = mx[64 * jj]; }
        }
        float s2[4];
#pragma unroll
        for (int k = 0; k < 4; ++k) {
            f32x4* xo = (f32x4*)(p.out + (size_t)(m0 + k) * DM) + lane;
            s2[k] = 0.f;
#pragma unroll
            for (int jj = 0; jj < 4; ++jj) {
                const u32x2v w = mw[k][jj];
                f32x4 mv = {__uint_as_float(w.x << 16), __uint_as_float(w.x & 0xffff0000u), __uint_as_float(w.y << 16), __uint_as_float(w.y & 0xffff0000u)};
                xv[k][jj] = xv[k][jj] + mv * r1[k] * gp[jj];
                s2[k] += (xv[k][jj][0] * xv[k][jj][0] + xv[k][jj][1] * xv[k][jj][1]) + (xv[k][jj][2] * xv[k][jj][2] + xv[k][jj][3] * xv[k][jj][3]);
                xo[64 * jj] = xv[k][jj];
            }
        }
#pragma unroll
        for (int k = 0; k < 4; ++k) {
            const float r2 = rsqrtf(wave_sum(s2[k]) * (1.f / DM) + EPS);
            u32x2v* mx = (u32x2v*)(MIX + (size_t)(m0 + k) * DM) + lane;
#pragma unroll
            for (int jj = 0; jj < 4; ++jj) { u32x2v w; w.x = cvt_pk_bf16(xv[k][jj][0] * r2, xv[k][jj][1] * r2); w.y = cvt_pk_bf16(xv[k][jj][2] * r2, xv[k][jj][3] * r2); mx[64 * jj] = w; }
        }
    }
}
__device__ __forceinline__ void p9_rows(const Params& p, int gw, int ngw, int lane) {
    const bf16_t* FF = (const bf16_t*)(p.ws + WS_MIX); const float* SS = (const float*)(p.ws + WS_SS2);
    f32x4 gp[4];
#pragma unroll
    for (int j = 0; j < 4; ++j) gp[j] = ((const f32x4*)p.g_post_ffn)[lane + 64 * j];
    for (int m0 = gw * 4; m0 < T_; m0 += ngw * 4) {
        f32x4 xv[4][4]; u32x2v fw[4][4]; float r1[4];
#pragma unroll
        for (int k = 0; k < 4; ++k) {
            const int m = m0 + k;
            const f32x4* ssp = (const f32x4*)(SS + (size_t)m * 16);
            const f32x4 a = ssp[0], b = ssp[1], c = ssp[2], d = ssp[3];
            const float ss = ((a[0] + a[1]) + (a[2] + a[3])) + ((b[0] + b[1]) + (b[2] + b[3])) + ((c[0] + c[1]) + (c[2] + c[3])) + ((d[0] + d[1]) + (d[2] + d[3]));
            r1[k] = rsqrtf(ss * (1.f / DM) + EPS);
            const u32x2v* fx = (const u32x2v*)(FF + (size_t)m * DM) + lane;
            const f32x4* xo = (const f32x4*)(p.out + (size_t)m * DM) + lane;
#pragma unroll
            for (int jj = 0; jj < 4; ++jj) { xv[k][jj] = xo[64 * jj]; fw[k][jj] = fx[64 * jj]; }
        }
#pragma unroll
        for (int k = 0; k < 4; ++k) {
            f32x4* xo = (f32x4*)(p.out + (size_t)(m0 + k) * DM) + lane;
#pragma unroll
            for (int jj = 0; jj < 4; ++jj) {
                const u32x2v w = fw[k][jj];
                f32x4 fv = {__uint_as_float(w.x << 16), __uint_as_float(w.x & 0xffff0000u), __uint_as_float(w.y << 16), __uint_as_float(w.y & 0xffff0000u)};
                xo[64 * jj] = xv[k][jj] + fv * r1[k] * gp[jj];
            }
        }
    }
}

__global__ void __launch_bounds__(512, 2) fwd_megakernel(Params p) {
    extern __shared__ __attribute__((aligned(16))) unsigned char lds_raw[];
    LAS unsigned char* lds = (LAS unsigned char*)lds_raw;
    cg::grid_group grid = cg::this_grid();
#define GSYNC() do { asm volatile("s_waitcnt vmcnt(0)" ::: "memory"); grid.sync(); \
        if (wave == 0) { __builtin_amdgcn_fence(__ATOMIC_ACQUIRE, "agent"); asm volatile("s_waitcnt vmcnt(0)" ::: "memory"); } __syncthreads(); } while (0)
    const int tid = otid(), lane = tid & 63, wave = __builtin_amdgcn_readfirstlane(tid >> 6);
    const int G = gridDim.x, blk = blockIdx.x;
    const int gw = blk * 8 + wave, ngw = G * 8;
    unsigned char* dob = (unsigned char*)p.out;
    bf16_t* U = (bf16_t*)(p.ws + WS_U);
    bf16_t* MIXIN = (bf16_t*)(dob + DO_MIXIN);

    volatile LAS unsigned* bst = (volatile LAS unsigned*)(lds + LDS_BYTES - 16);
    if (tid < 2) bst[tid] = 0u;
    if (blk == 0) for (int i2 = tid; i2 < 3456; i2 += 512) __hip_atomic_store(g_bar + i2, 0u, __ATOMIC_RELAXED, __HIP_MEMORY_SCOPE_AGENT);
    p0_prologue(p, lds, gw, ngw, wave, lane);
    GSYNC();
    const XcdBarrier xbar = xcd_barrier_post(g_bar, bst);
#define XSYNC() xcd_barrier(xbar)
    {
        pg8::Gemm g{(const bf16_t*)(dob + DO_XN), (const bf16_t*)(dob + DO_WIN), T_, NIN, DM}; pg8::StaticOrder S; S.init(T_, NIN, G, blk);
        EpiU E{U, (const float*)(dob + DO_ROPE)};
        pg8::gemm_phase<EpiU, pg8::StaticOrder, true, true>(lds, g, S, E);
    }
    XSYNC();
    for (int lin = blk; lin < hg::NITEM; lin += G) hg::pass1(p, U, lds, hg::item_of(lin, G));
    at::attn_phase(U, MIXIN, lds, blk, G);
    XSYNC();
    hg::scan(p, blk * 512 + tid, G * 512);
    XSYNC();
    for (int lin = blk; lin < hg::NITEM; lin += G) hg::pass2(p, U, MIXIN, lds, hg::item_of(lin, G));
    XSYNC();
    hg_finalize(p, U, MIXIN, blk, G, wave, lane);
    XSYNC();
    {
        pg8::Gemm g{MIXIN, (const bf16_t*)(dob + DO_WOUT), T_, DM, DM}; pg8::StaticOrder S; S.init(T_, DM, G, blk);
        EpiRowSS E{(bf16_t*)(p.ws + WS_MIX), (float*)(p.ws + WS_SS1)};
        pg8::gemm_phase<EpiRowSS, pg8::StaticOrder, true, true>(lds, g, S, E);
    }
    XSYNC();
    p6_rows(p, lds, gw, ngw, wave, lane);
    XSYNC();
    {
        pg8::Gemm g{(const bf16_t*)(p.ws + WS_MIX), (const bf16_t*)(p.ws + WS_WGU), T_, 2 * DFF, DM}; pg8::StaticOrder S; S.init(T_, 2 * DFF, G, blk);
        EpiSwiGLU E{(bf16_t*)(p.ws + WS_HFF)};
        pg8::gemm_phase<EpiSwiGLU, pg8::StaticOrder, true, true>(lds, g, S, E);
    }
    XSYNC();
    {
        pg8::Gemm g{(const bf16_t*)(p.ws + WS_HFF), (const bf16_t*)(p.ws + WS_WDN), T_, DM, DFF}; pg8::StaticOrder S; S.init(T_, DM, G, blk);
        EpiRowSS E{(bf16_t*)(p.ws + WS_MIX), (float*)(p.ws + WS_SS2)};
        pg8::gemm_phase<EpiRowSS, pg8::StaticOrder, true, true>(lds, g, S, E);
    }
    XSYNC();
    p9_rows(p, gw, ngw, lane);
}

extern "C" void kernel_launch(void* const* d_in, const int* in_sizes, int n_in, void* d_out, int out_size, void* d_ws, size_t ws_size, hipStream_t stream) {
    static int grid_blocks = 0;
    if (grid_blocks == 0) {
        int dev = 0, cus = 0, per_cu = 0;
        hipGetDevice(&dev);
        hipDeviceGetAttribute(&cus, hipDeviceAttributeMultiprocessorCount, dev);
        hipFuncSetAttribute((const void*)fwd_megakernel, hipFuncAttributeMaxDynamicSharedMemorySize, LDS_BYTES);
        hipOccupancyMaxActiveBlocksPerMultiprocessor(&per_cu, (const void*)fwd_megakernel, 512, LDS_BYTES);
        if (per_cu < 1) { fprintf(stderr, "occupancy query reports %d blocks per CU\n", per_cu); per_cu = 1; }
        if (per_cu > 1) per_cu = 1;
        grid_blocks = cus * per_cu;
        if (ws_size < 512 * MiB) fprintf(stderr, "kernel_launch: workspace %zu smaller than the 512 MiB map\n", ws_size);
    }
    Params p{};
    p.xp = (const float*)d_in[0]; p.xs = (const float*)d_in[1]; p.w_in = (const float*)d_in[2]; p.w_out = (const float*)d_in[3];
    p.lb_fwd = (const float*)d_in[4]; p.lb_bwd = (const float*)d_in[5]; p.g_hgrn = (const float*)d_in[6]; p.g_pre_mix = (const float*)d_in[7];
    p.g_post_mix = (const float*)d_in[8]; p.g_pre_ffn = (const float*)d_in[9]; p.g_post_ffn = (const float*)d_in[10];
    p.w_gate = (const float*)d_in[11]; p.w_up = (const float*)d_in[12]; p.w_down = (const float*)d_in[13];
    p.out = (float*)d_out; p.ws = (unsigned char*)d_ws;
    void* args[] = {&p};
    hipError_t e = hipLaunchCooperativeKernel((const void*)fwd_megakernel, dim3(grid_blocks), dim3(512), args, LDS_BYTES, stream);
    if (e != hipSuccess) fprintf(stderr, "cooperative launch failed: %s (grid %d)\n", hipGetErrorString(e), grid_blocks);
}
```

```cpp
#include <hip/hip_runtime.h>
#include <hip/hip_cooperative_groups.h>
#include <cstdio>
#include <cstdint>
namespace cg = cooperative_groups;
namespace pg8 {
#define PG8_LAS __attribute__((address_space(3)))
typedef unsigned short bf16_t;
typedef short bf16x8 __attribute__((ext_vector_type(8)));
typedef float f32x4 __attribute__((ext_vector_type(4)));
typedef unsigned u32x4 __attribute__((ext_vector_type(4)));
constexpr int BM = 256, BK = 64, HALF = 128, HTB = HALF * BK * 2  , STAGE_BYTES = 8 * HTB, NXCD = 8, WGM = 8;

__host__ __device__ __forceinline__ int lds_byte(int r, int c) { const int st = (r >> 4) * 2 + (c >> 5), rr = r & 15, cc = c & 31, ob = rr * 64 + cc * 2; return st * 1024 + (ob ^ (((ob >> 9) & 1) << 5)); }
__host__ __device__ __forceinline__ void stage_rc(int b, int& R, int& C) { const int st = b / 1024, sb = b % 1024, swz = sb ^ (((sb >> 9) & 1) << 5); R = (st >> 1) * 16 + swz / 64; C = (st & 1) * 32 + (swz % 64) / 2; }
__host__ __device__ __forceinline__ int perm32(int rho) { const int n = rho >> 4, i = rho & 15; return 8 * (i >> 2) + 4 * n + (i & 3); }

struct Unit { int pm, pn; };
struct Gemm { const bf16_t* A; const bf16_t* Bt; int M, N, K; };

struct StaticOrder {
    int nM, nN, nwg, G, c;
    __host__ __device__ void init(int M, int N, int G_, int c_) { nM = M / BM; nN = N / BM; nwg = nM * nN; G = G_; c = c_; }
    __host__ __device__ bool next(int i, Unit& u) const {
        const long L = (long)i * G + c; if (L >= nwg) return false;
        int wgid = (int)L; { const int q = nwg / NXCD, r = nwg % NXCD, xcd = wgid % NXCD, off = wgid / NXCD; wgid = (xcd < r ? xcd * (q + 1) : r * (q + 1) + (xcd - r) * q) + off; }
        const int nig = WGM * nN, gid = wgid / nig, fm = gid * WGM, gsz = (nM - fm) < WGM ? (nM - fm) : WGM;
        u.pm = fm + ((wgid % nig) % gsz); u.pn = (wgid % nig) / gsz; return true;
    }
    __device__ __forceinline__ void a_ready(const Unit&) const {}
    __device__ __forceinline__ void done(const Unit&) const {}
};

typedef __bf16 bf16x2_t __attribute__((ext_vector_type(2)));
typedef float f32x2_t __attribute__((ext_vector_type(2)));
__device__ __forceinline__ unsigned cvt_pk_bf16(float lo, float hi) { f32x2_t v = {lo, hi}; bf16x2_t b = __builtin_convertvector(v, bf16x2_t); return __builtin_bit_cast(unsigned, b); }
typedef float f32x2 __attribute__((ext_vector_type(2)));
template <class Epi, class Sched, bool ALIGN_EPI = false, bool SP2 = false>
__device__ __forceinline__ void gemm_phase(PG8_LAS unsigned char* lds, const Gemm g, const Sched& S, const Epi& E) {
    const int tid = threadIdx.x, wid = __builtin_amdgcn_readfirstlane(tid >> 6), lane = tid & 63, wr = wid >> 2, wc = wid & 3, fr = lane & 15, fq = lane >> 4;
    const int K = g.K, nt = K / BK;
    unsigned voffA[2], voffB[2];
#pragma unroll
    for (int i = 0; i < 2; ++i) { int R, C; stage_rc(tid * 16 + i * 8192, R, C); const int Rb = Epi::PERM ? ((R & ~31) + perm32(R & 31)) : R;
        voffA[i] = (unsigned)(R * K + C) * 2u; voffB[i] = (unsigned)(Rb * K + C) * 2u; }
    const size_t kstep = (size_t)(BK * 2);
    const size_t hstep = (size_t)HALF * K * 2;
    const size_t tstep = 2 * hstep;
    const unsigned ldsw = (unsigned)wid * 1024u;
    const int aoff = lds_byte(wr * 64 + fr, fq * 8), boff = lds_byte(wc * 32 + fr, fq * 8);
#define PG8_SA(b, h) (((b) * 2 + (h)) * HTB)
#define PG8_SB(b, h) ((4 + (b) * 2 + (h)) * HTB)
#define PG8_STAGE(bufoff, gbase, voff) do { _Pragma("unroll") for (int _i = 0; _i < 2; ++_i) \
        __builtin_amdgcn_global_load_lds((const unsigned*)((const char*)(gbase) + (voff)[_i]), (PG8_LAS unsigned*)(lds + (bufoff) + ldsw + _i * 8192), 16, 0, 0); } while (0)
#define PG8_LDA(dst, b, h) do { _Pragma("unroll") for (int m = 0; m < 4; ++m) _Pragma("unroll") for (int k = 0; k < 2; ++k) dst[m][k] = *(const PG8_LAS bf16x8*)(lds + PG8_SA(b, h) + aoff + m * 2048 + k * 1024); } while (0)
#define PG8_LDB(dst, b, h) do { _Pragma("unroll") for (int n = 0; n < 2; ++n) _Pragma("unroll") for (int k = 0; k < 2; ++k) dst[n][k] = *(const PG8_LAS bf16x8*)(lds + PG8_SB(b, h) + boff + n * 2048 + k * 1024); } while (0)
#define PG8_MMA(ai, bj, At, Bt) do { __builtin_amdgcn_s_setprio(1); _Pragma("unroll") for (int m = 0; m < 4; ++m) _Pragma("unroll") for (int n = 0; n < 2; ++n) _Pragma("unroll") for (int k = 0; k < 2; ++k) \
        acc[ai][bj][m][n] = __builtin_amdgcn_mfma_f32_16x16x32_bf16(Bt[n][k], At[m][k], acc[ai][bj][m][n], 0, 0, 0); __builtin_amdgcn_s_setprio(0); } while (0)
#define PG8_WAIT_V(n) asm volatile("s_waitcnt vmcnt(" #n ")" ::: "memory")
#define PG8_WAIT_L(n) asm volatile("s_waitcnt lgkmcnt(" #n ")" ::: "memory")
#define PG8_BAR __builtin_amdgcn_s_barrier()
#define PG8_SCHED __builtin_amdgcn_sched_barrier(0)
    Unit cur, nxt; int ui = 0;
    if (!S.next(0, cur)) return;
    f32x4 acc[2][2][4][2];
#pragma unroll
    for (int a = 0; a < 2; ++a)
#pragma unroll
        for (int b = 0; b < 2; ++b)
#pragma unroll
            for (int m = 0; m < 4; ++m)
#pragma unroll
                for (int n = 0; n < 2; ++n) acc[a][b][m][n] = (f32x4){0.f, 0.f, 0.f, 0.f};
    bf16x8 At[4][2], B0[2][2], B1[2][2];
    const char* cA = (const char*)g.A + (size_t)cur.pm * tstep; const char* cB = (const char*)g.Bt + (size_t)cur.pn * tstep;
    S.a_ready(cur);
    if constexpr (SP2) {
        PG8_STAGE(PG8_SB(0, 0), cB, voffB); PG8_STAGE(PG8_SB(0, 1), cB + hstep, voffB); PG8_STAGE(PG8_SA(0, 0), cA, voffA); PG8_STAGE(PG8_SA(0, 1), cA + hstep, voffA);
        if (wr == 1) PG8_BAR;
        PG8_WAIT_V(2); PG8_BAR;
        PG8_STAGE(PG8_SB(1, 0), cB + kstep, voffB); PG8_STAGE(PG8_SA(1, 0), cA + kstep, voffA); PG8_STAGE(PG8_SB(1, 1), cB + hstep + kstep, voffB);
        PG8_WAIT_V(6); PG8_BAR;
    } else {
        PG8_STAGE(PG8_SB(0, 0), cB, voffB); PG8_STAGE(PG8_SA(0, 0), cA, voffA); PG8_STAGE(PG8_SB(0, 1), cB + hstep, voffB); PG8_STAGE(PG8_SA(0, 1), cA + hstep, voffA);
        if (wr == 1) PG8_BAR;
        PG8_WAIT_V(4); PG8_BAR;
        PG8_STAGE(PG8_SB(1, 0), cB + kstep, voffB); PG8_STAGE(PG8_SA(1, 0), cA + kstep, voffA); PG8_STAGE(PG8_SB(1, 1), cB + hstep + kstep, voffB);
        PG8_WAIT_V(6); PG8_BAR;
    }
    for (;;) {
        const bool has_next = S.next(ui + 1, nxt);
        const char* nA = has_next ? (const char*)g.A + (size_t)nxt.pm * tstep : cA; const char* nB = has_next ? (const char*)g.Bt + (size_t)nxt.pn * tstep : cB;
        for (int t = 0; t < nt; t += 2) {
            const bool last = (t == nt - 2);
            const char* a1 = cA + (size_t)(t + 1) * kstep;
            const char* a2 = last ? nA : cA + (size_t)(t + 2) * kstep; const char* b2 = last ? nB : cB + (size_t)(t + 2) * kstep;
            const char* a3 = a2 + kstep; const char* b3 = b2 + kstep;
            if (last && has_next) S.a_ready(nxt);
            if constexpr (SP2) {
            PG8_LDB(B0, 0, 0); PG8_LDB(B1, 0, 1); PG8_SCHED; PG8_LDA(At, 0, 0); PG8_STAGE(PG8_SA(1, 1), a1 + hstep, voffA);
            PG8_WAIT_V(8); PG8_WAIT_L(0); PG8_BAR; PG8_MMA(0, 0, At, B0); PG8_MMA(0, 1, At, B1); PG8_BAR; PG8_SCHED;
            PG8_LDA(At, 0, 1); PG8_STAGE(PG8_SB(0, 0), b2, voffB); PG8_STAGE(PG8_SB(0, 1), b2 + hstep, voffB); PG8_STAGE(PG8_SA(0, 0), a2, voffA);
            PG8_WAIT_V(8); PG8_WAIT_L(0); PG8_BAR; PG8_MMA(1, 0, At, B0); PG8_MMA(1, 1, At, B1); PG8_BAR; PG8_SCHED;
            PG8_LDB(B0, 1, 0); PG8_LDB(B1, 1, 1); PG8_SCHED; PG8_LDA(At, 1, 0); PG8_STAGE(PG8_SA(0, 1), a2 + hstep, voffA);
            PG8_WAIT_V(8); PG8_WAIT_L(0); PG8_BAR; PG8_MMA(0, 0, At, B0); PG8_MMA(0, 1, At, B1); PG8_BAR; PG8_SCHED;
            PG8_LDA(At, 1, 1); PG8_STAGE(PG8_SB(1, 0), b3, voffB); PG8_STAGE(PG8_SB(1, 1), b3 + hstep, voffB); PG8_STAGE(PG8_SA(1, 0), a3, voffA);
            PG8_WAIT_V(8); PG8_WAIT_L(0); PG8_BAR; PG8_MMA(1, 0, At, B0); PG8_MMA(1, 1, At, B1); PG8_BAR; PG8_SCHED;
            } else {
            PG8_LDB(B0, 0, 0); PG8_SCHED; PG8_LDA(At, 0, 0); PG8_STAGE(PG8_SA(1, 1), a1 + hstep, voffA);
            PG8_WAIT_L(8); PG8_BAR; PG8_WAIT_L(0); PG8_MMA(0, 0, At, B0); PG8_BAR; PG8_SCHED;
            PG8_LDB(B1, 0, 1); PG8_STAGE(PG8_SB(0, 0), b2, voffB);
            PG8_BAR; PG8_WAIT_L(0); PG8_MMA(0, 1, At, B1); PG8_BAR;
            PG8_LDA(At, 0, 1); PG8_STAGE(PG8_SA(0, 0), a2, voffA);
            PG8_BAR; PG8_WAIT_L(0); PG8_MMA(1, 0, At, B0); PG8_BAR; PG8_SCHED;
            PG8_STAGE(PG8_SB(0, 1), b2 + hstep, voffB);
            PG8_WAIT_V(6); PG8_BAR; PG8_MMA(1, 1, At, B1); PG8_BAR;
            PG8_LDB(B0, 1, 0); PG8_SCHED; PG8_LDA(At, 1, 0); PG8_STAGE(PG8_SA(0, 1), a2 + hstep, voffA);
            PG8_WAIT_L(8); PG8_BAR; PG8_WAIT_L(0); PG8_MMA(0, 0, At, B0); PG8_BAR; PG8_SCHED;
            PG8_LDB(B1, 1, 1); PG8_STAGE(PG8_SB(1, 0), b3, voffB);
            PG8_BAR; PG8_WAIT_L(0); PG8_MMA(0, 1, At, B1); PG8_BAR;
            PG8_LDA(At, 1, 1); PG8_STAGE(PG8_SA(1, 0), a3, voffA);
            PG8_BAR; PG8_WAIT_L(0); PG8_MMA(1, 0, At, B0); PG8_BAR; PG8_SCHED;
            PG8_STAGE(PG8_SB(1, 1), b3 + hstep, voffB);
            PG8_WAIT_V(6); PG8_BAR; PG8_MMA(1, 1, At, B1); PG8_BAR;
            }
        }
        if constexpr (ALIGN_EPI) { if (wr == 0) PG8_BAR; }
        if constexpr (!Epi::AFTER_DRAIN) { E(acc, cur, wr, wc, fr, fq); S.done(cur); }
        if (!has_next) break;
#pragma unroll
        for (int a = 0; a < 2; ++a)
#pragma unroll
            for (int b = 0; b < 2; ++b)
#pragma unroll
                for (int m = 0; m < 4; ++m)
#pragma unroll
                    for (int n = 0; n < 2; ++n) acc[a][b][m][n] = (f32x4){0.f, 0.f, 0.f, 0.f};
        cur = nxt; cA = nA; cB = nB; ++ui;
        if constexpr (ALIGN_EPI) { if (wr == 1) PG8_BAR; }
    }
    PG8_WAIT_V(0);
    if constexpr (!ALIGN_EPI) { if (wr == 0) PG8_BAR; }
    PG8_BAR;
    if constexpr (Epi::AFTER_DRAIN) { E.fused(acc, cur, wr, wc, fr, fq, lds, wid, lane); S.done(cur); }
#undef PG8_SA
#undef PG8_SB
#undef PG8_STAGE
#undef PG8_LDA
#undef PG8_LDB
#undef PG8_MMA
#undef PG8_WAIT_V
#undef PG8_WAIT_L
#undef PG8_BAR
#undef PG8_SCHED
}
}

#define LAS __attribute__((address_space(3)))
typedef unsigned short bf16_t;
using pg8::f32x4; using pg8::u32x4; using pg8::Unit; using pg8::cvt_pk_bf16;
typedef float f32x2v __attribute__((ext_vector_type(2)));
typedef unsigned u32x2v __attribute__((ext_vector_type(2)));

constexpr int T_ = 65536, DM = 1024, NIN = 4096, DFF = 2816, ROWS_P = 32768;
constexpr size_t MiB = 1u << 20;
constexpr float EPS = 1e-6f;
constexpr int LDS_BYTES = 147456;
constexpr size_t DO_XN = 0, DO_MIXIN = 0, DO_WIN = 128 * MiB, DO_ROPE = 136 * MiB, DO_WOUT = 137 * MiB;
constexpr size_t WS_U = 0;
constexpr size_t WS_MIX = 0;
constexpr size_t WS_WGU = 128 * MiB, WS_WDN = 139 * MiB, WS_SS1 = 145 * MiB, WS_SS2 = 149 * MiB, WS_HFF = 160 * MiB;
constexpr int UC_QA = 0, UC_KA = 512, UC_VA = 1024, UC_QH = 1536, UC_ZF = 2048, UC_ZB = 2560, UC_IH = 3072, UC_GH = 3584;

__device__ __forceinline__ float bf2f(unsigned short h) { return __uint_as_float((unsigned)h << 16); }
__device__ __forceinline__ unsigned short f2bf(float f) { unsigned u = __float_as_uint(f); return (unsigned short)((u + 0x7fffu + ((u >> 16) & 1u)) >> 16); }
__device__ __forceinline__ unsigned pk2(float lo, float hi) { return (unsigned)f2bf(lo) | ((unsigned)f2bf(hi) << 16); }
__device__ __forceinline__ float silu_f(float x) { return x * __builtin_amdgcn_rcpf(1.f + __expf(-x)); }
__device__ __forceinline__ float sigmoid_f(float x) { return __builtin_amdgcn_rcpf(1.f + __expf(-x)); }
__device__ __forceinline__ int row_pos(int row) { return row < ROWS_P ? (row & 16383) : (row & 4095); }
__device__ __forceinline__ int row_S(int row) { return row < ROWS_P ? 16384 : 4096; }
__device__ __forceinline__ float wave_sum(float v) {
#pragma unroll
    for (int o = 1; o < 64; o <<= 1) v += __shfl_xor(v, o);
    return v;
}
__device__ __forceinline__ float wave_max(float v) {
#pragma unroll
    for (int o = 1; o < 64; o <<= 1) v = fmaxf(v, __shfl_xor(v, o));
    return v;
}
#define LDS_WAIT() asm volatile("s_waitcnt lgkmcnt(0)" ::: "memory")
__device__ __forceinline__ int otid() { int t; asm volatile("v_mov_b32 %0, %1" : "=v"(t) : "v"((int)threadIdx.x)); return t; }


__device__ unsigned g_bar[3456];
struct XcdBarrier { unsigned* bar; unsigned x; volatile LAS unsigned* st; };
#define XB_TMO      128
#define XB_XCNT(j)  (256  + 64 * (j))
#define XB_XSUB(j)  (1280 + 64 * (j))
#define XB_XGEN(j)  (2304 + 64 * (j))
#define XB_TOP      3328
#define XB_TOPGEN   3392
#define XCD_BAR_WORDS 3456
#define XB_SPIN_CAP (1u << 18)

__device__ __forceinline__ unsigned xb_ld(unsigned* p)              { return __hip_atomic_load(p, __ATOMIC_RELAXED, __HIP_MEMORY_SCOPE_AGENT); }
__device__ __forceinline__ unsigned xb_add(unsigned* p, unsigned v) { return __hip_atomic_fetch_add(p, v, __ATOMIC_RELAXED, __HIP_MEMORY_SCOPE_AGENT); }
__device__ __forceinline__ unsigned xb_xcc_id() { return (unsigned)__builtin_amdgcn_s_getreg((3 << 11) | 20) & 0xFu; }
#define XB_SPIN(cond, bar) do { unsigned _sp = 0; while (cond) { __builtin_amdgcn_s_sleep(1); \
    if ((++_sp & 255u) == 0u) { if (xb_ld(&(bar)[XB_TMO])) break; if (_sp > XB_SPIN_CAP) { atomicAdd(&(bar)[XB_TMO], 1u); break; } } } } while (0)
__device__ __forceinline__ XcdBarrier xcd_barrier_post(unsigned* bar, volatile LAS unsigned* st) {
    XcdBarrier b; b.bar = bar; b.x = xb_xcc_id(); b.st = st;
    if (threadIdx.x == 0) (void)xb_add(&bar[XB_XCNT(b.x)], 1u);
    return b;
}
__device__ __forceinline__ void xcd_barrier_complete(unsigned* bar, unsigned x, unsigned& nloc, unsigned& nx) {
    const unsigned G = gridDim.x * gridDim.y * gridDim.z;
    unsigned sum, cnt, mine, sp = 0u;
    for (;;) {
        sum = 0u; cnt = 0u; mine = 0u;
#pragma unroll
        for (unsigned j = 0; j < 16; ++j) { const unsigned c = xb_ld(&bar[XB_XCNT(j)]); sum += c; cnt += (c > 0u) ? 1u : 0u; mine = (j == x) ? c : mine; }
        if (sum == G) break;
        __builtin_amdgcn_s_sleep(1);
        if ((++sp & 255u) == 0u) { if (xb_ld(&bar[XB_TMO])) break; if (sp > XB_SPIN_CAP) { atomicAdd(&bar[XB_TMO], 1u); break; } }
    }
    nloc = mine > 0u ? mine : 1u; nx = cnt > 0u ? cnt : 1u;
}

__device__ __forceinline__ void xcd_barrier(const XcdBarrier& b) {
    asm volatile("s_waitcnt vmcnt(0)" ::: "memory");
    __syncthreads();
    if (threadIdx.x == 0) {
        unsigned* bar = b.bar;
        __builtin_amdgcn_s_waitcnt(0);
        unsigned nloc = b.st[0], nx = b.st[1];
        if (nloc == 0u) { xcd_barrier_complete(bar, b.x, nloc, nx); b.st[0] = nloc; b.st[1] = nx; }
        const unsigned old = xb_add(&bar[XB_XSUB(b.x)], 1u);
        const unsigned gen = old / nloc;
        if (old + 1u == (gen + 1u) * nloc) {
            __builtin_amdgcn_fence(__ATOMIC_RELEASE, "agent");
            asm volatile("s_waitcnt vmcnt(0)" ::: "memory");
            const unsigned og = xb_add(&bar[XB_TOP], 1u);
            const unsigned tg = og / nx;
            if (og + 1u == (tg + 1u) * nx) xb_add(&bar[XB_TOPGEN], 1u);
            else XB_SPIN(xb_ld(&bar[XB_TOPGEN]) == tg, bar);
            __builtin_amdgcn_fence(__ATOMIC_ACQUIRE, "agent");
            xb_add(&bar[XB_XGEN(b.x)], 1u);
            asm volatile("s_waitcnt vmcnt(0)" ::: "memory");
        } else {
            XB_SPIN(xb_ld(&bar[XB_XGEN(b.x)]) == gen, bar);
            __builtin_amdgcn_fence(__ATOMIC_ACQUIRE, "agent");
            asm volatile("s_waitcnt vmcnt(0)" ::: "memory");
        }
    }
    __syncthreads();
}

struct EpiU {
    static constexpr bool PERM = true, AFTER_DRAIN = false;
    bf16_t* U; const float* rope;
    __device__ __forceinline__ void operator()(const f32x4 (&acc)[2][2][4][2], const Unit& u, int wr, int wc, int fr, int fq) const {
        const int row0 = u.pm * 256 + wr * 64 + fr, col0 = u.pn * 256 + wc * 32 + 8 * fq;
        const bool rope_tile = (u.pn < 4) && ((wc & 1) == 0);
        const float sc = (u.pn < 2) ? 0.125f : 1.0f;
        const float sgn = (fq == 0) ? -1.f : 1.f;
#pragma unroll
        for (int ai = 0; ai < 2; ++ai)
#pragma unroll
            for (int m = 0; m < 4; ++m) {
                const int row = row0 + ai * 128 + m * 16;
                bf16_t* rowp = U + (size_t)row * NIN + col0;
                f32x4 r0 = {1.f, 0.f, 1.f, 0.f}, r1 = r0, r2 = r0, r3 = r0;
                if (rope_tile) { const f32x4* rp = (const f32x4*)(rope + (size_t)row_pos(row) * 16); r0 = rp[0]; r1 = rp[1]; r2 = rp[2]; r3 = rp[3]; }
#pragma unroll
                for (int bj = 0; bj < 2; ++bj) {
                    f32x4 v0 = acc[ai][bj][m][0], v1 = acc[ai][bj][m][1];
                    if (rope_tile) {
                        f32x4 p0, p1;
#pragma unroll
                        for (int j = 0; j < 4; ++j) { p0[j] = __shfl_xor(v0[j], 16); p1[j] = __shfl_xor(v1[j], 16); }
                        if (fq < 2) {
                            v0[0] = v0[0] * r0[0] + sgn * p0[0] * r0[1]; v0[1] = v0[1] * r0[2] + sgn * p0[1] * r0[3];
                            v0[2] = v0[2] * r1[0] + sgn * p0[2] * r1[1]; v0[3] = v0[3] * r1[2] + sgn * p0[3] * r1[3];
                            v1[0] = v1[0] * r2[0] + sgn * p1[0] * r2[1]; v1[1] = v1[1] * r2[2] + sgn * p1[1] * r2[3];
                            v1[2] = v1[2] * r3[0] + sgn * p1[2] * r3[1]; v1[3] = v1[3] * r3[2] + sgn * p1[3] * r3[3];
                        }
                    }
                    v0 = v0 * sc; v1 = v1 * sc;
                    u32x4 w; w.x = cvt_pk_bf16(v0[0], v0[1]); w.y = cvt_pk_bf16(v0[2], v0[3]); w.z = cvt_pk_bf16(v1[0], v1[1]); w.w = cvt_pk_bf16(v1[2], v1[3]);
                    *(u32x4*)(rowp + bj * 128) = w;
                }
            }
    }
};
struct EpiRowSS {
    static constexpr bool PERM = true, AFTER_DRAIN = false;
    bf16_t* O; float* SS;
    __device__ __forceinline__ void operator()(const f32x4 (&acc)[2][2][4][2], const Unit& u, int wr, int wc, int fr, int fq) const {
        const int row0 = u.pm * 256 + wr * 64 + fr, col0 = u.pn * 256 + wc * 32 + 8 * fq;
#pragma unroll
        for (int ai = 0; ai < 2; ++ai)
#pragma unroll
            for (int m = 0; m < 4; ++m) {
                const int row = row0 + ai * 128 + m * 16;
                bf16_t* rowp = O + (size_t)row * DM + col0;
                float s = 0.f;
#pragma unroll
                for (int bj = 0; bj < 2; ++bj) {
                    const f32x4 v0 = acc[ai][bj][m][0], v1 = acc[ai][bj][m][1];
                    s += (v0[0] * v0[0] + v0[1] * v0[1]) + (v0[2] * v0[2] + v0[3] * v0[3]) + (v1[0] * v1[0] + v1[1] * v1[1]) + (v1[2] * v1[2] + v1[3] * v1[3]);
                    u32x4 w; w.x = cvt_pk_bf16(v0[0], v0[1]); w.y = cvt_pk_bf16(v0[2], v0[3]); w.z = cvt_pk_bf16(v1[0], v1[1]); w.w = cvt_pk_bf16(v1[2], v1[3]);
                    *(u32x4*)(rowp + bj * 128) = w;
                }
                s += __shfl_xor(s, 16); s += __shfl_xor(s, 32);
                if (fq == 0) SS[(size_t)row * 16 + u.pn * 4 + wc] = s;
            }
    }
};
struct EpiSwiGLU {
    static constexpr bool PERM = true, AFTER_DRAIN = false;
    bf16_t* H;
    __device__ __forceinline__ void operator()(const f32x4 (&acc)[2][2][4][2], const Unit& u, int wr, int wc, int fr, int fq) const {
        const int row0 = u.pm * 256 + wr * 64 + fr, col0 = u.pn * 128 + wc * 32 + 8 * fq;
#pragma unroll
        for (int ai = 0; ai < 2; ++ai)
#pragma unroll
            for (int m = 0; m < 4; ++m) {
                const int row = row0 + ai * 128 + m * 16;
                const f32x4 g0 = acc[ai][0][m][0], g1 = acc[ai][0][m][1], u0 = acc[ai][1][m][0], u1 = acc[ai][1][m][1];
                f32x4 h0, h1;
#pragma unroll
                for (int j = 0; j < 4; ++j) { h0[j] = silu_f(g0[j]) * u0[j]; h1[j] = silu_f(g1[j]) * u1[j]; }
                u32x4 w; w.x = cvt_pk_bf16(h0[0], h0[1]); w.y = cvt_pk_bf16(h0[2], h0[3]); w.z = cvt_pk_bf16(h1[0], h1[1]); w.w = cvt_pk_bf16(h1[2], h1[3]);
                *(u32x4*)(H + (size_t)row * DFF + col0) = w;
            }
    }
};

template <class RowMap>
__device__ __forceinline__ void transpose_item(const float* W, int N, int k0, int n0, const float* kscale, bf16_t* WT, int K, RowMap rowmap, LAS float* scr, int lane) {
#pragma unroll 8
    for (int i = 0; i < 32; ++i) { const int kk = 2 * i + (lane >> 5); float w = W[(size_t)(k0 + kk) * N + n0 + (lane & 31)]; if (kscale) w *= kscale[k0 + kk]; scr[kk * 33 + (lane & 31)] = w; }
    LDS_WAIT();
    const int c = lane & 7;
#pragma unroll
    for (int j = 0; j < 4; ++j) { const int n = (lane >> 3) + 8 * j; const LAS float* s = scr + (8 * c) * 33 + n;
        u32x4 o; o.x = pk2(s[0 * 33], s[1 * 33]); o.y = pk2(s[2 * 33], s[3 * 33]); o.z = pk2(s[4 * 33], s[5 * 33]); o.w = pk2(s[6 * 33], s[7 * 33]);
        *(u32x4*)(WT + (size_t)rowmap(n0 + n) * K + k0 + 8 * c) = o; }
    LDS_WAIT();
}
struct RowId { __device__ __forceinline__ int operator()(int n) const { return n; } };
struct RowGU { int half; __device__ __forceinline__ int operator()(int n) const { return (n >> 7) * 256 + half * 128 + (n & 127); } };

struct Params {
    const float* xp; const float* xs; const float* w_in; const float* w_out; const float* lb_fwd; const float* lb_bwd; const float* g_hgrn;
    const float* g_pre_mix; const float* g_post_mix; const float* g_pre_ffn; const float* g_post_ffn; const float* w_gate; const float* w_up; const float* w_down;
    float* out; unsigned char* ws;
};
__device__ __forceinline__ const float* xrow_ptr(const Params& p, int row) { return row < ROWS_P ? p.xp + (size_t)row * DM : p.xs + (size_t)(row - ROWS_P) * DM; }

__device__ __forceinline__ void p0_prologue(const Params& p, LAS unsigned char* lds, int gw, int ngw, int wave, int lane) {
    unsigned char* dob = (unsigned char*)p.out;
    bf16_t* WIN = (bf16_t*)(dob + DO_WIN); bf16_t* WOUT = (bf16_t*)(dob + DO_WOUT); float* rope = (float*)(dob + DO_ROPE); bf16_t* XN = (bf16_t*)(dob + DO_XN);
    LAS float* scr = (LAS float*)(lds + wave * 16384);
    constexpr int I_IN = 16 * 128, I_OUT = 16 * 32;
    for (int it = gw; it < I_IN + I_OUT; it += ngw) {
        if (it < I_IN) transpose_item(p.w_in, NIN, 64 * (it / 128), 32 * (it % 128), p.g_pre_mix, WIN, DM, RowId{}, scr, lane);
        else { const int r = it - I_IN; transpose_item(p.w_out, DM, 64 * (r / 32), 32 * (r % 32), nullptr, WOUT, DM, RowId{}, scr, lane); }
    }
    {
        const int gt = gw * 64 + lane, ngt = ngw * 64;
        for (int e = gt; e < 16384 * 8; e += ngt) {
            const int pos = e >> 3, i = e & 7;
            const double rv = i == 0 ? 0.15915494309189535 : i == 1 ? 0.03086376340470123 : i == 2 ? 0.005985185712713705 : i == 3 ? 0.001160663641240061
                            : i == 4 ? 0.00022507907903927653 : i == 5 ? 4.364795279280289e-05 : i == 6 ? 8.464330808241401e-06 : 1.6414262627950345e-06;
            double a = (double)pos * rv; a -= floor(a);
            const float af = (float)a;
            rope[2 * e] = __builtin_amdgcn_cosf(af); rope[2 * e + 1] = __builtin_amdgcn_sinf(af);
        }
    }
    for (int m0 = gw * 4; m0 < T_; m0 += ngw * 4) {
        f32x4 v[4][4]; float s[4];
#pragma unroll
        for (int k = 0; k < 4; ++k) { const f32x4* xr = (const f32x4*)xrow_ptr(p, m0 + k) + lane;
#pragma unroll
            for (int j = 0; j < 4; ++j) v[k][j] = xr[64 * j]; }
#pragma unroll
        for (int k = 0; k < 4; ++k) { s[k] = 0.f;
#pragma unroll
            for (int j = 0; j < 4; ++j) s[k] += (v[k][j][0] * v[k][j][0] + v[k][j][1] * v[k][j][1]) + (v[k][j][2] * v[k][j][2] + v[k][j][3] * v[k][j][3]); }
#pragma unroll
        for (int k = 0; k < 4; ++k) {
            const float rstd = rsqrtf(wave_sum(s[k]) * (1.f / DM) + EPS);
            u32x2v* o8 = (u32x2v*)(XN + (size_t)(m0 + k) * DM) + lane;
#pragma unroll
            for (int j = 0; j < 4; ++j) { u32x2v w; w.x = cvt_pk_bf16(v[k][j][0] * rstd, v[k][j][1] * rstd); w.y = cvt_pk_bf16(v[k][j][2] * rstd, v[k][j][3] * rstd); o8[64 * j] = w; }
        }
    }
}

__device__ __forceinline__ void attn_simple(const bf16_t* U, bf16_t* MIXIN, int gw, int ngw, int lane) {
    for (int item = gw; item < T_ * 8; item += ngw) {
        const int row = item >> 3, h = item & 7;
        const int pos = row_pos(row), S = row_S(row), base = row - pos;
        float q[64];
        { const u32x4* qp = (const u32x4*)(U + (size_t)row * NIN + UC_QA + h * 64);
#pragma unroll
          for (int c = 0; c < 8; ++c) { const u32x4 w = qp[c];
              q[8 * c + 0] = __uint_as_float(w.x << 16); q[8 * c + 1] = __uint_as_float(w.x & 0xffff0000u);
              q[8 * c + 2] = __uint_as_float(w.y << 16); q[8 * c + 3] = __uint_as_float(w.y & 0xffff0000u);
              q[8 * c + 4] = __uint_as_float(w.z << 16); q[8 * c + 5] = __uint_as_float(w.z & 0xffff0000u);
              q[8 * c + 6] = __uint_as_float(w.w << 16); q[8 * c + 7] = __uint_as_float(w.w & 0xffff0000u); } }
        float s[9];
#pragma unroll
        for (int b = 0; b < 3; ++b)
#pragma unroll
            for (int r = 0; r < 3; ++r) {
                const int dil = 1 << (2 * b), j = -64 + 64 * r + lane, kp = pos + j * dil;
                const bool valid = (r < 2 || lane == 0) && kp >= 0 && kp < S;
                float d = -1e30f;
                if (valid) {
                    const u32x4* kq = (const u32x4*)(U + (size_t)(base + kp) * NIN + UC_KA + h * 64);
                    float a = 0.f;
#pragma unroll
                    for (int c = 0; c < 8; ++c) { const u32x4 w = kq[c];
                        a += q[8 * c + 0] * __uint_as_float(w.x << 16) + q[8 * c + 1] * __uint_as_float(w.x & 0xffff0000u)
                           + q[8 * c + 2] * __uint_as_float(w.y << 16) + q[8 * c + 3] * __uint_as_float(w.y & 0xffff0000u)
                           + q[8 * c + 4] * __uint_as_float(w.z << 16) + q[8 * c + 5] * __uint_as_float(w.z & 0xffff0000u)
                           + q[8 * c + 6] * __uint_as_float(w.w << 16) + q[8 * c + 7] * __uint_as_float(w.w & 0xffff0000u); }
                    d = a;
                }
                s[b * 3 + r] = d;
            }
        float mx = s[0];
#pragma unroll
        for (int i = 1; i < 9; ++i) mx = fmaxf(mx, s[i]);
        mx = wave_max(mx);
        float l = 0.f;
#pragma unroll
        for (int i = 0; i < 9; ++i) { s[i] = __expf(s[i] - mx); l += s[i]; }
        l = wave_sum(l);
        float o = 0.f;
        const bf16_t* vbase = U + UC_VA + h * 64 + lane;
#pragma unroll
        for (int b = 0; b < 3; ++b)
#pragma unroll
            for (int r = 0; r < 3; ++r) {
                const int dil = 1 << (2 * b), cnt = (r < 2) ? 64 : 1;
                for (int jj = 0; jj < cnt; ++jj) {
                    const float pj = __shfl(s[b * 3 + r], jj);
                    const int kp = pos + (-64 + 64 * r + jj) * dil;
                    if (kp >= 0 && kp < S) o += pj * bf2f(vbase[(size_t)(base + kp) * NIN]);
                }
            }
        MIXIN[(size_t)row * DM + h * 64 + lane] = f2bf(o / l);
    }
}

namespace at {
typedef short bf16x8 __attribute__((ext_vector_type(8)));
typedef short s16x4 __attribute__((ext_vector_type(4)));
constexpr int OS = 65;
constexpr int L_OUT = 0, L_L = 256 * OS * 4, L_VS = L_L + 1024, VS_STRIDE = 144, VS_WAVE = 32 * VS_STRIDE, L_END = L_VS + 8 * VS_WAVE;
static_assert(L_END <= LDS_BYTES, "attention LDS map");

__device__ __forceinline__ void wave_tile(const bf16_t* U, LAS unsigned char* lds, int w, int lane, int base, int S, int P0, int h, int idx) {
    const int n = lane & 15, quad = lane >> 4;
    const int br = idx >> 4, sub = idx & 15;
    const int dsh = 2 * br, dil = 1 << dsh;
    const int r = br == 0 ? 0 : (br == 1 ? (sub & 3) : sub);
    const int mt = br == 0 ? sub : (br == 1 ? (sub >> 2) : 0);
    const int Lsub = S >> dsh, m0 = (P0 >> dsh) + 16 * mt;
    const bf16_t* Ub = U + (size_t)base * NIN + h * 64;
    bf16x8 qf[2];
    { const bf16_t* qp = Ub + (size_t)((m0 + n) * dil + r) * NIN + UC_QA + 8 * quad; qf[0] = *(const bf16x8*)qp; qf[1] = *(const bf16x8*)(qp + 32); }
    bf16x8 kf[9][2];
#pragma unroll
    for (int kt = 0; kt < 9; ++kt) {
        int mk = m0 - 64 + 16 * kt + n; mk = mk < 0 ? 0 : (mk >= Lsub ? Lsub - 1 : mk);
        const bf16_t* kp = Ub + (size_t)(mk * dil + r) * NIN + UC_KA + 8 * quad; kf[kt][0] = *(const bf16x8*)kp; kf[kt][1] = *(const bf16x8*)(kp + 32);
    }
    u32x4 vr[5][4];
#pragma unroll
    for (int t = 0; t < 5; ++t)
#pragma unroll
        for (int e = 0; e < 4; ++e) {
            const int id = lane + 64 * e, rho = id >> 3, ch = id & 7;
            int mk = m0 - 64 + 32 * t + rho; mk = mk < 0 ? 0 : (mk >= Lsub ? Lsub - 1 : mk);
            vr[t][e] = *(const u32x4*)(Ub + (size_t)(mk * dil + r) * NIN + UC_VA + 8 * ch);
        }
    unsigned pk[10][2];
    float lsum = 0.f;
#pragma unroll
    for (int kt = 0; kt < 9; ++kt) {
        f32x4 sc = {0.f, 0.f, 0.f, 0.f};
        sc = __builtin_amdgcn_mfma_f32_16x16x32_bf16(kf[kt][0], qf[0], sc, 0, 0, 0);
        sc = __builtin_amdgcn_mfma_f32_16x16x32_bf16(kf[kt][1], qf[1], sc, 0, 0, 0);
        float pv[4];
#pragma unroll
        for (int j = 0; j < 4; ++j) {
            const int ko = 16 * kt + 4 * quad + j, mk = m0 - 64 + ko;
            const bool valid = (ko >= n) && (ko <= n + 128) && (mk >= 0) && (mk < Lsub);
            const float e = __expf(fminf(sc[j], 80.f));
            pv[j] = valid ? e : 0.f; lsum += pv[j];
        }
        pk[kt][0] = cvt_pk_bf16(pv[0], pv[1]); pk[kt][1] = cvt_pk_bf16(pv[2], pv[3]);
    }
    pk[9][0] = 0u; pk[9][1] = 0u;
    lsum += __shfl_xor(lsum, 16); lsum += __shfl_xor(lsum, 32);
    f32x4 ot[4];
#pragma unroll
    for (int dt = 0; dt < 4; ++dt) ot[dt] = (f32x4){0.f, 0.f, 0.f, 0.f};
    LAS unsigned char* vs = lds + L_VS + w * VS_WAVE;
#pragma unroll
    for (int t = 0; t < 5; ++t) {
#pragma unroll
        for (int e = 0; e < 4; ++e) { const int id = lane + 64 * e, rho = id >> 3, ch = id & 7; *(LAS u32x4*)(vs + rho * VS_STRIDE + ch * 16) = vr[t][e]; }
        bf16x8 pf; { u32x4 pw = {pk[2 * t][0], pk[2 * t][1], pk[2 * t + 1][0], pk[2 * t + 1][1]}; pf = __builtin_bit_cast(bf16x8, pw); }
#pragma unroll
        for (int dt = 0; dt < 4; ++dt) {
            const int q = (lane & 15) >> 2, pp = lane & 3;
            const s16x4 lo = __builtin_amdgcn_ds_read_tr16_b64_v4i16((LAS s16x4*)(vs + (4 * quad + q) * VS_STRIDE + (16 * dt + 4 * pp) * 2));
            const s16x4 hi = __builtin_amdgcn_ds_read_tr16_b64_v4i16((LAS s16x4*)(vs + (16 + 4 * quad + q) * VS_STRIDE + (16 * dt + 4 * pp) * 2));
            const bf16x8 vf = {lo[0], lo[1], lo[2], lo[3], hi[0], hi[1], hi[2], hi[3]};
            ot[dt] = __builtin_amdgcn_mfma_f32_16x16x32_bf16(vf, pf, ot[dt], 0, 0, 0);
        }
    }
    const int posl = ((m0 + n) * dil + r) - P0;
    LAS float* op = (LAS float*)(lds + L_OUT) + posl * OS + 4 * quad;
    LAS float* lp = (LAS float*)(lds + L_L) + posl;
    if (br == 0) {
#pragma unroll
        for (int dt = 0; dt < 4; ++dt)
#pragma unroll
            for (int j = 0; j < 4; ++j) op[16 * dt + j] = ot[dt][j];
        if (quad == 0) *lp = lsum;
    } else {
        float old[16];
#pragma unroll
        for (int dt = 0; dt < 4; ++dt)
#pragma unroll
            for (int j = 0; j < 4; ++j) old[4 * dt + j] = op[16 * dt + j];
        const float lo = *lp;
#pragma unroll
        for (int dt = 0; dt < 4; ++dt)
#pragma unroll
            for (int j = 0; j < 4; ++j) op[16 * dt + j] = old[4 * dt + j] + ot[dt][j];
        if (quad == 0) *lp = lo + lsum;
    }
}

__device__ __forceinline__ void attn_phase(const bf16_t* U, bf16_t* MIXIN, LAS unsigned char* lds, int blk, int G) {
    const int tid = otid(), lane = tid & 63, w = __builtin_amdgcn_readfirstlane(tid >> 6);
    __syncthreads();
    for (int u = blk; u < 2048; u += G) {
        int grp = u >> 3, h = u & 7;
        if (G == 256) { const int x = u & 7, j = (u >> 3) & 31, e8 = u >> 8; h = j & 7; grp = 32 * x + 4 * e8 + (j >> 3); }
        const int row0 = grp * 256;
        const int base = row0 < ROWS_P ? (row0 & ~16383) : (ROWS_P + ((row0 - ROWS_P) & ~4095)), S = row0 < ROWS_P ? 16384 : 4096, P0 = row0 - base;
        for (int br = 0; br < 3; ++br) {
            wave_tile(U, lds, w, lane, base, S, P0, h, 16 * br + w);
            wave_tile(U, lds, w, lane, base, S, P0, h, 16 * br + w + 8);
            __syncthreads();
        }
        {
            const int pos = tid >> 1, half = tid & 1;
            const LAS float* op = (const LAS float*)(lds + L_OUT) + pos * OS + 32 * half;
            const float inv = 1.f / ((const LAS float*)(lds + L_L))[pos];
            unsigned wv[16];
#pragma unroll
            for (int d = 0; d < 16; ++d) wv[d] = cvt_pk_bf16(op[2 * d] * inv, op[2 * d + 1] * inv);
            u32x4* gp = (u32x4*)(MIXIN + (size_t)(row0 + pos) * DM + h * 64 + 32 * half);
#pragma unroll
            for (int c = 0; c < 4; ++c) gp[c] = (u32x4){wv[4 * c], wv[4 * c + 1], wv[4 * c + 2], wv[4 * c + 3]};
        }
        __syncthreads();
    }
}
}

__device__ __forceinline__ void hgrn_simple(const Params& p, const bf16_t* U, bf16_t* MIXIN, LAS unsigned char* lds, int blk, int nblk) {
    LAS f32x2v* fqb = (LAS f32x2v*)lds;
    LAS float* po = (LAS float*)(lds + 2048);
    const int tid = threadIdx.x, vcol = tid & 127, kq = tid >> 7;
    for (int item = blk; item < 40; item += nblk) {
        const int sb = item >> 2, hh = item & 3;
        const int base = sb < 2 ? sb * 16384 : ROWS_P + (sb - 2) * 4096, S = sb < 2 ? 16384 : 4096;
        for (int dir = 1; dir >= 0; --dir) {
            const float* lbr = dir ? p.lb_bwd : p.lb_fwd;
            float lb = 0.f;
            if (tid < 128) { const int c = hh * 128 + tid; lb = 1.f / (1.f + __expf(lbr[512 + c] - lbr[c])); }
            const int zcol = (dir ? UC_ZB : UC_ZF) + hh * 128;
            float St[32];
#pragma unroll
            for (int k = 0; k < 32; ++k) St[k] = 0.f;
            int buf = 0;
            __syncthreads();
            for (int i = 0; i < S; ++i) {
                const int t = dir ? (S - 1 - i) : i;
                const size_t ro = (size_t)(base + t) * NIN;
                if (tid < 128) { const float z = bf2f(U[ro + zcol + tid]), qr = bf2f(U[ro + UC_QH + hh * 128 + tid]);
                    const float f = lb + (1.f - lb) * sigmoid_f(z); fqb[buf * 128 + tid] = (f32x2v){f, silu_f(qr)}; }
                const float v = bf2f(U[ro + UC_IH + hh * 128 + vcol]);
                __syncthreads();
                if (kq == 0 && i > 0) {
                    const LAS float* pp = po + (buf ^ 1) * 512 + vcol; const float o = (pp[0] + pp[128]) + (pp[256] + pp[384]);
                    const int tp = dir ? (S - i) : (i - 1);
                    const size_t mo = (size_t)(base + tp) * DM + 512 + hh * 128 + vcol;
                    if (dir) MIXIN[mo] = f2bf(o); else MIXIN[mo] = f2bf(o + bf2f(MIXIN[mo]));
                }
                float part = 0.f;
#pragma unroll
                for (int kk = 0; kk < 32; ++kk) { const f32x2v fq = fqb[buf * 128 + kq * 32 + kk]; St[kk] = fq.x * St[kk] + (1.f - fq.x) * v; part += fq.y * St[kk]; }
                po[buf * 512 + kq * 128 + vcol] = part;
                buf ^= 1;
            }
            __syncthreads();
            if (kq == 0) {
                const LAS float* pp = po + (buf ^ 1) * 512 + vcol; const float o = (pp[0] + pp[128]) + (pp[256] + pp[384]);
                const int tp = dir ? 0 : (S - 1);
                const size_t mo = (size_t)(base + tp) * DM + 512 + hh * 128 + vcol;
                if (dir) MIXIN[mo] = f2bf(o); else MIXIN[mo] = f2bf(o + bf2f(MIXIN[mo]));
            }
        }
    }
}


namespace hg {
typedef short bf16x8 __attribute__((ext_vector_type(8)));
constexpr int SEG = 1024, NCH = 16, NITEM = 512;
constexpr int RS = 272, TS = 144;
constexpr int L_QT = 0, L_QR = 17408, L_KR = 34816, L_K0 = 52224, L_Q4 = 56576, L_KT = 60928, L_VT = 79360, L_ST = 97792, L_AB = 132608, L_TOT = 141824, L_BV = 143872, L_END = 144384;
static_assert(L_END <= LDS_BYTES, "hgrn LDS map");
constexpr size_t DO_STATE = 140 * MiB, DO_DEC = 172 * MiB, DO_OB = 176 * MiB, DO_INIT = 240 * MiB;

__device__ __forceinline__ int phys_row(int g, int dir, int lt) { return dir ? (g * SEG + SEG - 1 - lt) : (g * SEG + lt); }
__device__ __forceinline__ unsigned short bf1(float x) { __bf16 b = (__bf16)x; return __builtin_bit_cast(unsigned short, b); }
__device__ __forceinline__ bf16x8 ldfrag(LAS unsigned char* lds, int off, int stride, int row0, int kel, int lane) {
    return *(const LAS bf16x8*)(lds + off + (row0 + (lane & 15)) * stride + (kel + 8 * (lane >> 4)) * 2);
}
template <bool FULL>
__device__ __forceinline__ void load_raw(const bf16_t* U, int g, int dir, int ch, int i, int zcol, int qcol, int vcol, unsigned short (&rz)[16], unsigned short (&rq)[16], unsigned short (&rv)[16]) {
#pragma unroll
    for (int r = 0; r < 16; ++r) {
        const bf16_t* pr = U + (size_t)phys_row(g, dir, 64 * ch + 16 * i + r) * NIN;
        rz[r] = pr[zcol]; if (FULL) rq[r] = pr[qcol]; rv[r] = pr[vcol];
    }
}
template <bool FULL>
__device__ __forceinline__ void prep(LAS unsigned char* lds, int i, int c, float lb, const unsigned short (&rz)[16], const unsigned short (&rq)[16], const unsigned short (&rv)[16], float& bdec) {
    float f[16], e1[16], qs[16];
    float run = 1.f;
#pragma unroll
    for (int r = 0; r < 16; ++r) {
        const float fr = lb + (1.f - lb) * sigmoid_f(bf2f(rz[r]));
        f[r] = fr; run *= fr; e1[r] = run;
        if (FULL) qs[r] = silu_f(bf2f(rq[r])); else qs[r] = 0.f;
    }
    ((LAS float*)(lds + L_TOT))[i * 128 + c] = run;
    {
        u32x4 a, b;
        a.x = rv[0] | ((unsigned)rv[1] << 16); a.y = rv[2] | ((unsigned)rv[3] << 16); a.z = rv[4] | ((unsigned)rv[5] << 16); a.w = rv[6] | ((unsigned)rv[7] << 16);
        b.x = rv[8] | ((unsigned)rv[9] << 16); b.y = rv[10] | ((unsigned)rv[11] << 16); b.z = rv[12] | ((unsigned)rv[13] << 16); b.w = rv[14] | ((unsigned)rv[15] << 16);
        LAS u32x4* vp = (LAS u32x4*)(lds + L_VT + c * TS + 32 * i); vp[0] = a; vp[1] = b;
    }
    __syncthreads();
    const LAS float* tp = (const LAS float*)(lds + L_TOT) + c;
    const float p0 = tp[0], p1 = tp[128], p2 = tp[256], p3 = tp[384];
    const float cQT = i == 0 ? 1.f : i == 1 ? p0 : i == 2 ? p0 * p1 : p0 * p1 * p2;
    const float cKT = i == 0 ? p1 * p2 * p3 : i == 1 ? p2 * p3 : i == 2 ? p3 : 1.f;
    const float cQR = i == 0 ? 1.f : i == 1 ? __builtin_amdgcn_rcpf(p1) : i == 2 ? 1.f : p2;
    const float cKR = i == 0 ? p1 : i == 1 ? 1.f : i == 2 ? __builtin_amdgcn_rcpf(p2) : 1.f;
    const float cK0 = __builtin_amdgcn_rcpf(p0), cQ4 = __builtin_amdgcn_rcpf(p3);
    bdec = (p0 * p1) * (p2 * p3);
    if (i == 0) ((LAS float*)(lds + L_BV))[c] = bdec;
    unsigned short kt[16];
    float e2 = 1.f;
#pragma unroll
    for (int r = 15; r >= 0; --r) {
        const float kb = (1.f - f[r]) * e2;
        kt[r] = bf1(kb * cKT);
        if (FULL) {
            *(LAS unsigned short*)(lds + L_KR + (16 * i + r) * RS + c * 2) = bf1(kb * cKR);
            if (i == 0) *(LAS unsigned short*)(lds + L_K0 + r * RS + c * 2) = bf1(kb * cK0);
        }
        e2 *= f[r];
    }
    {
        u32x4 a, b;
        a.x = kt[0] | ((unsigned)kt[1] << 16); a.y = kt[2] | ((unsigned)kt[3] << 16); a.z = kt[4] | ((unsigned)kt[5] << 16); a.w = kt[6] | ((unsigned)kt[7] << 16);
        b.x = kt[8] | ((unsigned)kt[9] << 16); b.y = kt[10] | ((unsigned)kt[11] << 16); b.z = kt[12] | ((unsigned)kt[13] << 16); b.w = kt[14] | ((unsigned)kt[15] << 16);
        LAS u32x4* kp = (LAS u32x4*)(lds + L_KT + c * TS + 32 * i); kp[0] = a; kp[1] = b;
    }
    if (FULL) {
#pragma unroll
        for (int r = 0; r < 16; ++r) {
            const float qe = qs[r] * e1[r];
            *(LAS unsigned short*)(lds + L_QT + (16 * i + r) * RS + c * 2) = bf1(qe * cQT);
            *(LAS unsigned short*)(lds + L_QR + (16 * i + r) * RS + c * 2) = bf1(qe * cQR);
            if (i == 3) *(LAS unsigned short*)(lds + L_Q4 + r * RS + c * 2) = bf1(qe * cQ4);
        }
    }
}
__device__ __forceinline__ void state_update(LAS unsigned char* lds, f32x4 (&S)[8], int w, int gq, int lane) {
    bf16x8 ktf[2];
#pragma unroll
    for (int k2 = 0; k2 < 2; ++k2) ktf[k2] = ldfrag(lds, L_KT, TS, 16 * w, 32 * k2, lane);
    const f32x4 dk = *(const LAS f32x4*)(lds + L_BV + (16 * w + 4 * gq) * 4);
#pragma unroll
    for (int n = 0; n < 8; ++n) {
        S[n] = S[n] * dk;
#pragma unroll
        for (int k2 = 0; k2 < 2; ++k2) S[n] = __builtin_amdgcn_mfma_f32_16x16x32_bf16(ktf[k2], ldfrag(lds, L_VT, TS, 16 * n, 32 * k2, lane), S[n], 0, 0, 0);
    }
}
__device__ __forceinline__ int item_of(int lin, int G) {
    if (G != 256) return lin;
    const int x = lin & 7, j = (lin >> 3) & 31, e = lin >> 8, g = 8 * x + 2 * (j >> 3) + e, hd = j & 7;
    return g * 8 + hd;
}
__device__ __forceinline__ float lb_of(const Params& p, int dir, int col) { const float* lbr = dir ? p.lb_bwd : p.lb_fwd; return 1.f / (1.f + __expf(lbr[512 + col] - lbr[col])); }

__device__ __forceinline__ void pass1(const Params& p, const bf16_t* U, LAS unsigned char* lds, int item) {
    const int tid = otid(), lane = tid & 63, w = __builtin_amdgcn_readfirstlane(tid >> 6), i = w >> 1, c = tid & 127, gq = lane >> 4;
    const int dir = item & 1, hh = (item >> 1) & 3, g = item >> 3;
    float* STATE = (float*)((unsigned char*)p.out + DO_STATE); float* DEC = (float*)((unsigned char*)p.out + DO_DEC);
    const float lb = lb_of(p, dir, hh * 128 + c);
    const int zcol = (dir ? UC_ZB : UC_ZF) + hh * 128 + c, qcol = UC_QH + hh * 128 + c, vcol = UC_IH + hh * 128 + c;
    f32x4 S[8];
#pragma unroll
    for (int n = 0; n < 8; ++n) S[n] = (f32x4){0.f, 0.f, 0.f, 0.f};
    float dtot = 1.f;
    unsigned short rz[16], rq[16], rv[16];
    load_raw<false>(U, g, dir, 0, i, zcol, qcol, vcol, rz, rq, rv);
    for (int ch = 0; ch < NCH; ++ch) {
        float bdec;
        prep<false>(lds, i, c, lb, rz, rq, rv, bdec);
        dtot *= bdec;
        if (ch + 1 < NCH) load_raw<false>(U, g, dir, ch + 1, i, zcol, qcol, vcol, rz, rq, rv);
        __syncthreads();
        state_update(lds, S, w, gq, lane);
        __syncthreads();
    }
    float* sp = STATE + (size_t)item * 16384 + (16 * w + 4 * gq) * 128 + (lane & 15);
#pragma unroll
    for (int n = 0; n < 8; ++n)
#pragma unroll
        for (int jj = 0; jj < 4; ++jj) sp[jj * 128 + 16 * n] = S[n][jj];
    if (i == 0) DEC[item * 128 + c] = dtot;
}
__device__ __forceinline__ void scan(const Params& p, int gt, int ngt) {
    const float* STATE = (const float*)((unsigned char*)p.out + DO_STATE); const float* DEC = (const float*)((unsigned char*)p.out + DO_DEC);
    bf16_t* INIT = (bf16_t*)((unsigned char*)p.out + DO_INIT);
    for (int e = gt; e < 80 * 4096; e += ngt) {
        const int chain = e >> 12, q4 = e & 4095, k = q4 >> 5;
        const int dir = chain & 1, hh = (chain >> 1) & 3, sb = chain >> 3;
        const int nseg = sb < 2 ? 16 : 4, g0 = sb < 2 ? sb * 16 : 32 + (sb - 2) * 4;
        f32x4 s = {0.f, 0.f, 0.f, 0.f};
        for (int j = 0; j < nseg; ++j) {
            const int g = dir ? (g0 + nseg - 1 - j) : (g0 + j), item = (g * 4 + hh) * 2 + dir;
            const f32x4 en = *((const f32x4*)(STATE + (size_t)item * 16384) + q4);
            u32x2v wv; wv.x = cvt_pk_bf16(s[0], s[1]); wv.y = cvt_pk_bf16(s[2], s[3]);
            *((u32x2v*)(INIT + (size_t)item * 16384) + q4) = wv;
            s = s * DEC[item * 128 + k] + en;
        }
    }
}
__device__ __forceinline__ void pass2(const Params& p, const bf16_t* U, bf16_t* MIXIN, LAS unsigned char* lds, int item) {
    const int tid = otid(), lane = tid & 63, w = __builtin_amdgcn_readfirstlane(tid >> 6), i = w >> 1, c = tid & 127, gq = lane >> 4;
    const int dir = item & 1, hh = (item >> 1) & 3, g = item >> 3;
    const bf16_t* INIT = (const bf16_t*)((unsigned char*)p.out + DO_INIT);
    bf16_t* OUT = dir ? (bf16_t*)((unsigned char*)p.out + DO_OB) + hh * 128 : MIXIN + 512 + hh * 128;
    const int opitch = dir ? 512 : DM;
    const float lb = lb_of(p, dir, hh * 128 + c);
    const int zcol = (dir ? UC_ZB : UC_ZF) + hh * 128 + c, qcol = UC_QH + hh * 128 + c, vcol = UC_IH + hh * 128 + c;
    for (int idx = tid; idx < 64 * TS / 4; idx += 512) ((LAS unsigned*)(lds + L_AB))[idx] = 0u;
    f32x4 S[8];
    {
        const bf16_t* sp = INIT + (size_t)item * 16384 + (16 * w + 4 * gq) * 128 + (lane & 15);
#pragma unroll
        for (int n = 0; n < 8; ++n)
#pragma unroll
            for (int jj = 0; jj < 4; ++jj) S[n][jj] = bf2f(sp[jj * 128 + 16 * n]);
    }
#define HG_ST_WRITE() do { _Pragma("unroll") for (int n = 0; n < 8; ++n) { u32x2v wv; wv.x = cvt_pk_bf16(S[n][0], S[n][1]); wv.y = cvt_pk_bf16(S[n][2], S[n][3]); \
        *(LAS u32x2v*)(lds + L_ST + (16 * n + (lane & 15)) * RS + (16 * w + 4 * gq) * 2) = wv; } } while (0)
    HG_ST_WRITE();
    unsigned short rz[16], rq[16], rv[16];
    load_raw<true>(U, g, dir, 0, i, zcol, qcol, vcol, rz, rq, rv);
    for (int ch = 0; ch < NCH; ++ch) {
        float bdec;
        prep<true>(lds, i, c, lb, rz, rq, rv, bdec);
        if (ch + 1 < NCH) load_raw<true>(U, g, dir, ch + 1, i, zcol, qcol, vcol, rz, rq, rv);
        __syncthreads();
        for (int bi = w; bi < 10; bi += 8) {
            const int ti = bi >= 6 ? 3 : bi >= 3 ? 2 : bi >= 1 ? 1 : 0, tj = bi - ti * (ti + 1) / 2;
            const int qoff = (bi == 9) ? L_Q4 : L_QR + 16 * ti * RS, koff = (bi == 0) ? L_K0 : L_KR + 16 * tj * RS;
            f32x4 a = {0.f, 0.f, 0.f, 0.f};
#pragma unroll
            for (int ks = 0; ks < 4; ++ks) a = __builtin_amdgcn_mfma_f32_16x16x32_bf16(ldfrag(lds, qoff, RS, 0, 32 * ks, lane), ldfrag(lds, koff, RS, 0, 32 * ks, lane), a, 0, 0, 0);
#pragma unroll
            for (int jj = 0; jj < 4; ++jj) {
                float val = a[jj];
                if (ti == tj && (lane & 15) > 4 * gq + jj) val = 0.f;
                *(LAS unsigned short*)(lds + L_AB + (16 * ti + 4 * gq + jj) * TS + (16 * tj + (lane & 15)) * 2) = bf1(val);
            }
        }
        __syncthreads();
        {
            bf16x8 stf[4], vtf[2];
#pragma unroll
            for (int ks = 0; ks < 4; ++ks) stf[ks] = ldfrag(lds, L_ST, RS, 16 * w, 32 * ks, lane);
#pragma unroll
            for (int k2 = 0; k2 < 2; ++k2) vtf[k2] = ldfrag(lds, L_VT, TS, 16 * w, 32 * k2, lane);
#pragma unroll
            for (int mt = 0; mt < 4; ++mt) {
                f32x4 o = {0.f, 0.f, 0.f, 0.f};
#pragma unroll
                for (int ks = 0; ks < 4; ++ks) o = __builtin_amdgcn_mfma_f32_16x16x32_bf16(ldfrag(lds, L_QT, RS, 16 * mt, 32 * ks, lane), stf[ks], o, 0, 0, 0);
#pragma unroll
                for (int k2 = 0; k2 < 2; ++k2) o = __builtin_amdgcn_mfma_f32_16x16x32_bf16(ldfrag(lds, L_AB, TS, 16 * mt, 32 * k2, lane), vtf[k2], o, 0, 0, 0);
#pragma unroll
                for (int jj = 0; jj < 4; ++jj) {
                    const int row = phys_row(g, dir, 64 * ch + 16 * mt + 4 * gq + jj);
                    OUT[(size_t)row * opitch + 16 * w + (lane & 15)] = bf1(o[jj]);
                }
            }
        }
        state_update(lds, S, w, gq, lane);
        __syncthreads();
        HG_ST_WRITE();
    }
#undef HG_ST_WRITE
}
}

__device__ __forceinline__ void hg_finalize(const Params& p, const bf16_t* U, bf16_t* MIXIN, int blk, int G, int wave, int lane) {
    const float gn0 = p.g_hgrn[2 * lane], gn1 = p.g_hgrn[2 * lane + 1];
    const bf16_t* OB = (const bf16_t*)((const unsigned char*)p.out + hg::DO_OB);
    const int gw = blk * 8 + wave, ngw = G * 8;
    for (int row = gw; row < T_; row += ngw) {
#pragma unroll
        for (int hh = 0; hh < 4; ++hh) {
            unsigned* mp = (unsigned*)(MIXIN + (size_t)row * DM + 512 + hh * 128) + lane;
            const unsigned w = *mp, gw2 = *((const unsigned*)(U + (size_t)row * NIN + UC_GH + hh * 128) + lane);
            const unsigned wb = *((const unsigned*)(OB + (size_t)row * 512 + hh * 128) + lane);
            const float o0 = __uint_as_float(w << 16) + __uint_as_float(wb << 16), o1 = __uint_as_float(w & 0xffff0000u) + __uint_as_float(wb & 0xffff0000u);
            const float g0 = __uint_as_float(gw2 << 16), g1 = __uint_as_float(gw2 & 0xffff0000u);
            const float rs = rsqrtf(wave_sum(o0 * o0 + o1 * o1) * (1.f / 128.f) + EPS);
            *mp = cvt_pk_bf16(o0 * rs * gn0 * silu_f(g0), o1 * rs * gn1 * silu_f(g1));
        }
    }
}

__device__ __forceinline__ void p6_rows(const Params& p, LAS unsigned char* lds, int gw, int ngw, int wave, int lane) {
    bf16_t* WGU = (bf16_t*)(p.ws + WS_WGU); bf16_t* WDN = (bf16_t*)(p.ws + WS_WDN);
    LAS float* scr = (LAS float*)(lds + wave * 16384);
    constexpr int I_G = 16 * 88, I_D = 44 * 32;
    for (int it = gw; it < 2 * I_G + I_D; it += ngw) {
        if (it < I_G) transpose_item(p.w_gate, DFF, 64 * (it / 88), 32 * (it % 88), p.g_pre_ffn, WGU, DM, RowGU{0}, scr, lane);
        else if (it < 2 * I_G) { const int r = it - I_G; transpose_item(p.w_up, DFF, 64 * (r / 88), 32 * (r % 88), p.g_pre_ffn, WGU, DM, RowGU{1}, scr, lane); }
        else { const int r = it - 2 * I_G; transpose_item(p.w_down, DM, 64 * (r / 32), 32 * (r % 32), nullptr, WDN, DFF, RowId{}, scr, lane); }
    }
    bf16_t* MIX = (bf16_t*)(p.ws + WS_MIX); const float* SS = (const float*)(p.ws + WS_SS1);
    f32x4 gp[4];
#pragma unroll
    for (int j = 0; j < 4; ++j) gp[j] = ((const f32x4*)p.g_post_mix)[lane + 64 * j];
    for (int m0 = gw * 4; m0 < T_; m0 += ngw * 4) {
        f32x4 xv[4][4]; u32x2v mw[4][4]; float r1[4];
#pragma unroll
        for (int k = 0; k < 4; ++k) {
            const int m = m0 + k;
            const f32x4* ssp = (const f32x4*)(SS + (size_t)m * 16);
            const f32x4 a = ssp[0], b = ssp[1], c = ssp[2], d = ssp[3];
            const float ss = ((a[0] + a[1]) + (a[2] + a[3])) + ((b[0] + b[1]) + (b[2] + b[3])) + ((c[0] + c[1]) + (c[2] + c[3])) + ((d[0] + d[1]) + (d[2] + d[3]));
            r1[k] = rsqrtf(ss * (1.f / DM) + EPS);
            const f32x4* xr = (const f32x4*)xrow_ptr(p, m) + lane;
            const u32x2v* mx = (const u32x2v*)(MIX + (size_t)m * DM) + lane;
#pragma unroll
            for (int jj = 0; jj < 4; ++jj) { xv[k][jj] = xr[64 * jj]; mw[k][jj] = mx[64 * jj]; }
        }
        float s2[4];
#pragma unroll
        for (int k = 0; k < 4; ++k) {
            f32x4* xo = (f32x4*)(p.out + (size_t)(m0 + k) * DM) + lane;
            s2[k] = 0.f;
#pragma unroll
            for (int jj = 0; jj < 4; ++jj) {
                const u32x2v w = mw[k][jj];
                f32x4 mv = {__uint_as_float(w.x << 16), __uint_as_float(w.x & 0xffff0000u), __uint_as_float(w.y << 16), __uint_as_float(w.y & 0xffff0000u)};
                xv[k][jj] = xv[k][jj] + mv * r1[k] * gp[jj];
                s2[k] += (xv[k][jj][0] * xv[k][jj][0] + xv[k][jj][1] * xv[k][jj][1]) + (xv[k][jj][2] * xv[k][jj][2] + xv[k][jj][3] * xv[k][jj][3]);
                xo[64 * jj] = xv[k][jj];
            }
        }
#pragma unroll
        for (int k = 0; k < 4; ++k) {
            const float r2 = rsqrtf(wave_sum(s2[k]) * (1.f / DM) + EPS);
            u32x2v* mx = (u32x2v*)(MIX + (size_t)(m0 + k) * DM) + lane;
#pragma unroll
            for (int jj = 0; jj < 4; ++jj) { u32x2v w; w.x = cvt_pk_bf16(xv[k][jj][0] * r2, xv[k][jj][1] * r2); w.y = cvt_pk_bf16(xv[k][jj][2] * r2, xv[k][jj][3] * r2); mx[64 * jj] = w; }
        }
    }
}
__device__ __forceinline__ void p9_rows(const Params& p, int gw, int ngw, int lane) {
    const bf16_t* FF = (const bf16_t*)(p.ws + WS_MIX); const float* SS = (const float*)(p.ws + WS_SS2);
    f32x4 gp[4];
#pragma unroll
    for (int j = 0; j < 4; ++j) gp[j] = ((const f32x4*)p.g_post_ffn)[lane + 64 * j];
    for (int m0 = gw * 4; m0 < T_; m0 += ngw * 4) {
        f32x4 xv[4][4]; u32x2v fw[4][4]; float r1[4];
#pragma unroll
        for (int k = 0; k < 4; ++k) {
            const int m = m0 + k;
            const f32x4* ssp = (const f32x4*)(SS + (size_t)m * 16);
            const f32x4 a = ssp[0], b = ssp[1], c = ssp[2], d = ssp[3];
            const float ss = ((a[0] + a[1]) + (a[2] + a[3])) + ((b[0] + b[1]) + (b[2] + b[3])) + ((c[0] + c[1]) + (c[2] + c[3])) + ((d[0] + d[1]) + (d[2] + d[3]));
            r1[k] = rsqrtf(ss * (1.f / DM) + EPS);
            const u32x2v* fx = (const u32x2v*)(FF + (size_t)m * DM) + lane;
            const f32x4* xo = (const f32x4*)(p.out + (size_t)m * DM) + lane;
#pragma unroll
            for (int jj = 0; jj < 4; ++jj) { xv[k][jj] = xo[64 * jj]; fw[k][jj] = fx[64 * jj]; }
        }
#pragma unroll
        for (int k = 0; k < 4; ++k) {
            f32x4* xo = (f32x4*)(p.out + (size_t)(m0 + k) * DM) + lane;
#pragma unroll
            for (int jj = 0; jj < 4; ++jj) {
                const u32x2v w = fw[k][jj];
                f32x4 fv = {__uint_as_float(w.x << 16), __uint_as_float(w.x & 0xffff0000u), __uint_as_float(w.y << 16), __uint_as_float(w.y & 0xffff0000u)};
                xo[64 * jj] = xv[k][jj] + fv * r1[k] * gp[jj];
            }
        }
    }
}

__global__ void __launch_bounds__(512, 2) fwd_megakernel(Params p) {
    extern __shared__ __attribute__((aligned(16))) unsigned char lds_raw[];
    LAS unsigned char* lds = (LAS unsigned char*)lds_raw;
    cg::grid_group grid = cg::this_grid();
#define GSYNC() do { asm volatile("s_waitcnt vmcnt(0)" ::: "memory"); grid.sync(); \
        if (wave == 0) { __builtin_amdgcn_fence(__ATOMIC_ACQUIRE, "agent"); asm volatile("s_waitcnt vmcnt(0)" ::: "memory"); } __syncthreads(); } while (0)
    const int tid = otid(), lane = tid & 63, wave = __builtin_amdgcn_readfirstlane(tid >> 6);
    const int G = gridDim.x, blk = blockIdx.x;
    const int gw = blk * 8 + wave, ngw = G * 8;
    unsigned char* dob = (unsigned char*)p.out;
    bf16_t* U = (bf16_t*)(p.ws + WS_U);
    bf16_t* MIXIN = (bf16_t*)(dob + DO_MIXIN);

    volatile LAS unsigned* bst = (volatile LAS unsigned*)(lds + LDS_BYTES - 16);
    if (tid < 2) bst[tid] = 0u;
    if (blk == 0) for (int i2 = tid; i2 < 3456; i2 += 512) __hip_atomic_store(g_bar + i2, 0u, __ATOMIC_RELAXED, __HIP_MEMORY_SCOPE_AGENT);
    p0_prologue(p, lds, gw, ngw, wave, lane);
    GSYNC();
    const XcdBarrier xbar = xcd_barrier_post(g_bar, bst);
#define XSYNC() xcd_barrier(xbar)
    {
        pg8::Gemm g{(const bf16_t*)(dob + DO_XN), (const bf16_t*)(dob + DO_WIN), T_, NIN, DM}; pg8::StaticOrder S; S.init(T_, NIN, G, blk);
        EpiU E{U, (const float*)(dob + DO_ROPE)};
        pg8::gemm_phase<EpiU, pg8::StaticOrder, true, true>(lds, g, S, E);
    }
    XSYNC();
    for (int lin = blk; lin < hg::NITEM; lin += G) hg::pass1(p, U, lds, hg::item_of(lin, G));
    at::attn_phase(U, MIXIN, lds, blk, G);
    XSYNC();
    hg::scan(p, blk * 512 + tid, G * 512);
    XSYNC();
    for (int lin = blk; lin < hg::NITEM; lin += G) hg::pass2(p, U, MIXIN, lds, hg::item_of(lin, G));
    XSYNC();
    hg_finalize(p, U, MIXIN, blk, G, wave, lane);
    XSYNC();
    {
        pg8::Gemm g{MIXIN, (const bf16_t*)(dob + DO_WOUT), T_, DM, DM}; pg8::StaticOrder S; S.init(T_, DM, G, blk);
        EpiRowSS E{(bf16_t*)(p.ws + WS_MIX), (float*)(p.ws + WS_SS1)};
        pg8::gemm_phase<EpiRowSS, pg8::StaticOrder, true, true>(lds, g, S, E);
    }
    XSYNC();
    p6_rows(p, lds, gw, ngw, wave, lane);
    XSYNC();
    {
        pg8::Gemm g{(const bf16_t*)(p.ws + WS_MIX), (const bf16_t*)(p.ws + WS_WGU), T_, 2 * DFF, DM}; pg8::StaticOrder S; S.init(T_, 2 * DFF, G, blk);
        EpiSwiGLU E{(bf16_t*)(p.ws + WS_HFF)};
        pg8::gemm_phase<EpiSwiGLU, pg8::StaticOrder, true, true>(lds, g, S, E);
    }
    XSYNC();
    {
        pg8::Gemm g{(const bf16_t*)(p.ws + WS_HFF), (const bf16_t*)(p.ws + WS_WDN), T_, DM, DFF}; pg8::StaticOrder S; S.init(T_, DM, G, blk);
        EpiRowSS E{(bf16_t*)(p.ws + WS_MIX), (float*)(p.ws + WS_SS2)};
        pg8::gemm_phase<EpiRowSS, pg8::StaticOrder, true, true>(lds, g, S, E);
    }
    XSYNC();
    p9_rows(p, gw, ngw, lane);
}

extern "C" void kernel_launch(void* const* d_in, const int* in_sizes, int n_in, void* d_out, int out_size, void* d_ws, size_t ws_size, hipStream_t stream) {
    static int grid_blocks = 0;
    if (grid_blocks == 0) {
        int dev = 0, cus = 0, per_cu = 0;
        hipGetDevice(&dev);
        hipDeviceGetAttribute(&cus, hipDeviceAttributeMultiprocessorCount, dev);
        hipFuncSetAttribute((const void*)fwd_megakernel, hipFuncAttributeMaxDynamicSharedMemorySize, LDS_BYTES);
        hipOccupancyMaxActiveBlocksPerMultiprocessor(&per_cu, (const void*)fwd_megakernel, 512, LDS_BYTES);
        if (per_cu < 1) { fprintf(stderr, "occupancy query reports %d blocks per CU\n", per_cu); per_cu = 1; }
        if (per_cu > 1) per_cu = 1;
        grid_blocks = cus * per_cu;
        if (ws_size < 512 * MiB) fprintf(stderr, "kernel_launch: workspace %zu smaller than the 512 MiB map\n", ws_size);
    }
    Params p{};
    p.xp = (const float*)d_in[0]; p.xs = (const float*)d_in[1]; p.w_in = (const float*)d_in[2]; p.w_out = (const float*)d_in[3];
    p.lb_fwd = (const float*)d_in[4]; p.lb_bwd = (const float*)d_in[5]; p.g_hgrn = (const float*)d_in[6]; p.g_pre_mix = (const float*)d_in[7];
    p.g_post_mix = (const float*)d_in[8]; p.g_pre_ffn = (const float*)d_in[9]; p.g_post_ffn = (const float*)d_in[10];
    p.w_gate = (const float*)d_in[11]; p.w_up = (const float*)d_in[12]; p.w_down = (const float*)d_in[13];
    p.out = (float*)d_out; p.ws = (unsigned char*)d_ws;
    void* args[] = {&p};
    hipError_t e = hipLaunchCooperativeKernel((const void*)fwd_megakernel, dim3(grid_blocks), dim3(512), args, LDS_BYTES, stream);
    if (e != hipSuccess) fprintf(stderr, "cooperative launch failed: %s (grid %d)\n", hipGetErrorString(e), grid_blocks);
}
```

```cpp
#include <hip/hip_runtime.h>
#include <hip/hip_cooperative_groups.h>
#include <cstdio>
#include <cstdint>
namespace cg = cooperative_groups;
namespace pg8 {
#define PG8_LAS __attribute__((address_space(3)))
typedef unsigned short bf16_t;
typedef short bf16x8 __attribute__((ext_vector_type(8)));
typedef float f32x4 __attribute__((ext_vector_type(4)));
typedef unsigned u32x4 __attribute__((ext_vector_type(4)));
constexpr int BM = 256, BK = 64, HALF = 128, HTB = HALF * BK * 2  , STAGE_BYTES = 8 * HTB, NXCD = 8, WGM = 8;

__host__ __device__ __forceinline__ int lds_byte(int r, int c) { const int st = (r >> 4) * 2 + (c >> 5), rr = r & 15, cc = c & 31, ob = rr * 64 + cc * 2; return st * 1024 + (ob ^ (((ob >> 9) & 1) << 5)); }
__host__ __device__ __forceinline__ void stage_rc(int b, int& R, int& C) { const int st = b / 1024, sb = b % 1024, swz = sb ^ (((sb >> 9) & 1) << 5); R = (st >> 1) * 16 + swz / 64; C = (st & 1) * 32 + (swz % 64) / 2; }
__host__ __device__ __forceinline__ int perm32(int rho) { const int n = rho >> 4, i = rho & 15; return 8 * (i >> 2) + 4 * n + (i & 3); }

struct Unit { int pm, pn; };
struct Gemm { const bf16_t* A; const bf16_t* Bt; int M, N, K; };

struct StaticOrder {
    int nM, nN, nwg, G, c;
    __host__ __device__ void init(int M, int N, int G_, int c_) { nM = M / BM; nN = N / BM; nwg = nM * nN; G = G_; c = c_; }
    __host__ __device__ bool next(int i, Unit& u) const {
        const long L = (long)i * G + c; if (L >= nwg) return false;
        int wgid = (int)L; { const int q = nwg / NXCD, r = nwg % NXCD, xcd = wgid % NXCD, off = wgid / NXCD; wgid = (xcd < r ? xcd * (q + 1) : r * (q + 1) + (xcd - r) * q) + off; }
        const int nig = WGM * nN, gid = wgid / nig, fm = gid * WGM, gsz = (nM - fm) < WGM ? (nM - fm) : WGM;
        u.pm = fm + ((wgid % nig) % gsz); u.pn = (wgid % nig) / gsz; return true;
    }
    __device__ __forceinline__ void a_ready(const Unit&) const {}
    __device__ __forceinline__ void done(const Unit&) const {}
};

typedef __bf16 bf16x2_t __attribute__((ext_vector_type(2)));
typedef float f32x2_t __attribute__((ext_vector_type(2)));
__device__ __forceinline__ unsigned cvt_pk_bf16(float lo, float hi) { f32x2_t v = {lo, hi}; bf16x2_t b = __builtin_convertvector(v, bf16x2_t); return __builtin_bit_cast(unsigned, b); }
typedef float f32x2 __attribute__((ext_vector_type(2)));
template <class Epi, class Sched, bool ALIGN_EPI = false, bool SP2 = false>
__device__ __forceinline__ void gemm_phase(PG8_LAS unsigned char* lds, const Gemm g, const Sched& S, const Epi& E) {
    const int tid = threadIdx.x, wid = __builtin_amdgcn_readfirstlane(tid >> 6), lane = tid & 63, wr = wid >> 2, wc = wid & 3, fr = lane & 15, fq = lane >> 4;
    const int K = g.K, nt = K / BK;
    unsigned voffA[2], voffB[2];
#pragma unroll
    for (int i = 0; i < 2; ++i) { int R, C; stage_rc(tid * 16 + i * 8192, R, C); const int Rb = Epi::PERM ? ((R & ~31) + perm32(R & 31)) : R;
        voffA[i] = (unsigned)(R * K + C) * 2u; voffB[i] = (unsigned)(Rb * K + C) * 2u; }
    const size_t kstep = (size_t)(BK * 2);
    const size_t hstep = (size_t)HALF * K * 2;
    const size_t tstep = 2 * hstep;
    const unsigned ldsw = (unsigned)wid * 1024u;
    const int aoff = lds_byte(wr * 64 + fr, fq * 8), boff = lds_byte(wc * 32 + fr, fq * 8);
#define PG8_SA(b, h) (((b) * 2 + (h)) * HTB)
#define PG8_SB(b, h) ((4 + (b) * 2 + (h)) * HTB)
#define PG8_STAGE(bufoff, gbase, voff) do { _Pragma("unroll") for (int _i = 0; _i < 2; ++_i) \
        __builtin_amdgcn_global_load_lds((const unsigned*)((const char*)(gbase) + (voff)[_i]), (PG8_LAS unsigned*)(lds + (bufoff) + ldsw + _i * 8192), 16, 0, 0); } while (0)
#define PG8_LDA(dst, b, h) do { _Pragma("unroll") for (int m = 0; m < 4; ++m) _Pragma("unroll") for (int k = 0; k < 2; ++k) dst[m][k] = *(const PG8_LAS bf16x8*)(lds + PG8_SA(b, h) + aoff + m * 2048 + k * 1024); } while (0)
#define PG8_LDB(dst, b, h) do { _Pragma("unroll") for (int n = 0; n < 2; ++n) _Pragma("unroll") for (int k = 0; k < 2; ++k) dst[n][k] = *(const PG8_LAS bf16x8*)(lds + PG8_SB(b, h) + boff + n * 2048 + k * 1024); } while (0)
#define PG8_MMA(ai, bj, At, Bt) do { __builtin_amdgcn_s_setprio(1); _Pragma("unroll") for (int m = 0; m < 4; ++m) _Pragma("unroll") for (int n = 0; n < 2; ++n) _Pragma("unroll") for (int k = 0; k < 2; ++k) \
        acc[ai][bj][m][n] = __builtin_amdgcn_mfma_f32_16x16x32_bf16(Bt[n][k], At[m][k], acc[ai][bj][m][n], 0, 0, 0); __builtin_amdgcn_s_setprio(0); } while (0)
#define PG8_WAIT_V(n) asm volatile("s_waitcnt vmcnt(" #n ")" ::: "memory")
#define PG8_WAIT_L(n) asm volatile("s_waitcnt lgkmcnt(" #n ")" ::: "memory")
#define PG8_BAR __builtin_amdgcn_s_barrier()
#define PG8_SCHED __builtin_amdgcn_sched_barrier(0)
    Unit cur, nxt; int ui = 0;
    if (!S.next(0, cur)) return;
    f32x4 acc[2][2][4][2];
#pragma unroll
    for (int a = 0; a < 2; ++a)
#pragma unroll
        for (int b = 0; b < 2; ++b)
#pragma unroll
            for (int m = 0; m < 4; ++m)
#pragma unroll
                for (int n = 0; n < 2; ++n) acc[a][b][m][n] = (f32x4){0.f, 0.f, 0.f, 0.f};
    bf16x8 At[4][2], B0[2][2], B1[2][2];
    const char* cA = (const char*)g.A + (size_t)cur.pm * tstep; const char* cB = (const char*)g.Bt + (size_t)cur.pn * tstep;
    S.a_ready(cur);
    if constexpr (SP2) {
        PG8_STAGE(PG8_SB(0, 0), cB, voffB); PG8_STAGE(PG8_SB(0, 1), cB + hstep, voffB); PG8_STAGE(PG8_SA(0, 0), cA, voffA); PG8_STAGE(PG8_SA(0, 1), cA + hstep, voffA);
        if (wr == 1) PG8_BAR;
        PG8_WAIT_V(2); PG8_BAR;
        PG8_STAGE(PG8_SB(1, 0), cB + kstep, voffB); PG8_STAGE(PG8_SA(1, 0), cA + kstep, voffA); PG8_STAGE(PG8_SB(1, 1), cB + hstep + kstep, voffB);
        PG8_WAIT_V(6); PG8_BAR;
    } else {
        PG8_STAGE(PG8_SB(0, 0), cB, voffB); PG8_STAGE(PG8_SA(0, 0), cA, voffA); PG8_STAGE(PG8_SB(0, 1), cB + hstep, voffB); PG8_STAGE(PG8_SA(0, 1), cA + hstep, voffA);
        if (wr == 1) PG8_BAR;
        PG8_WAIT_V(4); PG8_BAR;
        PG8_STAGE(PG8_SB(1, 0), cB + kstep, voffB); PG8_STAGE(PG8_SA(1, 0), cA + kstep, voffA); PG8_STAGE(PG8_SB(1, 1), cB + hstep + kstep, voffB);
        PG8_WAIT_V(6); PG8_BAR;
    }
    for (;;) {
        const bool has_next = S.next(ui + 1, nxt);
        const char* nA = has_next ? (const char*)g.A + (size_t)nxt.pm * tstep : cA; const char* nB = has_next ? (const char*)g.Bt + (size_t)nxt.pn * tstep : cB;
        for (int t = 0; t < nt; t += 2) {
            const bool last = (t == nt - 2);
            const char* a1 = cA + (size_t)(t + 1) * kstep;
            const char* a2 = last ? nA : cA + (size_t)(t + 2) * kstep; const char* b2 = last ? nB : cB + (size_t)(t + 2) * kstep;
            const char* a3 = a2 + kstep; const char* b3 = b2 + kstep;
            if (last && has_next) S.a_ready(nxt);
            if constexpr (SP2) {
            PG8_LDB(B0, 0, 0); PG8_LDB(B1, 0, 1); PG8_SCHED; PG8_LDA(At, 0, 0); PG8_STAGE(PG8_SA(1, 1), a1 + hstep, voffA);
            PG8_WAIT_V(8); PG8_WAIT_L(0); PG8_BAR; PG8_MMA(0, 0, At, B0); PG8_MMA(0, 1, At, B1); PG8_BAR; PG8_SCHED;
            PG8_LDA(At, 0, 1); PG8_STAGE(PG8_SB(0, 0), b2, voffB); PG8_STAGE(PG8_SB(0, 1), b2 + hstep, voffB); PG8_STAGE(PG8_SA(0, 0), a2, voffA);
            PG8_WAIT_V(8); PG8_WAIT_L(0); PG8_BAR; PG8_MMA(1, 0, At, B0); PG8_MMA(1, 1, At, B1); PG8_BAR; PG8_SCHED;
            PG8_LDB(B0, 1, 0); PG8_LDB(B1, 1, 1); PG8_SCHED; PG8_LDA(At, 1, 0); PG8_STAGE(PG8_SA(0, 1), a2 + hstep, voffA);
            PG8_WAIT_V(8); PG8_WAIT_L(0); PG8_BAR; PG8_MMA(0, 0, At, B0); PG8_MMA(0, 1, At, B1); PG8_BAR; PG8_SCHED;
            PG8_LDA(At, 1, 1); PG8_STAGE(PG8_SB(1, 0), b3, voffB); PG8_STAGE(PG8_SB(1, 1), b3 + hstep, voffB); PG8_STAGE(PG8_SA(1, 0), a3, voffA);
            PG8_WAIT_V(8); PG8_WAIT_L(0); PG8_BAR; PG8_MMA(1, 0, At, B0); PG8_MMA(1, 1, At, B1); PG8_BAR; PG8_SCHED;
            } else {
            PG8_LDB(B0, 0, 0); PG8_SCHED; PG8_LDA(At, 0, 0); PG8_STAGE(PG8_SA(1, 1), a1 + hstep, voffA);
            PG8_WAIT_L(8); PG8_BAR; PG8_WAIT_L(0); PG8_MMA(0, 0, At, B0); PG8_BAR; PG8_SCHED;
            PG8_LDB(B1, 0, 1); PG8_STAGE(PG8_SB(0, 0), b2, voffB);
            PG8_BAR; PG8_WAIT_L(0); PG8_MMA(0, 1, At, B1); PG8_BAR;
            PG8_LDA(At, 0, 1); PG8_STAGE(PG8_SA(0, 0), a2, voffA);
            PG8_BAR; PG8_WAIT_L(0); PG8_MMA(1, 0, At, B0); PG8_BAR; PG8_SCHED;
            PG8_STAGE(PG8_SB(0, 1), b2 + hstep, voffB);
            PG8_WAIT_V(6); PG8_BAR; PG8_MMA(1, 1, At, B1); PG8_BAR;
            PG8_LDB(B0, 1, 0); PG8_SCHED; PG8_LDA(At, 1, 0); PG8_STAGE(PG8_SA(0, 1), a2 + hstep, voffA);
            PG8_WAIT_L(8); PG8_BAR; PG8_WAIT_L(0); PG8_MMA(0, 0, At, B0); PG8_BAR; PG8_SCHED;
            PG8_LDB(B1, 1, 1); PG8_STAGE(PG8_SB(1, 0), b3, voffB);
            PG8_BAR; PG8_WAIT_L(0); PG8_MMA(0, 1, At, B1); PG8_BAR;
            PG8_LDA(At, 1, 1); PG8_STAGE(PG8_SA(1, 0), a3, voffA);
            PG8_BAR; PG8_WAIT_L(0); PG8_MMA(1, 0, At, B0); PG8_BAR; PG8_SCHED;
            PG8_STAGE(PG8_SB(1, 1), b3 + hstep, voffB);
            PG8_WAIT_V(6); PG8_BAR; PG8_MMA(1, 1, At, B1); PG8_BAR;
            }
        }
        if constexpr (ALIGN_EPI) { if (wr == 0) PG8_BAR; }
        if constexpr (!Epi::AFTER_DRAIN) { E(acc, cur, wr, wc, fr, fq); S.done(cur); }
        if (!has_next) break;
#pragma unroll
        for (int a = 0; a < 2; ++a)
#pragma unroll
            for (int b = 0; b < 2; ++b)
#pragma unroll
                for (int m = 0; m < 4; ++m)
#pragma unroll
                    for (int n = 0; n < 2; ++n) acc[a][b][m][n] = (f32x4){0.f, 0.f, 0.f, 0.f};
        cur = nxt; cA = nA; cB = nB; ++ui;
        if constexpr (ALIGN_EPI) { if (wr == 1) PG8_BAR; }
    }
    PG8_WAIT_V(0);
    if constexpr (!ALIGN_EPI) { if (wr == 0) PG8_BAR; }
    PG8_BAR;
    if constexpr (Epi::AFTER_DRAIN) { E.fused(acc, cur, wr, wc, fr, fq, lds, wid, lane); S.done(cur); }
#undef PG8_SA
#undef PG8_SB
#undef PG8_STAGE
#undef PG8_LDA
#undef PG8_LDB
#undef PG8_MMA
#undef PG8_WAIT_V
#undef PG8_WAIT_L
#undef PG8_BAR
#undef PG8_SCHED
}
}

#define LAS __attribute__((address_space(3)))
typedef unsigned short bf16_t;
using pg8::f32x4; using pg8::u32x4; using pg8::Unit; using pg8::cvt_pk_bf16;
typedef float f32x2v __attribute__((ext_vector_type(2)));
typedef unsigned u32x2v __attribute__((ext_vector_type(2)));

constexpr int T_ = 65536, DM = 1024, NIN = 4096, DFF = 2816, ROWS_P = 32768;
constexpr size_t MiB = 1u << 20;
constexpr float EPS = 1e-6f;
constexpr int LDS_BYTES = 147456;
constexpr size_t DO_XN = 0, DO_MIXIN = 0, DO_WIN = 128 * MiB, DO_ROPE = 136 * MiB, DO_WOUT = 137 * MiB;
constexpr size_t WS_U = 0;
constexpr size_t WS_MIX = 0;
constexpr size_t WS_WGU = 128 * MiB, WS_WDN = 139 * MiB, WS_SS1 = 145 * MiB, WS_SS2 = 149 * MiB, WS_HFF = 160 * MiB;
constexpr int UC_QA = 0, UC_KA = 512, UC_VA = 1024, UC_QH = 1536, UC_ZF = 2048, UC_ZB = 2560, UC_IH = 3072, UC_GH = 3584;

__device__ __forceinline__ float bf2f(unsigned short h) { return __uint_as_float((unsigned)h << 16); }
__device__ __forceinline__ unsigned short f2bf(float f) { unsigned u = __float_as_uint(f); return (unsigned short)((u + 0x7fffu + ((u >> 16) & 1u)) >> 16); }
__device__ __forceinline__ unsigned pk2(float lo, float hi) { return cvt_pk_bf16(lo, hi); }
__device__ __forceinline__ float silu_f(float x) { return x * __builtin_amdgcn_rcpf(1.f + __expf(-x)); }
__device__ __forceinline__ float sigmoid_f(float x) { return __builtin_amdgcn_rcpf(1.f + __expf(-x)); }
__device__ __forceinline__ int row_pos(int row) { return row < ROWS_P ? (row & 16383) : (row & 4095); }
__device__ __forceinline__ int row_S(int row) { return row < ROWS_P ? 16384 : 4096; }
__device__ __forceinline__ float wave_sum(float v) {
#pragma unroll
    for (int o = 1; o < 64; o <<= 1) v += __shfl_xor(v, o);
    return v;
}
__device__ __forceinline__ float wave_max(float v) {
#pragma unroll
    for (int o = 1; o < 64; o <<= 1) v = fmaxf(v, __shfl_xor(v, o));
    return v;
}
#define LDS_WAIT() asm volatile("s_waitcnt lgkmcnt(0)" ::: "memory")
__device__ __forceinline__ int otid() { int t; asm volatile("v_mov_b32 %0, %1" : "=v"(t) : "v"((int)threadIdx.x)); return t; }


__device__ unsigned g_bar[3456];
struct XcdBarrier { unsigned* bar; unsigned x; volatile LAS unsigned* st; };
#define XB_TMO      128
#define XB_XCNT(j)  (256  + 64 * (j))
#define XB_XSUB(j)  (1280 + 64 * (j))
#define XB_XGEN(j)  (2304 + 64 * (j))
#define XB_TOP      3328
#define XB_TOPGEN   3392
#define XCD_BAR_WORDS 3456
#define XB_SPIN_CAP (1u << 18)

__device__ __forceinline__ unsigned xb_ld(unsigned* p)              { return __hip_atomic_load(p, __ATOMIC_RELAXED, __HIP_MEMORY_SCOPE_AGENT); }
__device__ __forceinline__ unsigned xb_add(unsigned* p, unsigned v) { return __hip_atomic_fetch_add(p, v, __ATOMIC_RELAXED, __HIP_MEMORY_SCOPE_AGENT); }
__device__ __forceinline__ unsigned xb_xcc_id() { return (unsigned)__builtin_amdgcn_s_getreg((3 << 11) | 20) & 0xFu; }
#define XB_SPIN(cond, bar) do { unsigned _sp = 0; while (cond) { __builtin_amdgcn_s_sleep(1); \
    if ((++_sp & 255u) == 0u) { if (xb_ld(&(bar)[XB_TMO])) break; if (_sp > XB_SPIN_CAP) { atomicAdd(&(bar)[XB_TMO], 1u); break; } } } } while (0)
__device__ __forceinline__ XcdBarrier xcd_barrier_post(unsigned* bar, volatile LAS unsigned* st) {
    XcdBarrier b; b.bar = bar; b.x = xb_xcc_id(); b.st = st;
    if (threadIdx.x == 0) (void)xb_add(&bar[XB_XCNT(b.x)], 1u);
    return b;
}
__device__ __forceinline__ void xcd_barrier_complete(unsigned* bar, unsigned x, unsigned& nloc, unsigned& nx) {
    const unsigned G = gridDim.x * gridDim.y * gridDim.z;
    unsigned sum, cnt, mine, sp = 0u;
    for (;;) {
        sum = 0u; cnt = 0u; mine = 0u;
#pragma unroll
        for (unsigned j = 0; j < 16; ++j) { const unsigned c = xb_ld(&bar[XB_XCNT(j)]); sum += c; cnt += (c > 0u) ? 1u : 0u; mine = (j == x) ? c : mine; }
        if (sum == G) break;
        __builtin_amdgcn_s_sleep(1);
        if ((++sp & 255u) == 0u) { if (xb_ld(&bar[XB_TMO])) break; if (sp > XB_SPIN_CAP) { atomicAdd(&bar[XB_TMO], 1u); break; } }
    }
    nloc = mine > 0u ? mine : 1u; nx = cnt > 0u ? cnt : 1u;
}

__device__ __forceinline__ void xcd_barrier(const XcdBarrier& b) {
    asm volatile("s_waitcnt vmcnt(0)" ::: "memory");
    __syncthreads();
    if (threadIdx.x == 0) {
        unsigned* bar = b.bar;
        __builtin_amdgcn_s_waitcnt(0);
        unsigned nloc = b.st[0], nx = b.st[1];
        if (nloc == 0u) { xcd_barrier_complete(bar, b.x, nloc, nx); b.st[0] = nloc; b.st[1] = nx; }
        const unsigned old = xb_add(&bar[XB_XSUB(b.x)], 1u);
        const unsigned gen = old / nloc;
        if (old + 1u == (gen + 1u) * nloc) {
            __builtin_amdgcn_fence(__ATOMIC_RELEASE, "agent");
            asm volatile("s_waitcnt vmcnt(0)" ::: "memory");
            const unsigned og = xb_add(&bar[XB_TOP], 1u);
            const unsigned tg = og / nx;
            if (og + 1u == (tg + 1u) * nx) xb_add(&bar[XB_TOPGEN], 1u);
            else XB_SPIN(xb_ld(&bar[XB_TOPGEN]) == tg, bar);
            __builtin_amdgcn_fence(__ATOMIC_ACQUIRE, "agent");
            xb_add(&bar[XB_XGEN(b.x)], 1u);
            asm volatile("s_waitcnt vmcnt(0)" ::: "memory");
        } else {
            XB_SPIN(xb_ld(&bar[XB_XGEN(b.x)]) == gen, bar);
            __builtin_amdgcn_fence(__ATOMIC_ACQUIRE, "agent");
            asm volatile("s_waitcnt vmcnt(0)" ::: "memory");
        }
    }
    __syncthreads();
}

struct EpiU {
    static constexpr bool PERM = true, AFTER_DRAIN = false;
    bf16_t* U; const float* rope;
    __device__ __forceinline__ void operator()(const f32x4 (&acc)[2][2][4][2], const Unit& u, int wr, int wc, int fr, int fq) const {
        const int row0 = u.pm * 256 + wr * 64 + fr, col0 = u.pn * 256 + wc * 32 + 8 * fq;
        const bool rope_tile = (u.pn < 4) && ((wc & 1) == 0);
        const float sc = (u.pn < 2) ? 0.125f : 1.0f;
        const float sgn = (fq == 0) ? -1.f : 1.f;
#pragma unroll
        for (int ai = 0; ai < 2; ++ai)
#pragma unroll
            for (int m = 0; m < 4; ++m) {
                const int row = row0 + ai * 128 + m * 16;
                bf16_t* rowp = U + (size_t)row * NIN + col0;
                f32x4 r0 = {1.f, 0.f, 1.f, 0.f}, r1 = r0, r2 = r0, r3 = r0;
                if (rope_tile) { const f32x4* rp = (const f32x4*)(rope + (size_t)row_pos(row) * 16); r0 = rp[0]; r1 = rp[1]; r2 = rp[2]; r3 = rp[3]; }
#pragma unroll
                for (int bj = 0; bj < 2; ++bj) {
                    f32x4 v0 = acc[ai][bj][m][0], v1 = acc[ai][bj][m][1];
                    if (rope_tile) {
                        f32x4 p0, p1;
#pragma unroll
                        for (int j = 0; j < 4; ++j) { p0[j] = __shfl_xor(v0[j], 16); p1[j] = __shfl_xor(v1[j], 16); }
                        if (fq < 2) {
                            v0[0] = v0[0] * r0[0] + sgn * p0[0] * r0[1]; v0[1] = v0[1] * r0[2] + sgn * p0[1] * r0[3];
                            v0[2] = v0[2] * r1[0] + sgn * p0[2] * r1[1]; v0[3] = v0[3] * r1[2] + sgn * p0[3] * r1[3];
                            v1[0] = v1[0] * r2[0] + sgn * p1[0] * r2[1]; v1[1] = v1[1] * r2[2] + sgn * p1[1] * r2[3];
                            v1[2] = v1[2] * r3[0] + sgn * p1[2] * r3[1]; v1[3] = v1[3] * r3[2] + sgn * p1[3] * r3[3];
                        }
                    }
                    v0 = v0 * sc; v1 = v1 * sc;
                    u32x4 w; w.x = cvt_pk_bf16(v0[0], v0[1]); w.y = cvt_pk_bf16(v0[2], v0[3]); w.z = cvt_pk_bf16(v1[0], v1[1]); w.w = cvt_pk_bf16(v1[2], v1[3]);
                    *(u32x4*)(rowp + bj * 128) = w;
                }
            }
    }
};
struct EpiRowSS {
    static constexpr bool PERM = true, AFTER_DRAIN = false;
    bf16_t* O; float* SS;
    __device__ __forceinline__ void operator()(const f32x4 (&acc)[2][2][4][2], const Unit& u, int wr, int wc, int fr, int fq) const {
        const int row0 = u.pm * 256 + wr * 64 + fr, col0 = u.pn * 256 + wc * 32 + 8 * fq;
#pragma unroll
        for (int ai = 0; ai < 2; ++ai)
#pragma unroll
            for (int m = 0; m < 4; ++m) {
                const int row = row0 + ai * 128 + m * 16;
                bf16_t* rowp = O + (size_t)row * DM + col0;
                float s = 0.f;
#pragma unroll
                for (int bj = 0; bj < 2; ++bj) {
                    const f32x4 v0 = acc[ai][bj][m][0], v1 = acc[ai][bj][m][1];
                    s += (v0[0] * v0[0] + v0[1] * v0[1]) + (v0[2] * v0[2] + v0[3] * v0[3]) + (v1[0] * v1[0] + v1[1] * v1[1]) + (v1[2] * v1[2] + v1[3] * v1[3]);
                    u32x4 w; w.x = cvt_pk_bf16(v0[0], v0[1]); w.y = cvt_pk_bf16(v0[2], v0[3]); w.z = cvt_pk_bf16(v1[0], v1[1]); w.w = cvt_pk_bf16(v1[2], v1[3]);
                    *(u32x4*)(rowp + bj * 128) = w;
                }
                s += __shfl_xor(s, 16); s += __shfl_xor(s, 32);
                if (fq == 0) SS[(size_t)row * 16 + u.pn * 4 + wc] = s;
            }
    }
};
struct EpiSwiGLU {
    static constexpr bool PERM = true, AFTER_DRAIN = false;
    bf16_t* H;
    __device__ __forceinline__ void operator()(const f32x4 (&acc)[2][2][4][2], const Unit& u, int wr, int wc, int fr, int fq) const {
        const int row0 = u.pm * 256 + wr * 64 + fr, col0 = u.pn * 128 + wc * 32 + 8 * fq;
#pragma unroll
        for (int ai = 0; ai < 2; ++ai)
#pragma unroll
            for (int m = 0; m < 4; ++m) {
                const int row = row0 + ai * 128 + m * 16;
                const f32x4 g0 = acc[ai][0][m][0], g1 = acc[ai][0][m][1], u0 = acc[ai][1][m][0], u1 = acc[ai][1][m][1];
                f32x4 h0, h1;
#pragma unroll
                for (int j = 0; j < 4; ++j) { h0[j] = silu_f(g0[j]) * u0[j]; h1[j] = silu_f(g1[j]) * u1[j]; }
                u32x4 w; w.x = cvt_pk_bf16(h0[0], h0[1]); w.y = cvt_pk_bf16(h0[2], h0[3]); w.z = cvt_pk_bf16(h1[0], h1[1]); w.w = cvt_pk_bf16(h1[2], h1[3]);
                *(u32x4*)(H + (size_t)row * DFF + col0) = w;
            }
    }
};

template <class RowMap>
__device__ __forceinline__ void transpose_item(const float* W, int N, int k0, int n0, const float* kscale, bf16_t* WT, int K, RowMap rowmap, LAS float* scr, int lane) {
#pragma unroll 8
    for (int i = 0; i < 32; ++i) { const int kk = 2 * i + (lane >> 5); float w = W[(size_t)(k0 + kk) * N + n0 + (lane & 31)]; if (kscale) w *= kscale[k0 + kk]; scr[kk * 33 + (lane & 31)] = w; }
    LDS_WAIT();
    const int c = lane & 7;
#pragma unroll
    for (int j = 0; j < 4; ++j) { const int n = (lane >> 3) + 8 * j; const LAS float* s = scr + (8 * c) * 33 + n;
        u32x4 o; o.x = pk2(s[0 * 33], s[1 * 33]); o.y = pk2(s[2 * 33], s[3 * 33]); o.z = pk2(s[4 * 33], s[5 * 33]); o.w = pk2(s[6 * 33], s[7 * 33]);
        *(u32x4*)(WT + (size_t)rowmap(n0 + n) * K + k0 + 8 * c) = o; }
    LDS_WAIT();
}
struct RowId { __device__ __forceinline__ int operator()(int n) const { return n; } };
struct RowGU { int half; __device__ __forceinline__ int operator()(int n) const { return (n >> 7) * 256 + half * 128 + (n & 127); } };

struct Params {
    const float* xp; const float* xs; const float* w_in; const float* w_out; const float* lb_fwd; const float* lb_bwd; const float* g_hgrn;
    const float* g_pre_mix; const float* g_post_mix; const float* g_pre_ffn; const float* g_post_ffn; const float* w_gate; const float* w_up; const float* w_down;
    float* out; unsigned char* ws;
};
__device__ __forceinline__ const float* xrow_ptr(const Params& p, int row) { return row < ROWS_P ? p.xp + (size_t)row * DM : p.xs + (size_t)(row - ROWS_P) * DM; }

__device__ __forceinline__ void p0_prologue(const Params& p, LAS unsigned char* lds, int gw, int ngw, int wave, int lane) {
    unsigned char* dob = (unsigned char*)p.out;
    bf16_t* WIN = (bf16_t*)(dob + DO_WIN); bf16_t* WOUT = (bf16_t*)(dob + DO_WOUT); float* rope = (float*)(dob + DO_ROPE); bf16_t* XN = (bf16_t*)(dob + DO_XN);
    LAS float* scr = (LAS float*)(lds + wave * 16384);
    constexpr int I_IN = 16 * 128, I_OUT = 16 * 32;
    for (int it = gw; it < I_IN + I_OUT; it += ngw) {
        if (it < I_IN) transpose_item(p.w_in, NIN, 64 * (it / 128), 32 * (it % 128), p.g_pre_mix, WIN, DM, RowId{}, scr, lane);
        else { const int r = it - I_IN; transpose_item(p.w_out, DM, 64 * (r / 32), 32 * (r % 32), nullptr, WOUT, DM, RowId{}, scr, lane); }
    }
    {
        const int gt = gw * 64 + lane, ngt = ngw * 64;
        for (int e = gt; e < 16384 * 8; e += ngt) {
            const int pos = e >> 3, i = e & 7;
            const double rv = i == 0 ? 0.15915494309189535 : i == 1 ? 0.03086376340470123 : i == 2 ? 0.005985185712713705 : i == 3 ? 0.001160663641240061
                            : i == 4 ? 0.00022507907903927653 : i == 5 ? 4.364795279280289e-05 : i == 6 ? 8.464330808241401e-06 : 1.6414262627950345e-06;
            double a = (double)pos * rv; a -= floor(a);
            const float af = (float)a;
            rope[2 * e] = __builtin_amdgcn_cosf(af); rope[2 * e + 1] = __builtin_amdgcn_sinf(af);
        }
    }
    for (int m0 = gw * 4; m0 < T_; m0 += ngw * 4) {
        f32x4 v[4][4]; float s[4];
#pragma unroll
        for (int k = 0; k < 4; ++k) { const f32x4* xr = (const f32x4*)xrow_ptr(p, m0 + k) + lane;
#pragma unroll
            for (int j = 0; j < 4; ++j) v[k][j] = xr[64 * j]; }
#pragma unroll
        for (int k = 0; k < 4; ++k) { s[k] = 0.f;
#pragma unroll
            for (int j = 0; j < 4; ++j) s[k] += (v[k][j][0] * v[k][j][0] + v[k][j][1] * v[k][j][1]) + (v[k][j][2] * v[k][j][2] + v[k][j][3] * v[k][j][3]); }
#pragma unroll
        for (int k = 0; k < 4; ++k) {
            const float rstd = rsqrtf(wave_sum(s[k]) * (1.f / DM) + EPS);
            u32x2v* o8 = (u32x2v*)(XN + (size_t)(m0 + k) * DM) + lane;
#pragma unroll
            for (int j = 0; j < 4; ++j) { u32x2v w; w.x = cvt_pk_bf16(v[k][j][0] * rstd, v[k][j][1] * rstd); w.y = cvt_pk_bf16(v[k][j][2] * rstd, v[k][j][3] * rstd); o8[64 * j] = w; }
        }
    }
}

__device__ __forceinline__ void attn_simple(const bf16_t* U, bf16_t* MIXIN, int gw, int ngw, int lane) {
    for (int item = gw; item < T_ * 8; item += ngw) {
        const int row = item >> 3, h = item & 7;
        const int pos = row_pos(row), S = row_S(row), base = row - pos;
        float q[64];
        { const u32x4* qp = (const u32x4*)(U + (size_t)row * NIN + UC_QA + h * 64);
#pragma unroll
          for (int c = 0; c < 8; ++c) { const u32x4 w = qp[c];
              q[8 * c + 0] = __uint_as_float(w.x << 16); q[8 * c + 1] = __uint_as_float(w.x & 0xffff0000u);
              q[8 * c + 2] = __uint_as_float(w.y << 16); q[8 * c + 3] = __uint_as_float(w.y & 0xffff0000u);
              q[8 * c + 4] = __uint_as_float(w.z << 16); q[8 * c + 5] = __uint_as_float(w.z & 0xffff0000u);
              q[8 * c + 6] = __uint_as_float(w.w << 16); q[8 * c + 7] = __uint_as_float(w.w & 0xffff0000u); } }
        float s[9];
#pragma unroll
        for (int b = 0; b < 3; ++b)
#pragma unroll
            for (int r = 0; r < 3; ++r) {
                const int dil = 1 << (2 * b), j = -64 + 64 * r + lane, kp = pos + j * dil;
                const bool valid = (r < 2 || lane == 0) && kp >= 0 && kp < S;
                float d = -1e30f;
                if (valid) {
                    const u32x4* kq = (const u32x4*)(U + (size_t)(base + kp) * NIN + UC_KA + h * 64);
                    float a = 0.f;
#pragma unroll
                    for (int c = 0; c < 8; ++c) { const u32x4 w = kq[c];
                        a += q[8 * c + 0] * __uint_as_float(w.x << 16) + q[8 * c + 1] * __uint_as_float(w.x & 0xffff0000u)
                           + q[8 * c + 2] * __uint_as_float(w.y << 16) + q[8 * c + 3] * __uint_as_float(w.y & 0xffff0000u)
                           + q[8 * c + 4] * __uint_as_float(w.z << 16) + q[8 * c + 5] * __uint_as_float(w.z & 0xffff0000u)
                           + q[8 * c + 6] * __uint_as_float(w.w << 16) + q[8 * c + 7] * __uint_as_float(w.w & 0xffff0000u); }
                    d = a;
                }
                s[b * 3 + r] = d;
            }
        float mx = s[0];
#pragma unroll
        for (int i = 1; i < 9; ++i) mx = fmaxf(mx, s[i]);
        mx = wave_max(mx);
        float l = 0.f;
#pragma unroll
        for (int i = 0; i < 9; ++i) { s[i] = __expf(s[i] - mx); l += s[i]; }
        l = wave_sum(l);
        float o = 0.f;
        const bf16_t* vbase = U + UC_VA + h * 64 + lane;
#pragma unroll
        for (int b = 0; b < 3; ++b)
#pragma unroll
            for (int r = 0; r < 3; ++r) {
                const int dil = 1 << (2 * b), cnt = (r < 2) ? 64 : 1;
                for (int jj = 0; jj < cnt; ++jj) {
                    const float pj = __shfl(s[b * 3 + r], jj);
                    const int kp = pos + (-64 + 64 * r + jj) * dil;
                    if (kp >= 0 && kp < S) o += pj * bf2f(vbase[(size_t)(base + kp) * NIN]);
                }
            }
        MIXIN[(size_t)row * DM + h * 64 + lane] = f2bf(o / l);
    }
}

namespace at {
typedef short bf16x8 __attribute__((ext_vector_type(8)));
typedef short s16x4 __attribute__((ext_vector_type(4)));
constexpr int OS = 65;
constexpr int L_OUT = 0, L_L = 256 * OS * 4, L_VS = L_L + 1024, VS_STRIDE = 144, VS_WAVE = 32 * VS_STRIDE, L_END = L_VS + 8 * VS_WAVE;
static_assert(L_END <= LDS_BYTES, "attention LDS map");

__device__ __forceinline__ void wave_tile(const bf16_t* U, LAS unsigned char* lds, int w, int lane, int base, int S, int P0, int h, int idx) {
    const int n = lane & 15, quad = lane >> 4;
    const int br = idx >> 4, sub = idx & 15;
    const int dsh = 2 * br, dil = 1 << dsh;
    const int r = br == 0 ? 0 : (br == 1 ? (sub & 3) : sub);
    const int mt = br == 0 ? sub : (br == 1 ? (sub >> 2) : 0);
    const int Lsub = S >> dsh, m0 = (P0 >> dsh) + 16 * mt;
    const bf16_t* Ub = U + (size_t)base * NIN + h * 64;
    bf16x8 qf[2];
    { const bf16_t* qp = Ub + (size_t)((m0 + n) * dil + r) * NIN + UC_QA + 8 * quad; qf[0] = *(const bf16x8*)qp; qf[1] = *(const bf16x8*)(qp + 32); }
    bf16x8 kf[9][2];
#pragma unroll
    for (int kt = 0; kt < 9; ++kt) {
        int mk = m0 - 64 + 16 * kt + n; mk = mk < 0 ? 0 : (mk >= Lsub ? Lsub - 1 : mk);
        const bf16_t* kp = Ub + (size_t)(mk * dil + r) * NIN + UC_KA + 8 * quad; kf[kt][0] = *(const bf16x8*)kp; kf[kt][1] = *(const bf16x8*)(kp + 32);
    }
    u32x4 vr[5][4];
#pragma unroll
    for (int t = 0; t < 5; ++t)
#pragma unroll
        for (int e = 0; e < 4; ++e) {
            const int id = lane + 64 * e, rho = id >> 3, ch = id & 7;
            int mk = m0 - 64 + 32 * t + rho; mk = mk < 0 ? 0 : (mk >= Lsub ? Lsub - 1 : mk);
            vr[t][e] = *(const u32x4*)(Ub + (size_t)(mk * dil + r) * NIN + UC_VA + 8 * ch);
        }
    unsigned pk[10][2];
    float lsum = 0.f;
#pragma unroll
    for (int kt = 0; kt < 9; ++kt) {
        f32x4 sc = {0.f, 0.f, 0.f, 0.f};
        sc = __builtin_amdgcn_mfma_f32_16x16x32_bf16(kf[kt][0], qf[0], sc, 0, 0, 0);
        sc = __builtin_amdgcn_mfma_f32_16x16x32_bf16(kf[kt][1], qf[1], sc, 0, 0, 0);
        float pv[4];
#pragma unroll
        for (int j = 0; j < 4; ++j) {
            const int ko = 16 * kt + 4 * quad + j, mk = m0 - 64 + ko;
            const bool valid = (ko >= n) && (ko <= n + 128) && (mk >= 0) && (mk < Lsub);
            const float e = __expf(fminf(sc[j], 80.f));
            pv[j] = valid ? e : 0.f; lsum += pv[j];
        }
        pk[kt][0] = cvt_pk_bf16(pv[0], pv[1]); pk[kt][1] = cvt_pk_bf16(pv[2], pv[3]);
    }
    pk[9][0] = 0u; pk[9][1] = 0u;
    lsum += __shfl_xor(lsum, 16); lsum += __shfl_xor(lsum, 32);
    f32x4 ot[4];
#pragma unroll
    for (int dt = 0; dt < 4; ++dt) ot[dt] = (f32x4){0.f, 0.f, 0.f, 0.f};
    LAS unsigned char* vs = lds + L_VS + w * VS_WAVE;
#pragma unroll
    for (int t = 0; t < 5; ++t) {
#pragma unroll
        for (int e = 0; e < 4; ++e) { const int id = lane + 64 * e, rho = id >> 3, ch = id & 7; *(LAS u32x4*)(vs + rho * VS_STRIDE + ch * 16) = vr[t][e]; }
        bf16x8 pf; { u32x4 pw = {pk[2 * t][0], pk[2 * t][1], pk[2 * t + 1][0], pk[2 * t + 1][1]}; pf = __builtin_bit_cast(bf16x8, pw); }
#pragma unroll
        for (int dt = 0; dt < 4; ++dt) {
            const int q = (lane & 15) >> 2, pp = lane & 3;
            const s16x4 lo = __builtin_amdgcn_ds_read_tr16_b64_v4i16((LAS s16x4*)(vs + (4 * quad + q) * VS_STRIDE + (16 * dt + 4 * pp) * 2));
            const s16x4 hi = __builtin_amdgcn_ds_read_tr16_b64_v4i16((LAS s16x4*)(vs + (16 + 4 * quad + q) * VS_STRIDE + (16 * dt + 4 * pp) * 2));
            const bf16x8 vf = {lo[0], lo[1], lo[2], lo[3], hi[0], hi[1], hi[2], hi[3]};
            ot[dt] = __builtin_amdgcn_mfma_f32_16x16x32_bf16(vf, pf, ot[dt], 0, 0, 0);
        }
    }
    const int posl = ((m0 + n) * dil + r) - P0;
    LAS float* op = (LAS float*)(lds + L_OUT) + posl * OS + 4 * quad;
    LAS float* lp = (LAS float*)(lds + L_L) + posl;
    if (br == 0) {
#pragma unroll
        for (int dt = 0; dt < 4; ++dt)
#pragma unroll
            for (int j = 0; j < 4; ++j) op[16 * dt + j] = ot[dt][j];
        if (quad == 0) *lp = lsum;
    } else {
        float old[16];
#pragma unroll
        for (int dt = 0; dt < 4; ++dt)
#pragma unroll
            for (int j = 0; j < 4; ++j) old[4 * dt + j] = op[16 * dt + j];
        const float lo = *lp;
#pragma unroll
        for (int dt = 0; dt < 4; ++dt)
#pragma unroll
            for (int j = 0; j < 4; ++j) op[16 * dt + j] = old[4 * dt + j] + ot[dt][j];
        if (quad == 0) *lp = lo + lsum;
    }
}

__device__ __forceinline__ void attn_phase(const bf16_t* U, bf16_t* MIXIN, LAS unsigned char* lds, int blk, int G) {
    const int tid = otid(), lane = tid & 63, w = __builtin_amdgcn_readfirstlane(tid >> 6);
    __syncthreads();
    for (int u = blk; u < 2048; u += G) {
        int grp = u >> 3, h = u & 7;
        if (G == 256) { const int x = u & 7, j = (u >> 3) & 31, e8 = u >> 8; h = j & 7; grp = 32 * x + 4 * e8 + (j >> 3); }
        const int row0 = grp * 256;
        const int base = row0 < ROWS_P ? (row0 & ~16383) : (ROWS_P + ((row0 - ROWS_P) & ~4095)), S = row0 < ROWS_P ? 16384 : 4096, P0 = row0 - base;
        for (int br = 0; br < 3; ++br) {
            wave_tile(U, lds, w, lane, base, S, P0, h, 16 * br + w);
            wave_tile(U, lds, w, lane, base, S, P0, h, 16 * br + w + 8);
            __syncthreads();
        }
        {
            const int pos = tid >> 1, half = tid & 1;
            const LAS float* op = (const LAS float*)(lds + L_OUT) + pos * OS + 32 * half;
            const float inv = 1.f / ((const LAS float*)(lds + L_L))[pos];
            unsigned wv[16];
#pragma unroll
            for (int d = 0; d < 16; ++d) wv[d] = cvt_pk_bf16(op[2 * d] * inv, op[2 * d + 1] * inv);
            u32x4* gp = (u32x4*)(MIXIN + (size_t)(row0 + pos) * DM + h * 64 + 32 * half);
#pragma unroll
            for (int c = 0; c < 4; ++c) gp[c] = (u32x4){wv[4 * c], wv[4 * c + 1], wv[4 * c + 2], wv[4 * c + 3]};
        }
        __syncthreads();
    }
}
}

__device__ __forceinline__ void hgrn_simple(const Params& p, const bf16_t* U, bf16_t* MIXIN, LAS unsigned char* lds, int blk, int nblk) {
    LAS f32x2v* fqb = (LAS f32x2v*)lds;
    LAS float* po = (LAS float*)(lds + 2048);
    const int tid = threadIdx.x, vcol = tid & 127, kq = tid >> 7;
    for (int item = blk; item < 40; item += nblk) {
        const int sb = item >> 2, hh = item & 3;
        const int base = sb < 2 ? sb * 16384 : ROWS_P + (sb - 2) * 4096, S = sb < 2 ? 16384 : 4096;
        for (int dir = 1; dir >= 0; --dir) {
            const float* lbr = dir ? p.lb_bwd : p.lb_fwd;
            float lb = 0.f;
            if (tid < 128) { const int c = hh * 128 + tid; lb = 1.f / (1.f + __expf(lbr[512 + c] - lbr[c])); }
            const int zcol = (dir ? UC_ZB : UC_ZF) + hh * 128;
            float St[32];
#pragma unroll
            for (int k = 0; k < 32; ++k) St[k] = 0.f;
            int buf = 0;
            __syncthreads();
            for (int i = 0; i < S; ++i) {
                const int t = dir ? (S - 1 - i) : i;
                const size_t ro = (size_t)(base + t) * NIN;
                if (tid < 128) { const float z = bf2f(U[ro + zcol + tid]), qr = bf2f(U[ro + UC_QH + hh * 128 + tid]);
                    const float f = lb + (1.f - lb) * sigmoid_f(z); fqb[buf * 128 + tid] = (f32x2v){f, silu_f(qr)}; }
                const float v = bf2f(U[ro + UC_IH + hh * 128 + vcol]);
                __syncthreads();
                if (kq == 0 && i > 0) {
                    const LAS float* pp = po + (buf ^ 1) * 512 + vcol; const float o = (pp[0] + pp[128]) + (pp[256] + pp[384]);
                    const int tp = dir ? (S - i) : (i - 1);
                    const size_t mo = (size_t)(base + tp) * DM + 512 + hh * 128 + vcol;
                    if (dir) MIXIN[mo] = f2bf(o); else MIXIN[mo] = f2bf(o + bf2f(MIXIN[mo]));
                }
                float part = 0.f;
#pragma unroll
                for (int kk = 0; kk < 32; ++kk) { const f32x2v fq = fqb[buf * 128 + kq * 32 + kk]; St[kk] = fq.x * St[kk] + (1.f - fq.x) * v; part += fq.y * St[kk]; }
                po[buf * 512 + kq * 128 + vcol] = part;
                buf ^= 1;
            }
            __syncthreads();
            if (kq == 0) {
                const LAS float* pp = po + (buf ^ 1) * 512 + vcol; const float o = (pp[0] + pp[128]) + (pp[256] + pp[384]);
                const int tp = dir ? 0 : (S - 1);
                const size_t mo = (size_t)(base + tp) * DM + 512 + hh * 128 + vcol;
                if (dir) MIXIN[mo] = f2bf(o); else MIXIN[mo] = f2bf(o + bf2f(MIXIN[mo]));
            }
        }
    }
}


namespace hg {
typedef short bf16x8 __attribute__((ext_vector_type(8)));
constexpr int SEG = 1024, NCH = 16, NITEM = 512;
constexpr int RS = 272, TS = 144;
constexpr int L_QT = 0, L_QR = 17408, L_KR = 34816, L_K0 = 52224, L_Q4 = 56576, L_KT = 60928, L_VT = 79360, L_ST = 97792, L_AB = 132608, L_TOT = 141824, L_BV = 143872, L_END = 144384;
static_assert(L_END <= LDS_BYTES, "hgrn LDS map");
constexpr size_t DO_STATE = 140 * MiB, DO_DEC = 172 * MiB, DO_OB = 176 * MiB, DO_INIT = 240 * MiB;

__device__ __forceinline__ int phys_row(int g, int dir, int lt) { return dir ? (g * SEG + SEG - 1 - lt) : (g * SEG + lt); }
__device__ __forceinline__ unsigned short bf1(float x) { __bf16 b = (__bf16)x; return __builtin_bit_cast(unsigned short, b); }
__device__ __forceinline__ bf16x8 ldfrag(LAS unsigned char* lds, int off, int stride, int row0, int kel, int lane) {
    return *(const LAS bf16x8*)(lds + off + (row0 + (lane & 15)) * stride + (kel + 8 * (lane >> 4)) * 2);
}
template <bool FULL>
__device__ __forceinline__ void load_raw(const bf16_t* U, int g, int dir, int ch, int i, int zcol, int qcol, int vcol, unsigned short (&rz)[16], unsigned short (&rq)[16], unsigned short (&rv)[16]) {
#pragma unroll
    for (int r = 0; r < 16; ++r) {
        const bf16_t* pr = U + (size_t)phys_row(g, dir, 64 * ch + 16 * i + r) * NIN;
        rz[r] = pr[zcol]; if (FULL) rq[r] = pr[qcol]; rv[r] = pr[vcol];
    }
}
template <bool FULL>
__device__ __forceinline__ void prep(LAS unsigned char* lds, int i, int c, float lb, const unsigned short (&rz)[16], const unsigned short (&rq)[16], const unsigned short (&rv)[16], float& bdec) {
    float f[16], e1[16], qs[16];
    float run = 1.f;
#pragma unroll
    for (int r = 0; r < 16; ++r) {
        const float fr = lb + (1.f - lb) * sigmoid_f(bf2f(rz[r]));
        f[r] = fr; run *= fr; e1[r] = run;
        if (FULL) qs[r] = silu_f(bf2f(rq[r])); else qs[r] = 0.f;
    }
    ((LAS float*)(lds + L_TOT))[i * 128 + c] = run;
    {
        u32x4 a, b;
        a.x = rv[0] | ((unsigned)rv[1] << 16); a.y = rv[2] | ((unsigned)rv[3] << 16); a.z = rv[4] | ((unsigned)rv[5] << 16); a.w = rv[6] | ((unsigned)rv[7] << 16);
        b.x = rv[8] | ((unsigned)rv[9] << 16); b.y = rv[10] | ((unsigned)rv[11] << 16); b.z = rv[12] | ((unsigned)rv[13] << 16); b.w = rv[14] | ((unsigned)rv[15] << 16);
        LAS u32x4* vp = (LAS u32x4*)(lds + L_VT + c * TS + 32 * i); vp[0] = a; vp[1] = b;
    }
    __syncthreads();
    const LAS float* tp = (const LAS float*)(lds + L_TOT) + c;
    const float p0 = tp[0], p1 = tp[128], p2 = tp[256], p3 = tp[384];
    const float cQT = i == 0 ? 1.f : i == 1 ? p0 : i == 2 ? p0 * p1 : p0 * p1 * p2;
    const float cKT = i == 0 ? p1 * p2 * p3 : i == 1 ? p2 * p3 : i == 2 ? p3 : 1.f;
    const float cQR = i == 0 ? 1.f : i == 1 ? __builtin_amdgcn_rcpf(p1) : i == 2 ? 1.f : p2;
    const float cKR = i == 0 ? p1 : i == 1 ? 1.f : i == 2 ? __builtin_amdgcn_rcpf(p2) : 1.f;
    const float cK0 = __builtin_amdgcn_rcpf(p0), cQ4 = __builtin_amdgcn_rcpf(p3);
    bdec = (p0 * p1) * (p2 * p3);
    if (i == 0) ((LAS float*)(lds + L_BV))[c] = bdec;
    unsigned short kt[16];
    float e2 = 1.f;
#pragma unroll
    for (int r = 15; r >= 0; --r) {
        const float kb = (1.f - f[r]) * e2;
        kt[r] = bf1(kb * cKT);
        if (FULL) {
            *(LAS unsigned short*)(lds + L_KR + (16 * i + r) * RS + c * 2) = bf1(kb * cKR);
            if (i == 0) *(LAS unsigned short*)(lds + L_K0 + r * RS + c * 2) = bf1(kb * cK0);
        }
        e2 *= f[r];
    }
    {
        u32x4 a, b;
        a.x = kt[0] | ((unsigned)kt[1] << 16); a.y = kt[2] | ((unsigned)kt[3] << 16); a.z = kt[4] | ((unsigned)kt[5] << 16); a.w = kt[6] | ((unsigned)kt[7] << 16);
        b.x = kt[8] | ((unsigned)kt[9] << 16); b.y = kt[10] | ((unsigned)kt[11] << 16); b.z = kt[12] | ((unsigned)kt[13] << 16); b.w = kt[14] | ((unsigned)kt[15] << 16);
        LAS u32x4* kp = (LAS u32x4*)(lds + L_KT + c * TS + 32 * i); kp[0] = a; kp[1] = b;
    }
    if (FULL) {
#pragma unroll
        for (int r = 0; r < 16; ++r) {
            const float qe = qs[r] * e1[r];
            *(LAS unsigned short*)(lds + L_QT + (16 * i + r) * RS + c * 2) = bf1(qe * cQT);
            *(LAS unsigned short*)(lds + L_QR + (16 * i + r) * RS + c * 2) = bf1(qe * cQR);
            if (i == 3) *(LAS unsigned short*)(lds + L_Q4 + r * RS + c * 2) = bf1(qe * cQ4);
        }
    }
}
__device__ __forceinline__ void state_update(LAS unsigned char* lds, f32x4 (&S)[8], int w, int gq, int lane) {
    bf16x8 ktf[2];
#pragma unroll
    for (int k2 = 0; k2 < 2; ++k2) ktf[k2] = ldfrag(lds, L_KT, TS, 16 * w, 32 * k2, lane);
    const f32x4 dk = *(const LAS f32x4*)(lds + L_BV + (16 * w + 4 * gq) * 4);
#pragma unroll
    for (int n = 0; n < 8; ++n) {
        S[n] = S[n] * dk;
#pragma unroll
        for (int k2 = 0; k2 < 2; ++k2) S[n] = __builtin_amdgcn_mfma_f32_16x16x32_bf16(ktf[k2], ldfrag(lds, L_VT, TS, 16 * n, 32 * k2, lane), S[n], 0, 0, 0);
    }
}
__device__ __forceinline__ int item_of(int lin, int G) {
    if (G != 256) return lin;
    const int x = lin & 7, j = (lin >> 3) & 31, e = lin >> 8, g = 8 * x + 2 * (j >> 3) + e, hd = j & 7;
    return g * 8 + hd;
}
__device__ __forceinline__ float lb_of(const Params& p, int dir, int col) { const float* lbr = dir ? p.lb_bwd : p.lb_fwd; return 1.f / (1.f + __expf(lbr[512 + col] - lbr[col])); }

__device__ __forceinline__ void pass1(const Params& p, const bf16_t* U, LAS unsigned char* lds, int item) {
    const int tid = otid(), lane = tid & 63, w = __builtin_amdgcn_readfirstlane(tid >> 6), i = w >> 1, c = tid & 127, gq = lane >> 4;
    const int dir = item & 1, hh = (item >> 1) & 3, g = item >> 3;
    float* STATE = (float*)((unsigned char*)p.out + DO_STATE); float* DEC = (float*)((unsigned char*)p.out + DO_DEC);
    const float lb = lb_of(p, dir, hh * 128 + c);
    const int zcol = (dir ? UC_ZB : UC_ZF) + hh * 128 + c, qcol = UC_QH + hh * 128 + c, vcol = UC_IH + hh * 128 + c;
    f32x4 S[8];
#pragma unroll
    for (int n = 0; n < 8; ++n) S[n] = (f32x4){0.f, 0.f, 0.f, 0.f};
    float dtot = 1.f;
    unsigned short rz[16], rq[16], rv[16];
    load_raw<false>(U, g, dir, 0, i, zcol, qcol, vcol, rz, rq, rv);
    for (int ch = 0; ch < NCH; ++ch) {
        float bdec;
        prep<false>(lds, i, c, lb, rz, rq, rv, bdec);
        dtot *= bdec;
        if (ch + 1 < NCH) load_raw<false>(U, g, dir, ch + 1, i, zcol, qcol, vcol, rz, rq, rv);
        __syncthreads();
        state_update(lds, S, w, gq, lane);
        __syncthreads();
    }
    float* sp = STATE + (size_t)item * 16384 + (16 * w + 4 * gq) * 128 + (lane & 15);
#pragma unroll
    for (int n = 0; n < 8; ++n)
#pragma unroll
        for (int jj = 0; jj < 4; ++jj) sp[jj * 128 + 16 * n] = S[n][jj];
    if (i == 0) DEC[item * 128 + c] = dtot;
}
__device__ __forceinline__ void scan(const Params& p, int gt, int ngt) {
    const float* STATE = (const float*)((unsigned char*)p.out + DO_STATE); const float* DEC = (const float*)((unsigned char*)p.out + DO_DEC);
    bf16_t* INIT = (bf16_t*)((unsigned char*)p.out + DO_INIT);
    for (int e = gt; e < 80 * 4096; e += ngt) {
        const int chain = e >> 12, q4 = e & 4095, k = q4 >> 5;
        const int dir = chain & 1, hh = (chain >> 1) & 3, sb = chain >> 3;
        const int nseg = sb < 2 ? 16 : 4, g0 = sb < 2 ? sb * 16 : 32 + (sb - 2) * 4;
        f32x4 s = {0.f, 0.f, 0.f, 0.f};
        for (int j = 0; j < nseg; ++j) {
            const int g = dir ? (g0 + nseg - 1 - j) : (g0 + j), item = (g * 4 + hh) * 2 + dir;
            const f32x4 en = *((const f32x4*)(STATE + (size_t)item * 16384) + q4);
            u32x2v wv; wv.x = cvt_pk_bf16(s[0], s[1]); wv.y = cvt_pk_bf16(s[2], s[3]);
            *((u32x2v*)(INIT + (size_t)item * 16384) + q4) = wv;
            s = s * DEC[item * 128 + k] + en;
        }
    }
}
__device__ __forceinline__ void pass2(const Params& p, const bf16_t* U, bf16_t* MIXIN, LAS unsigned char* lds, int item) {
    const int tid = otid(), lane = tid & 63, w = __builtin_amdgcn_readfirstlane(tid >> 6), i = w >> 1, c = tid & 127, gq = lane >> 4;
    const int dir = item & 1, hh = (item >> 1) & 3, g = item >> 3;
    const bf16_t* INIT = (const bf16_t*)((unsigned char*)p.out + DO_INIT);
    bf16_t* OUT = dir ? (bf16_t*)((unsigned char*)p.out + DO_OB) + hh * 128 : MIXIN + 512 + hh * 128;
    const int opitch = dir ? 512 : DM;
    const float lb = lb_of(p, dir, hh * 128 + c);
    const int zcol = (dir ? UC_ZB : UC_ZF) + hh * 128 + c, qcol = UC_QH + hh * 128 + c, vcol = UC_IH + hh * 128 + c;
    for (int idx = tid; idx < 64 * TS / 4; idx += 512) ((LAS unsigned*)(lds + L_AB))[idx] = 0u;
    f32x4 S[8];
    {
        const bf16_t* sp = INIT + (size_t)item * 16384 + (16 * w + 4 * gq) * 128 + (lane & 15);
#pragma unroll
        for (int n = 0; n < 8; ++n)
#pragma unroll
            for (int jj = 0; jj < 4; ++jj) S[n][jj] = bf2f(sp[jj * 128 + 16 * n]);
    }
#define HG_ST_WRITE() do { _Pragma("unroll") for (int n = 0; n < 8; ++n) { u32x2v wv; wv.x = cvt_pk_bf16(S[n][0], S[n][1]); wv.y = cvt_pk_bf16(S[n][2], S[n][3]); \
        *(LAS u32x2v*)(lds + L_ST + (16 * n + (lane & 15)) * RS + (16 * w + 4 * gq) * 2) = wv; } } while (0)
    HG_ST_WRITE();
    unsigned short rz[16], rq[16], rv[16];
    load_raw<true>(U, g, dir, 0, i, zcol, qcol, vcol, rz, rq, rv);
    for (int ch = 0; ch < NCH; ++ch) {
        float bdec;
        prep<true>(lds, i, c, lb, rz, rq, rv, bdec);
        if (ch + 1 < NCH) load_raw<true>(U, g, dir, ch + 1, i, zcol, qcol, vcol, rz, rq, rv);
        __syncthreads();
        for (int bi = w; bi < 10; bi += 8) {
            const int ti = bi >= 6 ? 3 : bi >= 3 ? 2 : bi >= 1 ? 1 : 0, tj = bi - ti * (ti + 1) / 2;
            const int qoff = (bi == 9) ? L_Q4 : L_QR + 16 * ti * RS, koff = (bi == 0) ? L_K0 : L_KR + 16 * tj * RS;
            f32x4 a = {0.f, 0.f, 0.f, 0.f};
#pragma unroll
            for (int ks = 0; ks < 4; ++ks) a = __builtin_amdgcn_mfma_f32_16x16x32_bf16(ldfrag(lds, qoff, RS, 0, 32 * ks, lane), ldfrag(lds, koff, RS, 0, 32 * ks, lane), a, 0, 0, 0);
#pragma unroll
            for (int jj = 0; jj < 4; ++jj) {
                float val = a[jj];
                if (ti == tj && (lane & 15) > 4 * gq + jj) val = 0.f;
                *(LAS unsigned short*)(lds + L_AB + (16 * ti + 4 * gq + jj) * TS + (16 * tj + (lane & 15)) * 2) = bf1(val);
            }
        }
        __syncthreads();
        {
            bf16x8 stf[4], vtf[2];
#pragma unroll
            for (int ks = 0; ks < 4; ++ks) stf[ks] = ldfrag(lds, L_ST, RS, 16 * w, 32 * ks, lane);
#pragma unroll
            for (int k2 = 0; k2 < 2; ++k2) vtf[k2] = ldfrag(lds, L_VT, TS, 16 * w, 32 * k2, lane);
#pragma unroll
            for (int mt = 0; mt < 4; ++mt) {
                f32x4 o = {0.f, 0.f, 0.f, 0.f};
#pragma unroll
                for (int ks = 0; ks < 4; ++ks) o = __builtin_amdgcn_mfma_f32_16x16x32_bf16(ldfrag(lds, L_QT, RS, 16 * mt, 32 * ks, lane), stf[ks], o, 0, 0, 0);
#pragma unroll
                for (int k2 = 0; k2 < 2; ++k2) o = __builtin_amdgcn_mfma_f32_16x16x32_bf16(ldfrag(lds, L_AB, TS, 16 * mt, 32 * k2, lane), vtf[k2], o, 0, 0, 0);
#pragma unroll
                for (int jj = 0; jj < 4; ++jj) {
                    const int row = phys_row(g, dir, 64 * ch + 16 * mt + 4 * gq + jj);
                    OUT[(size_t)row * opitch + 16 * w + (lane & 15)] = bf1(o[jj]);
                }
            }
        }
        state_update(lds, S, w, gq, lane);
        __syncthreads();
        HG_ST_WRITE();
    }
#undef HG_ST_WRITE
}
}

__device__ __forceinline__ void hg_finalize(const Params& p, const bf16_t* U, bf16_t* MIXIN, int blk, int G, int wave, int lane) {
    const float gn0 = p.g_hgrn[2 * lane], gn1 = p.g_hgrn[2 * lane + 1];
    const bf16_t* OB = (const bf16_t*)((const unsigned char*)p.out + hg::DO_OB);
    const int gw = blk * 8 + wave, ngw = G * 8;
    for (int row = gw; row < T_; row += ngw) {
#pragma unroll
        for (int hh = 0; hh < 4; ++hh) {
            unsigned* mp = (unsigned*)(MIXIN + (size_t)row * DM + 512 + hh * 128) + lane;
            const unsigned w = *mp, gw2 = *((const unsigned*)(U + (size_t)row * NIN + UC_GH + hh * 128) + lane);
            const unsigned wb = *((const unsigned*)(OB + (size_t)row * 512 + hh * 128) + lane);
            const float o0 = __uint_as_float(w << 16) + __uint_as_float(wb << 16), o1 = __uint_as_float(w & 0xffff0000u) + __uint_as_float(wb & 0xffff0000u);
            const float g0 = __uint_as_float(gw2 << 16), g1 = __uint_as_float(gw2 & 0xffff0000u);
            const float rs = rsqrtf(wave_sum(o0 * o0 + o1 * o1) * (1.f / 128.f) + EPS);
            *mp = cvt_pk_bf16(o0 * rs * gn0 * silu_f(g0), o1 * rs * gn1 * silu_f(g1));
        }
    }
}

__device__ __forceinline__ void p6_rows(const Params& p, LAS unsigned char* lds, int gw, int ngw, int wave, int lane) {
    bf16_t* WGU = (bf16_t*)(p.ws + WS_WGU); bf16_t* WDN = (bf16_t*)(p.ws + WS_WDN);
    LAS float* scr = (LAS float*)(lds + wave * 16384);
    constexpr int I_G = 16 * 88, I_D = 44 * 32;
    for (int it = gw; it < 2 * I_G + I_D; it += ngw) {
        if (it < I_G) transpose_item(p.w_gate, DFF, 64 * (it / 88), 32 * (it % 88), p.g_pre_ffn, WGU, DM, RowGU{0}, scr, lane);
        else if (it < 2 * I_G) { const int r = it - I_G; transpose_item(p.w_up, DFF, 64 * (r / 88), 32 * (r % 88), p.g_pre_ffn, WGU, DM, RowGU{1}, scr, lane); }
        else { const int r = it - 2 * I_G; transpose_item(p.w_down, DM, 64 * (r / 32), 32 * (r % 32), nullptr, WDN, DFF, RowId{}, scr, lane); }
    }
    bf16_t* MIX = (bf16_t*)(p.ws + WS_MIX); const float* SS = (const float*)(p.ws + WS_SS1);
    f32x4 gp[4];
#pragma unroll
    for (int j = 0; j < 4; ++j) gp[j] = ((const f32x4*)p.g_post_mix)[lane + 64 * j];
    for (int m0 = gw * 4; m0 < T_; m0 += ngw * 4) {
        f32x4 xv[4][4]; u32x2v mw[4][4]; float r1[4];
#pragma unroll
        for (int k = 0; k < 4; ++k) {
            const int m = m0 + k;
            const f32x4* ssp = (const f32x4*)(SS + (size_t)m * 16);
            const f32x4 a = ssp[0], b = ssp[1], c = ssp[2], d = ssp[3];
            const float ss = ((a[0] + a[1]) + (a[2] + a[3])) + ((b[0] + b[1]) + (b[2] + b[3])) + ((c[0] + c[1]) + (c[2] + c[3])) + ((d[0] + d[1]) + (d[2] + d[3]));
            r1[k] = rsqrtf(ss * (1.f / DM) + EPS);
            const f32x4* xr = (const f32x4*)xrow_ptr(p, m) + lane;
            const u32x2v* mx = (const u32x2v*)(MIX + (size_t)m * DM) + lane;
#pragma unroll
            for (int jj = 0; jj < 4; ++jj) { xv[k][jj] = xr[64 * jj]; mw[k][jj] = mx[64 * jj]; }
        }
        float s2[4];
#pragma unroll
        for (int k = 0; k < 4; ++k) {
            f32x4* xo = (f32x4*)(p.out + (size_t)(m0 + k) * DM) + lane;
            s2[k] = 0.f;
#pragma unroll
            for (int jj = 0; jj < 4; ++jj) {
                const u32x2v w = mw[k][jj];
                f32x4 mv = {__uint_as_float(w.x << 16), __uint_as_float(w.x & 0xffff0000u), __uint_as_float(w.y << 16), __uint_as_float(w.y & 0xffff0000u)};
                xv[k][jj] = xv[k][jj] + mv * r1[k] * gp[jj];
                s2[k] += (xv[k][jj][0] * xv[k][jj][0] + xv[k][jj][1] * xv[k][jj][1]) + (xv[k][jj][2] * xv[k][jj][2] + xv[k][jj][3] * xv[k][jj][3]);
                xo[64 * jj] = xv[k][jj];
            }
        }
#pragma unroll
        for (int k = 0; k < 4; ++k) {
            const float r2 = rsqrtf(wave_sum(s2[k]) * (1.f / DM) + EPS);
            u32x2v* mx = (u32x2v*)(MIX + (size_t)(m0 + k) * DM) + lane;
#pragma unroll
            for (int jj = 0; jj < 4; ++jj) { u32x2v w; w.x = cvt_pk_bf16(xv[k][jj][0] * r2, xv[k][jj][1] * r2); w.y = cvt_pk_bf16(xv[k][jj][2] * r2, xv[k][jj][3] * r2); mx[64 * jj] = w; }
        }
    }
}
__device__ __forceinline__ void p9_rows(const Params& p, int gw, int ngw, int lane) {
    const bf16_t* FF = (const bf16_t*)(p.ws + WS_MIX); const float* SS = (const float*)(p.ws + WS_SS2);
    f32x4 gp[4];
#pragma unroll
    for (int j = 0; j < 4; ++j) gp[j] = ((const f32x4*)p.g_post_ffn)[lane + 64 * j];
    for (int m0 = gw * 4; m0 < T_; m0 += ngw * 4) {
        f32x4 xv[4][4]; u32x2v fw[4][4]; float r1[4];
#pragma unroll
        for (int k = 0; k < 4; ++k) {
            const int m = m0 + k;
            const f32x4* ssp = (const f32x4*)(SS + (size_t)m * 16);
            const f32x4 a = ssp[0], b = ssp[1], c = ssp[2], d = ssp[3];
            const float ss = ((a[0] + a[1]) + (a[2] + a[3])) + ((b[0] + b[1]) + (b[2] + b[3])) + ((c[0] + c[1]) + (c[2] + c[3])) + ((d[0] + d[1]) + (d[2] + d[3]));
            r1[k] = rsqrtf(ss * (1.f / DM) + EPS);
            const u32x2v* fx = (const u32x2v*)(FF + (size_t)m * DM) + lane;
            const f32x4* xo = (const f32x4*)(p.out + (size_t)m * DM) + lane;
#pragma unroll
            for (int jj = 0; jj < 4; ++jj) { xv[k][jj] = xo[64 * jj]; fw[k][jj] = fx[64 * jj]; }
        }
#pragma unroll
        for (int k = 0; k < 4; ++k) {
            f32x4* xo = (f32x4*)(p.out + (size_t)(m0 + k) * DM) + lane;
#pragma unroll
            for (int jj = 0; jj < 4; ++jj) {
                const u32x2v w = fw[k][jj];
                f32x4 fv = {__uint_as_float(w.x << 16), __uint_as_float(w.x & 0xffff0000u), __uint_as_float(w.y << 16), __uint_as_float(w.y & 0xffff0000u)};
                xo[64 * jj] = xv[k][jj] + fv * r1[k] * gp[jj];
            }
        }
    }
}

__global__ void __launch_bounds__(512, 2) fwd_megakernel(Params p) {
    extern __shared__ __attribute__((aligned(16))) unsigned char lds_raw[];
    LAS unsigned char* lds = (LAS unsigned char*)lds_raw;
    cg::grid_group grid = cg::this_grid();
#define GSYNC() do { asm volatile("s_waitcnt vmcnt(0)" ::: "memory"); grid.sync(); \
        if (wave == 0) { __builtin_amdgcn_fence(__ATOMIC_ACQUIRE, "agent"); asm volatile("s_waitcnt vmcnt(0)" ::: "memory"); } __syncthreads(); } while (0)
    const int tid = otid(), lane = tid & 63, wave = __builtin_amdgcn_readfirstlane(tid >> 6);
    const int G = gridDim.x, blk = blockIdx.x;
    const int gw = blk * 8 + wave, ngw = G * 8;
    unsigned char* dob = (unsigned char*)p.out;
    bf16_t* U = (bf16_t*)(p.ws + WS_U);
    bf16_t* MIXIN = (bf16_t*)(dob + DO_MIXIN);

    volatile LAS unsigned* bst = (volatile LAS unsigned*)(lds + LDS_BYTES - 16);
    if (tid < 2) bst[tid] = 0u;
    if (blk == 0) for (int i2 = tid; i2 < 3456; i2 += 512) __hip_atomic_store(g_bar + i2, 0u, __ATOMIC_RELAXED, __HIP_MEMORY_SCOPE_AGENT);
    p0_prologue(p, lds, gw, ngw, wave, lane);
    GSYNC();
    const XcdBarrier xbar = xcd_barrier_post(g_bar, bst);
#define XSYNC() xcd_barrier(xbar)
    {
        pg8::Gemm g{(const bf16_t*)(dob + DO_XN), (const bf16_t*)(dob + DO_WIN), T_, NIN, DM}; pg8::StaticOrder S; S.init(T_, NIN, G, blk);
        EpiU E{U, (const float*)(dob + DO_ROPE)};
        pg8::gemm_phase<EpiU, pg8::StaticOrder, true, true>(lds, g, S, E);
    }
    XSYNC();
    for (int lin = blk; lin < hg::NITEM; lin += G) hg::pass1(p, U, lds, hg::item_of(lin, G));
    at::attn_phase(U, MIXIN, lds, blk, G);
    XSYNC();
    hg::scan(p, blk * 512 + tid, G * 512);
    XSYNC();
    for (int lin = blk; lin < hg::NITEM; lin += G) hg::pass2(p, U, MIXIN, lds, hg::item_of(lin, G));
    XSYNC();
    hg_finalize(p, U, MIXIN, blk, G, wave, lane);
    XSYNC();
    {
        pg8::Gemm g{MIXIN, (const bf16_t*)(dob + DO_WOUT), T_, DM, DM}; pg8::StaticOrder S; S.init(T_, DM, G, blk);
        EpiRowSS E{(bf16_t*)(p.ws + WS_MIX), (float*)(p.ws + WS_SS1)};
        pg8::gemm_phase<EpiRowSS, pg8::StaticOrder, true, true>(lds, g, S, E);
    }
    XSYNC();
    p6_rows(p, lds, gw, ngw, wave, lane);
    XSYNC();
    {
        pg8::Gemm g{(const bf16_t*)(p.ws + WS_MIX), (const bf16_t*)(p.ws + WS_WGU), T_, 2 * DFF, DM}; pg8::StaticOrder S; S.init(T_, 2 * DFF, G, blk);
        EpiSwiGLU E{(bf16_t*)(p.ws + WS_HFF)};
        pg8::gemm_phase<EpiSwiGLU, pg8::StaticOrder, true, true>(lds, g, S, E);
    }
    XSYNC();
    {
        pg8::Gemm g{(const bf16_t*)(p.ws + WS_HFF), (const bf16_t*)(p.ws + WS_WDN), T_, DM, DFF}; pg8::StaticOrder S; S.init(T_, DM, G, blk);
        EpiRowSS E{(bf16_t*)(p.ws + WS_MIX), (float*)(p.ws + WS_SS2)};
        pg8::gemm_phase<EpiRowSS, pg8::StaticOrder, true, true>(lds, g, S, E);
    }
    XSYNC();
    p9_rows(p, gw, ngw, lane);
}

extern "C" void kernel_launch(void* const* d_in, const int* in_sizes, int n_in, void* d_out, int out_size, void* d_ws, size_t ws_size, hipStream_t stream) {
    static int grid_blocks = 0;
    if (grid_blocks == 0) {
        int dev = 0, cus = 0, per_cu = 0;
        hipGetDevice(&dev);
        hipDeviceGetAttribute(&cus, hipDeviceAttributeMultiprocessorCount, dev);
        hipFuncSetAttribute((const void*)fwd_megakernel, hipFuncAttributeMaxDynamicSharedMemorySize, LDS_BYTES);
        hipOccupancyMaxActiveBlocksPerMultiprocessor(&per_cu, (const void*)fwd_megakernel, 512, LDS_BYTES);
        if (per_cu < 1) { fprintf(stderr, "occupancy query reports %d blocks per CU\n", per_cu); per_cu = 1; }
        if (per_cu > 1) per_cu = 1;
        grid_blocks = cus * per_cu;
        if (ws_size < 512 * MiB) fprintf(stderr, "kernel_launch: workspace %zu smaller than the 512 MiB map\n", ws_size);
    }
    Params p{};
    p.xp = (const float*)d_in[0]; p.xs = (const float*)d_in[1]; p.w_in = (const float*)d_in[2]; p.w_out = (const float*)d_in[3];
    p.lb_fwd = (const float*)d_in[4]; p.lb_bwd = (const float*)d_in[5]; p.g_hgrn = (const float*)d_in[6]; p.g_pre_mix = (const float*)d_in[7];
    p.g_post_mix = (const float*)d_in[8]; p.g_pre_ffn = (const float*)d_in[9]; p.g_post_ffn = (const float*)d_in[10];
    p.w_gate = (const float*)d_in[11]; p.w_up = (const float*)d_in[12]; p.w_down = (const float*)d_in[13];
    p.out = (float*)d_out; p.ws = (unsigned char*)d_ws;
    void* args[] = {&p};
    hipError_t e = hipLaunchCooperativeKernel((const void*)fwd_megakernel, dim3(grid_blocks), dim3(512), args, LDS_BYTES, stream);
    if (e != hipSuccess) fprintf(stderr, "cooperative launch failed: %s (grid %d)\n", hipGetErrorString(e), grid_blocks);
}
```

```cpp
#include <hip/hip_runtime.h>
#include <hip/hip_cooperative_groups.h>
#include <cstdio>
#include <cstdint>
namespace cg = cooperative_groups;
namespace pg8 {
#define PG8_LAS __attribute__((address_space(3)))
typedef unsigned short bf16_t;
typedef short bf16x8 __attribute__((ext_vector_type(8)));
typedef float f32x4 __attribute__((ext_vector_type(4)));
typedef unsigned u32x4 __attribute__((ext_vector_type(4)));
constexpr int BM = 256, BK = 64, HALF = 128, HTB = HALF * BK * 2  , STAGE_BYTES = 8 * HTB, NXCD = 8, WGM = 8;

__host__ __device__ __forceinline__ int lds_byte(int r, int c) { const int st = (r >> 4) * 2 + (c >> 5), rr = r & 15, cc = c & 31, ob = rr * 64 + cc * 2; return st * 1024 + (ob ^ (((ob >> 9) & 1) << 5)); }
__host__ __device__ __forceinline__ void stage_rc(int b, int& R, int& C) { const int st = b / 1024, sb = b % 1024, swz = sb ^ (((sb >> 9) & 1) << 5); R = (st >> 1) * 16 + swz / 64; C = (st & 1) * 32 + (swz % 64) / 2; }
__host__ __device__ __forceinline__ int perm32(int rho) { const int n = rho >> 4, i = rho & 15; return 8 * (i >> 2) + 4 * n + (i & 3); }

struct Unit { int pm, pn; };
struct Gemm { const bf16_t* A; const bf16_t* Bt; int M, N, K; };

struct StaticOrder {
    int nM, nN, nwg, G, c;
    __host__ __device__ void init(int M, int N, int G_, int c_) { nM = M / BM; nN = N / BM; nwg = nM * nN; G = G_; c = c_; }
    __host__ __device__ bool next(int i, Unit& u) const {
        const long L = (long)i * G + c; if (L >= nwg) return false;
        int wgid = (int)L; { const int q = nwg / NXCD, r = nwg % NXCD, xcd = wgid % NXCD, off = wgid / NXCD; wgid = (xcd < r ? xcd * (q + 1) : r * (q + 1) + (xcd - r) * q) + off; }
        const int nig = WGM * nN, gid = wgid / nig, fm = gid * WGM, gsz = (nM - fm) < WGM ? (nM - fm) : WGM;
        u.pm = fm + ((wgid % nig) % gsz); u.pn = (wgid % nig) / gsz; return true;
    }
    __device__ __forceinline__ void a_ready(const Unit&) const {}
    __device__ __forceinline__ void done(const Unit&) const {}
};

typedef __bf16 bf16x2_t __attribute__((ext_vector_type(2)));
typedef float f32x2_t __attribute__((ext_vector_type(2)));
__device__ __forceinline__ unsigned cvt_pk_bf16(float lo, float hi) { f32x2_t v = {lo, hi}; bf16x2_t b = __builtin_convertvector(v, bf16x2_t); return __builtin_bit_cast(unsigned, b); }
typedef float f32x2 __attribute__((ext_vector_type(2)));
template <class Epi, class Sched, bool ALIGN_EPI = false, bool SP2 = false>
__device__ __forceinline__ void gemm_phase(PG8_LAS unsigned char* lds, const Gemm g, const Sched& S, const Epi& E) {
    int tid; asm volatile("v_mov_b32 %0, %1" : "=v"(tid) : "v"((int)threadIdx.x));
    const int wid = __builtin_amdgcn_readfirstlane(tid >> 6), lane = tid & 63, wr = wid >> 2, wc = wid & 3, fr = lane & 15, fq = lane >> 4;
    const int K = g.K, nt = K / BK;
    unsigned voffA[2], voffB[2];
#pragma unroll
    for (int i = 0; i < 2; ++i) { int R, C; stage_rc(tid * 16 + i * 8192, R, C); const int Rb = Epi::PERM ? ((R & ~31) + perm32(R & 31)) : R;
        voffA[i] = (unsigned)(R * K + C) * 2u; voffB[i] = (unsigned)(Rb * K + C) * 2u; }
    const size_t kstep = (size_t)(BK * 2);
    const size_t hstep = (size_t)HALF * K * 2;
    const size_t tstep = 2 * hstep;
    const unsigned ldsw = (unsigned)wid * 1024u;
    const int aoff = lds_byte(wr * 64 + fr, fq * 8), boff = lds_byte(wc * 32 + fr, fq * 8);
#define PG8_SA(b, h) (((b) * 2 + (h)) * HTB)
#define PG8_SB(b, h) ((4 + (b) * 2 + (h)) * HTB)
#define PG8_STAGE(bufoff, gbase, voff) do { _Pragma("unroll") for (int _i = 0; _i < 2; ++_i) \
        __builtin_amdgcn_global_load_lds((const unsigned*)((const char*)(gbase) + (voff)[_i]), (PG8_LAS unsigned*)(lds + (bufoff) + ldsw + _i * 8192), 16, 0, 0); } while (0)
#define PG8_LDA(dst, b, h) do { _Pragma("unroll") for (int m = 0; m < 4; ++m) _Pragma("unroll") for (int k = 0; k < 2; ++k) dst[m][k] = *(const PG8_LAS bf16x8*)(lds + PG8_SA(b, h) + aoff + m * 2048 + k * 1024); } while (0)
#define PG8_LDB(dst, b, h) do { _Pragma("unroll") for (int n = 0; n < 2; ++n) _Pragma("unroll") for (int k = 0; k < 2; ++k) dst[n][k] = *(const PG8_LAS bf16x8*)(lds + PG8_SB(b, h) + boff + n * 2048 + k * 1024); } while (0)
#define PG8_MMA(ai, bj, At, Bt) do { __builtin_amdgcn_s_setprio(1); _Pragma("unroll") for (int m = 0; m < 4; ++m) _Pragma("unroll") for (int n = 0; n < 2; ++n) _Pragma("unroll") for (int k = 0; k < 2; ++k) \
        acc[ai][bj][m][n] = __builtin_amdgcn_mfma_f32_16x16x32_bf16(Bt[n][k], At[m][k], acc[ai][bj][m][n], 0, 0, 0); __builtin_amdgcn_s_setprio(0); } while (0)
#define PG8_WAIT_V(n) asm volatile("s_waitcnt vmcnt(" #n ")" ::: "memory")
#define PG8_WAIT_L(n) asm volatile("s_waitcnt lgkmcnt(" #n ")" ::: "memory")
#define PG8_BAR __builtin_amdgcn_s_barrier()
#define PG8_SCHED __builtin_amdgcn_sched_barrier(0)
    Unit cur, nxt; int ui = 0;
    if (!S.next(0, cur)) return;
    f32x4 acc[2][2][4][2];
#pragma unroll
    for (int a = 0; a < 2; ++a)
#pragma unroll
        for (int b = 0; b < 2; ++b)
#pragma unroll
            for (int m = 0; m < 4; ++m)
#pragma unroll
                for (int n = 0; n < 2; ++n) acc[a][b][m][n] = (f32x4){0.f, 0.f, 0.f, 0.f};
    bf16x8 At[4][2], B0[2][2], B1[2][2];
    const char* cA = (const char*)g.A + (size_t)cur.pm * tstep; const char* cB = (const char*)g.Bt + (size_t)cur.pn * tstep;
    S.a_ready(cur);
    if constexpr (SP2) {
        PG8_STAGE(PG8_SB(0, 0), cB, voffB); PG8_STAGE(PG8_SB(0, 1), cB + hstep, voffB); PG8_STAGE(PG8_SA(0, 0), cA, voffA); PG8_STAGE(PG8_SA(0, 1), cA + hstep, voffA);
        if (wr == 1) PG8_BAR;
        PG8_WAIT_V(2); PG8_BAR;
        PG8_STAGE(PG8_SB(1, 0), cB + kstep, voffB); PG8_STAGE(PG8_SA(1, 0), cA + kstep, voffA); PG8_STAGE(PG8_SB(1, 1), cB + hstep + kstep, voffB);
        PG8_WAIT_V(6); PG8_BAR;
    } else {
        PG8_STAGE(PG8_SB(0, 0), cB, voffB); PG8_STAGE(PG8_SA(0, 0), cA, voffA); PG8_STAGE(PG8_SB(0, 1), cB + hstep, voffB); PG8_STAGE(PG8_SA(0, 1), cA + hstep, voffA);
        if (wr == 1) PG8_BAR;
        PG8_WAIT_V(4); PG8_BAR;
        PG8_STAGE(PG8_SB(1, 0), cB + kstep, voffB); PG8_STAGE(PG8_SA(1, 0), cA + kstep, voffA); PG8_STAGE(PG8_SB(1, 1), cB + hstep + kstep, voffB);
        PG8_WAIT_V(6); PG8_BAR;
    }
    for (;;) {
        const bool has_next = S.next(ui + 1, nxt);
        const char* nA = has_next ? (const char*)g.A + (size_t)nxt.pm * tstep : cA; const char* nB = has_next ? (const char*)g.Bt + (size_t)nxt.pn * tstep : cB;
        for (int t = 0; t < nt; t += 2) {
            const bool last = (t == nt - 2);
            const char* a1 = cA + (size_t)(t + 1) * kstep;
            const char* a2 = last ? nA : cA + (size_t)(t + 2) * kstep; const char* b2 = last ? nB : cB + (size_t)(t + 2) * kstep;
            const char* a3 = a2 + kstep; const char* b3 = b2 + kstep;
            if (last && has_next) S.a_ready(nxt);
            if constexpr (SP2) {
            PG8_LDB(B0, 0, 0); PG8_LDB(B1, 0, 1); PG8_SCHED; PG8_LDA(At, 0, 0); PG8_STAGE(PG8_SA(1, 1), a1 + hstep, voffA);
            PG8_WAIT_V(8); PG8_WAIT_L(0); PG8_BAR; PG8_MMA(0, 0, At, B0); PG8_MMA(0, 1, At, B1); PG8_BAR; PG8_SCHED;
            PG8_LDA(At, 0, 1); PG8_STAGE(PG8_SB(0, 0), b2, voffB); PG8_STAGE(PG8_SB(0, 1), b2 + hstep, voffB); PG8_STAGE(PG8_SA(0, 0), a2, voffA);
            PG8_WAIT_V(8); PG8_WAIT_L(0); PG8_BAR; PG8_MMA(1, 0, At, B0); PG8_MMA(1, 1, At, B1); PG8_BAR; PG8_SCHED;
            PG8_LDB(B0, 1, 0); PG8_LDB(B1, 1, 1); PG8_SCHED; PG8_LDA(At, 1, 0); PG8_STAGE(PG8_SA(0, 1), a2 + hstep, voffA);
            PG8_WAIT_V(8); PG8_WAIT_L(0); PG8_BAR; PG8_MMA(0, 0, At, B0); PG8_MMA(0, 1, At, B1); PG8_BAR; PG8_SCHED;
            PG8_LDA(At, 1, 1); PG8_STAGE(PG8_SB(1, 0), b3, voffB); PG8_STAGE(PG8_SB(1, 1), b3 + hstep, voffB); PG8_STAGE(PG8_SA(1, 0), a3, voffA);
            PG8_WAIT_V(8); PG8_WAIT_L(0); PG8_BAR; PG8_MMA(1, 0, At, B0); PG8_MMA(1, 1, At, B1); PG8_BAR; PG8_SCHED;
            } else {
            PG8_LDB(B0, 0, 0); PG8_SCHED; PG8_LDA(At, 0, 0); PG8_STAGE(PG8_SA(1, 1), a1 + hstep, voffA);
            PG8_WAIT_L(8); PG8_BAR; PG8_WAIT_L(0); PG8_MMA(0, 0, At, B0); PG8_BAR; PG8_SCHED;
            PG8_LDB(B1, 0, 1); PG8_STAGE(PG8_SB(0, 0), b2, voffB);
            PG8_BAR; PG8_WAIT_L(0); PG8_MMA(0, 1, At, B1); PG8_BAR;
            PG8_LDA(At, 0, 1); PG8_STAGE(PG8_SA(0, 0), a2, voffA);
            PG8_BAR; PG8_WAIT_L(0); PG8_MMA(1, 0, At, B0); PG8_BAR; PG8_SCHED;
            PG8_STAGE(PG8_SB(0, 1), b2 + hstep, voffB);
            PG8_WAIT_V(6); PG8_BAR; PG8_MMA(1, 1, At, B1); PG8_BAR;
            PG8_LDB(B0, 1, 0); PG8_SCHED; PG8_LDA(At, 1, 0); PG8_STAGE(PG8_SA(0, 1), a2 + hstep, voffA);
            PG8_WAIT_L(8); PG8_BAR; PG8_WAIT_L(0); PG8_MMA(0, 0, At, B0); PG8_BAR; PG8_SCHED;
            PG8_LDB(B1, 1, 1); PG8_STAGE(PG8_SB(1, 0), b3, voffB);
            PG8_BAR; PG8_WAIT_L(0); PG8_MMA(0, 1, At, B1); PG8_BAR;
            PG8_LDA(At, 1, 1); PG8_STAGE(PG8_SA(1, 0), a3, voffA);
            PG8_BAR; PG8_WAIT_L(0); PG8_MMA(1, 0, At, B0); PG8_BAR; PG8_SCHED;
            PG8_STAGE(PG8_SB(1, 1), b3 + hstep, voffB);
            PG8_WAIT_V(6); PG8_BAR; PG8_MMA(1, 1, At, B1); PG8_BAR;
            }
        }
        if constexpr (ALIGN_EPI) { if (wr == 0) PG8_BAR; }
        if constexpr (!Epi::AFTER_DRAIN) { E(acc, cur, wr, wc, fr, fq); S.done(cur); }
        if (!has_next) break;
#pragma unroll
        for (int a = 0; a < 2; ++a)
#pragma unroll
            for (int b = 0; b < 2; ++b)
#pragma unroll
                for (int m = 0; m < 4; ++m)
#pragma unroll
                    for (int n = 0; n < 2; ++n) acc[a][b][m][n] = (f32x4){0.f, 0.f, 0.f, 0.f};
        cur = nxt; cA = nA; cB = nB; ++ui;
        if constexpr (ALIGN_EPI) { if (wr == 1) PG8_BAR; }
    }
    PG8_WAIT_V(0);
    if constexpr (!ALIGN_EPI) { if (wr == 0) PG8_BAR; }
    PG8_BAR;
    if constexpr (Epi::AFTER_DRAIN) { E.fused(acc, cur, wr, wc, fr, fq, lds, wid, lane); S.done(cur); }
#undef PG8_SA
#undef PG8_SB
#undef PG8_STAGE
#undef PG8_LDA
#undef PG8_LDB
#undef PG8_MMA
#undef PG8_WAIT_V
#undef PG8_WAIT_L
#undef PG8_BAR
#undef PG8_SCHED
}
}

#define LAS __attribute__((address_space(3)))
typedef unsigned short bf16_t;
using pg8::f32x4; using pg8::u32x4; using pg8::Unit; using pg8::cvt_pk_bf16;
typedef float f32x2v __attribute__((ext_vector_type(2)));
typedef unsigned u32x2v __attribute__((ext_vector_type(2)));

constexpr int T_ = 65536, DM = 1024, NIN = 4096, DFF = 2816, ROWS_P = 32768;
constexpr size_t MiB = 1u << 20;
constexpr float EPS = 1e-6f;
constexpr int LDS_BYTES = 147456;
constexpr size_t DO_XN = 0, DO_MIXIN = 0, DO_WIN = 128 * MiB, DO_ROPE = 136 * MiB, DO_WOUT = 137 * MiB;
constexpr size_t WS_U = 0;
constexpr size_t WS_MIX = 0;
constexpr size_t WS_WGU = 128 * MiB, WS_WDN = 139 * MiB, WS_SS1 = 145 * MiB, WS_SS2 = 149 * MiB, WS_HFF = 160 * MiB;
constexpr int UP = 2560;
constexpr int UC_QH = 0, UC_ZF = 512, UC_ZB = 1024, UC_IH = 1536, UC_GH = 2048;
constexpr size_t WS_QB = 320 * MiB, WS_KB = 384 * MiB, WS_VB = 448 * MiB;
__device__ __forceinline__ int perm_row(int row) {
    if (row < ROWS_P) { const int pos = row & 16383; return (row & ~16383) + ((pos & 15) << 10) + (pos >> 4); }
    const int pos = row & 4095; return (row & ~4095) + ((pos & 15) << 8) + (pos >> 4);
}

__device__ __forceinline__ float bf2f(unsigned short h) { return __uint_as_float((unsigned)h << 16); }
__device__ __forceinline__ unsigned short f2bf(float f) { unsigned u = __float_as_uint(f); return (unsigned short)((u + 0x7fffu + ((u >> 16) & 1u)) >> 16); }
__device__ __forceinline__ unsigned pk2(float lo, float hi) { return cvt_pk_bf16(lo, hi); }
__device__ __forceinline__ float silu_f(float x) { return x * __builtin_amdgcn_rcpf(1.f + __expf(-x)); }
__device__ __forceinline__ float sigmoid_f(float x) { return __builtin_amdgcn_rcpf(1.f + __expf(-x)); }
__device__ __forceinline__ int row_pos(int row) { return row < ROWS_P ? (row & 16383) : (row & 4095); }
__device__ __forceinline__ int row_S(int row) { return row < ROWS_P ? 16384 : 4096; }
__device__ __forceinline__ float wave_sum(float v) {
#pragma unroll
    for (int o = 1; o < 64; o <<= 1) v += __shfl_xor(v, o);
    return v;
}
__device__ __forceinline__ float wave_max(float v) {
#pragma unroll
    for (int o = 1; o < 64; o <<= 1) v = fmaxf(v, __shfl_xor(v, o));
    return v;
}
#define LDS_WAIT() asm volatile("s_waitcnt lgkmcnt(0)" ::: "memory")
__device__ __forceinline__ int otid() { int t; asm volatile("v_mov_b32 %0, %1" : "=v"(t) : "v"((int)threadIdx.x)); return t; }


__device__ unsigned g_bar[3456];
struct XcdBarrier { unsigned* bar; unsigned x; volatile LAS unsigned* st; };
#define XB_TMO      128
#define XB_XCNT(j)  (256  + 64 * (j))
#define XB_XSUB(j)  (1280 + 64 * (j))
#define XB_XGEN(j)  (2304 + 64 * (j))
#define XB_TOP      3328
#define XB_TOPGEN   3392
#define XCD_BAR_WORDS 3456
#define XB_SPIN_CAP (1u << 18)

__device__ __forceinline__ unsigned xb_ld(unsigned* p)              { return __hip_atomic_load(p, __ATOMIC_RELAXED, __HIP_MEMORY_SCOPE_AGENT); }
__device__ __forceinline__ unsigned xb_add(unsigned* p, unsigned v) { return __hip_atomic_fetch_add(p, v, __ATOMIC_RELAXED, __HIP_MEMORY_SCOPE_AGENT); }
__device__ __forceinline__ unsigned xb_xcc_id() { return (unsigned)__builtin_amdgcn_s_getreg((3 << 11) | 20) & 0xFu; }
#define XB_SPIN(cond, bar) do { unsigned _sp = 0; while (cond) { __builtin_amdgcn_s_sleep(1); \
    if ((++_sp & 255u) == 0u) { if (xb_ld(&(bar)[XB_TMO])) break; if (_sp > XB_SPIN_CAP) { atomicAdd(&(bar)[XB_TMO], 1u); break; } } } } while (0)
__device__ __forceinline__ XcdBarrier xcd_barrier_post(unsigned* bar, volatile LAS unsigned* st) {
    XcdBarrier b; b.bar = bar; b.x = xb_xcc_id(); b.st = st;
    if (threadIdx.x == 0) (void)xb_add(&bar[XB_XCNT(b.x)], 1u);
    return b;
}
__device__ __forceinline__ void xcd_barrier_complete(unsigned* bar, unsigned x, unsigned& nloc, unsigned& nx) {
    const unsigned G = gridDim.x * gridDim.y * gridDim.z;
    unsigned sum, cnt, mine, sp = 0u;
    for (;;) {
        sum = 0u; cnt = 0u; mine = 0u;
#pragma unroll
        for (unsigned j = 0; j < 16; ++j) { const unsigned c = xb_ld(&bar[XB_XCNT(j)]); sum += c; cnt += (c > 0u) ? 1u : 0u; mine = (j == x) ? c : mine; }
        if (sum == G) break;
        __builtin_amdgcn_s_sleep(1);
        if ((++sp & 255u) == 0u) { if (xb_ld(&bar[XB_TMO])) break; if (sp > XB_SPIN_CAP) { atomicAdd(&bar[XB_TMO], 1u); break; } }
    }
    nloc = mine > 0u ? mine : 1u; nx = cnt > 0u ? cnt : 1u;
}

__device__ __forceinline__ void xcd_barrier(const XcdBarrier& b) {
    asm volatile("s_waitcnt vmcnt(0)" ::: "memory");
    __syncthreads();
    if (threadIdx.x == 0) {
        unsigned* bar = b.bar;
        __builtin_amdgcn_s_waitcnt(0);
        unsigned nloc = b.st[0], nx = b.st[1];
        if (nloc == 0u) { xcd_barrier_complete(bar, b.x, nloc, nx); b.st[0] = nloc; b.st[1] = nx; }
        const unsigned old = xb_add(&bar[XB_XSUB(b.x)], 1u);
        const unsigned gen = old / nloc;
        if (old + 1u == (gen + 1u) * nloc) {
            __builtin_amdgcn_fence(__ATOMIC_RELEASE, "agent");
            asm volatile("s_waitcnt vmcnt(0)" ::: "memory");
            const unsigned og = xb_add(&bar[XB_TOP], 1u);
            const unsigned tg = og / nx;
            if (og + 1u == (tg + 1u) * nx) xb_add(&bar[XB_TOPGEN], 1u);
            else XB_SPIN(xb_ld(&bar[XB_TOPGEN]) == tg, bar);
            __builtin_amdgcn_fence(__ATOMIC_ACQUIRE, "agent");
            xb_add(&bar[XB_XGEN(b.x)], 1u);
            asm volatile("s_waitcnt vmcnt(0)" ::: "memory");
        } else {
            XB_SPIN(xb_ld(&bar[XB_XGEN(b.x)]) == gen, bar);
            __builtin_amdgcn_fence(__ATOMIC_ACQUIRE, "agent");
            asm volatile("s_waitcnt vmcnt(0)" ::: "memory");
        }
    }
    __syncthreads();
}

struct EpiU {
    static constexpr bool PERM = true, AFTER_DRAIN = false;
    bf16_t* UH; bf16_t* XB; const float* rope;
    __device__ __forceinline__ void operator()(const f32x4 (&acc)[2][2][4][2], const Unit& u, int wr, int wc, int fr, int fq) const {
        const int row0 = u.pm * 256 + wr * 64 + fr;
        const bool attn = u.pn < 6;
        const bool rope_tile = (u.pn < 4) && ((wc & 1) == 0);
        const float sc = (u.pn < 2) ? 0.125f : 1.0f;
        const float sgn = (fq == 0) ? -1.f : 1.f;
#pragma unroll
        for (int ai = 0; ai < 2; ++ai)
#pragma unroll
            for (int m = 0; m < 4; ++m) {
                const int row = row0 + ai * 128 + m * 16;
                f32x4 r0 = {1.f, 0.f, 1.f, 0.f}, r1 = r0, r2 = r0, r3 = r0;
                if (rope_tile) { const f32x4* rp = (const f32x4*)(rope + (size_t)row_pos(row) * 16); r0 = rp[0]; r1 = rp[1]; r2 = rp[2]; r3 = rp[3]; }
                const size_t prow = attn ? (size_t)perm_row(row) : 0;
#pragma unroll
                for (int bj = 0; bj < 2; ++bj) {
                    f32x4 v0 = acc[ai][bj][m][0], v1 = acc[ai][bj][m][1];
                    if (rope_tile) {
                        f32x4 p0, p1;
#pragma unroll
                        for (int j = 0; j < 4; ++j) { p0[j] = __shfl_xor(v0[j], 16); p1[j] = __shfl_xor(v1[j], 16); }
                        if (fq < 2) {
                            v0[0] = v0[0] * r0[0] + sgn * p0[0] * r0[1]; v0[1] = v0[1] * r0[2] + sgn * p0[1] * r0[3];
                            v0[2] = v0[2] * r1[0] + sgn * p0[2] * r1[1]; v0[3] = v0[3] * r1[2] + sgn * p0[3] * r1[3];
                            v1[0] = v1[0] * r2[0] + sgn * p1[0] * r2[1]; v1[1] = v1[1] * r2[2] + sgn * p1[1] * r2[3];
                            v1[2] = v1[2] * r3[0] + sgn * p1[2] * r3[1]; v1[3] = v1[3] * r3[2] + sgn * p1[3] * r3[3];
                        }
                    }
                    v0 = v0 * sc; v1 = v1 * sc;
                    u32x4 w; w.x = cvt_pk_bf16(v0[0], v0[1]); w.y = cvt_pk_bf16(v0[2], v0[3]); w.z = cvt_pk_bf16(v1[0], v1[1]); w.w = cvt_pk_bf16(v1[2], v1[3]);
                    bf16_t* dst;
                    if (attn) {
                        const int cs = (u.pn & 1) * 256 + bj * 128 + wc * 32 + 8 * fq;
                        dst = XB + (size_t)(u.pn >> 1) * ((size_t)T_ * 512) + ((size_t)(cs >> 6) * T_ + prow) * 64 + (cs & 63);
                    } else dst = UH + (size_t)row * UP + (u.pn * 256 - 1536) + bj * 128 + wc * 32 + 8 * fq;
                    *(u32x4*)dst = w;
                }
            }
    }
};
struct EpiRowSS {
    static constexpr bool PERM = true, AFTER_DRAIN = false;
    bf16_t* O; float* SS;
    __device__ __forceinline__ void operator()(const f32x4 (&acc)[2][2][4][2], const Unit& u, int wr, int wc, int fr, int fq) const {
        const int row0 = u.pm * 256 + wr * 64 + fr, col0 = u.pn * 256 + wc * 32 + 8 * fq;
#pragma unroll
        for (int ai = 0; ai < 2; ++ai)
#pragma unroll
            for (int m = 0; m < 4; ++m) {
                const int row = row0 + ai * 128 + m * 16;
                bf16_t* rowp = O + (size_t)row * DM + col0;
                float s = 0.f;
#pragma unroll
                for (int bj = 0; bj < 2; ++bj) {
                    const f32x4 v0 = acc[ai][bj][m][0], v1 = acc[ai][bj][m][1];
                    s += (v0[0] * v0[0] + v0[1] * v0[1]) + (v0[2] * v0[2] + v0[3] * v0[3]) + (v1[0] * v1[0] + v1[1] * v1[1]) + (v1[2] * v1[2] + v1[3] * v1[3]);
                    u32x4 w; w.x = cvt_pk_bf16(v0[0], v0[1]); w.y = cvt_pk_bf16(v0[2], v0[3]); w.z = cvt_pk_bf16(v1[0], v1[1]); w.w = cvt_pk_bf16(v1[2], v1[3]);
                    *(u32x4*)(rowp + bj * 128) = w;
                }
                s += __shfl_xor(s, 16); s += __shfl_xor(s, 32);
                if (fq == 0) SS[(size_t)row * 16 + u.pn * 4 + wc] = s;
            }
    }
};
struct EpiSwiGLU {
    static constexpr bool PERM = true, AFTER_DRAIN = false;
    bf16_t* H;
    __device__ __forceinline__ void operator()(const f32x4 (&acc)[2][2][4][2], const Unit& u, int wr, int wc, int fr, int fq) const {
        const int row0 = u.pm * 256 + wr * 64 + fr, col0 = u.pn * 128 + wc * 32 + 8 * fq;
#pragma unroll
        for (int ai = 0; ai < 2; ++ai)
#pragma unroll
            for (int m = 0; m < 4; ++m) {
                const int row = row0 + ai * 128 + m * 16;
                const f32x4 g0 = acc[ai][0][m][0], g1 = acc[ai][0][m][1], u0 = acc[ai][1][m][0], u1 = acc[ai][1][m][1];
                f32x4 h0, h1;
#pragma unroll
                for (int j = 0; j < 4; ++j) { h0[j] = silu_f(g0[j]) * u0[j]; h1[j] = silu_f(g1[j]) * u1[j]; }
                u32x4 w; w.x = cvt_pk_bf16(h0[0], h0[1]); w.y = cvt_pk_bf16(h0[2], h0[3]); w.z = cvt_pk_bf16(h1[0], h1[1]); w.w = cvt_pk_bf16(h1[2], h1[3]);
                *(u32x4*)(H + (size_t)row * DFF + col0) = w;
            }
    }
};

template <class RowMap>
__device__ __forceinline__ void transpose_item(const float* W, int N, int k0, int n0, const float* kscale, bf16_t* WT, int K, RowMap rowmap, LAS float* scr, int lane) {
#pragma unroll 8
    for (int i = 0; i < 32; ++i) { const int kk = 2 * i + (lane >> 5); float w = W[(size_t)(k0 + kk) * N + n0 + (lane & 31)]; if (kscale) w *= kscale[k0 + kk]; scr[kk * 33 + (lane & 31)] = w; }
    LDS_WAIT();
    const int c = lane & 7;
#pragma unroll
    for (int j = 0; j < 4; ++j) { const int n = (lane >> 3) + 8 * j; const LAS float* s = scr + (8 * c) * 33 + n;
        u32x4 o; o.x = pk2(s[0 * 33], s[1 * 33]); o.y = pk2(s[2 * 33], s[3 * 33]); o.z = pk2(s[4 * 33], s[5 * 33]); o.w = pk2(s[6 * 33], s[7 * 33]);
        *(u32x4*)(WT + (size_t)rowmap(n0 + n) * K + k0 + 8 * c) = o; }
    LDS_WAIT();
}
struct RowId { __device__ __forceinline__ int operator()(int n) const { return n; } };
struct RowGU { int half; __device__ __forceinline__ int operator()(int n) const { return (n >> 7) * 256 + half * 128 + (n & 127); } };

struct Params {
    const float* xp; const float* xs; const float* w_in; const float* w_out; const float* lb_fwd; const float* lb_bwd; const float* g_hgrn;
    const float* g_pre_mix; const float* g_post_mix; const float* g_pre_ffn; const float* g_post_ffn; const float* w_gate; const float* w_up; const float* w_down;
    float* out; unsigned char* ws;
};
__device__ __forceinline__ const float* xrow_ptr(const Params& p, int row) { return row < ROWS_P ? p.xp + (size_t)row * DM : p.xs + (size_t)(row - ROWS_P) * DM; }

__device__ __forceinline__ void p0_prologue(const Params& p, LAS unsigned char* lds, int gw, int ngw, int wave, int lane) {
    unsigned char* dob = (unsigned char*)p.out;
    bf16_t* WIN = (bf16_t*)(dob + DO_WIN); bf16_t* WOUT = (bf16_t*)(dob + DO_WOUT); float* rope = (float*)(dob + DO_ROPE); bf16_t* XN = (bf16_t*)(dob + DO_XN);
    LAS float* scr = (LAS float*)(lds + wave * 16384);
    constexpr int I_IN = 16 * 128, I_OUT = 16 * 32;
    for (int it = gw; it < I_IN + I_OUT; it += ngw) {
        if (it < I_IN) transpose_item(p.w_in, NIN, 64 * (it / 128), 32 * (it % 128), p.g_pre_mix, WIN, DM, RowId{}, scr, lane);
        else { const int r = it - I_IN; transpose_item(p.w_out, DM, 64 * (r / 32), 32 * (r % 32), nullptr, WOUT, DM, RowId{}, scr, lane); }
    }
    {
        const int gt = gw * 64 + lane, ngt = ngw * 64;
        for (int e = gt; e < 16384 * 8; e += ngt) {
            const int pos = e >> 3, i = e & 7;
            const double rv = i == 0 ? 0.15915494309189535 : i == 1 ? 0.03086376340470123 : i == 2 ? 0.005985185712713705 : i == 3 ? 0.001160663641240061
                            : i == 4 ? 0.00022507907903927653 : i == 5 ? 4.364795279280289e-05 : i == 6 ? 8.464330808241401e-06 : 1.6414262627950345e-06;
            double a = (double)pos * rv; a -= floor(a);
            const float af = (float)a;
            rope[2 * e] = __builtin_amdgcn_cosf(af); rope[2 * e + 1] = __builtin_amdgcn_sinf(af);
        }
    }
    for (int m0 = gw * 4; m0 < T_; m0 += ngw * 4) {
        f32x4 v[4][4]; float s[4];
#pragma unroll
        for (int k = 0; k < 4; ++k) { const f32x4* xr = (const f32x4*)xrow_ptr(p, m0 + k) + lane;
#pragma unroll
            for (int j = 0; j < 4; ++j) v[k][j] = xr[64 * j]; }
#pragma unroll
        for (int k = 0; k < 4; ++k) { s[k] = 0.f;
#pragma unroll
            for (int j = 0; j < 4; ++j) s[k] += (v[k][j][0] * v[k][j][0] + v[k][j][1] * v[k][j][1]) + (v[k][j][2] * v[k][j][2] + v[k][j][3] * v[k][j][3]); }
#pragma unroll
        for (int k = 0; k < 4; ++k) {
            const float rstd = rsqrtf(wave_sum(s[k]) * (1.f / DM) + EPS);
            u32x2v* o8 = (u32x2v*)(XN + (size_t)(m0 + k) * DM) + lane;
#pragma unroll
            for (int j = 0; j < 4; ++j) { u32x2v w; w.x = cvt_pk_bf16(v[k][j][0] * rstd, v[k][j][1] * rstd); w.y = cvt_pk_bf16(v[k][j][2] * rstd, v[k][j][3] * rstd); o8[64 * j] = w; }
        }
    }
}

namespace at {
typedef short bf16x8 __attribute__((ext_vector_type(8)));
typedef short s16x4 __attribute__((ext_vector_type(4)));
constexpr int OS = 68;
constexpr int L_OUT = 0, L_L = 272 * OS * 4, L_VS = L_L + 1024, VS_STRIDE = 144, VS_WAVE = 32 * VS_STRIDE, L_END = L_VS + 8 * VS_WAVE;
static_assert(L_END <= LDS_BYTES, "attention LDS map");

__device__ __forceinline__ void wave_tile(const bf16_t* XBp, LAS unsigned char* lds, int w, int lane, int base, int S, int P0, int h, int idx) {
    const int n = lane & 15, quad = lane >> 4;
    const int br = idx >> 4, sub = idx & 15;
    const int dsh = 2 * br, dil = 1 << dsh;
    const int r = br == 0 ? 0 : (br == 1 ? (sub & 3) : sub);
    const int mt = br == 0 ? sub : (br == 1 ? (sub >> 2) : 0);
    const int Lsub = S >> dsh, m0 = (P0 >> dsh) + 16 * mt;
    const bf16_t* Qb = XBp + ((size_t)h * T_ + base) * 64;
    const bf16_t* Kb = Qb + (size_t)T_ * 512, * Vb = Kb + (size_t)T_ * 512;
    const int sh16 = (S == 16384) ? 10 : 8;
#define AT_ROW(pos) ((((pos) & 15) << sh16) + ((pos) >> 4))
    bf16x8 qf[2];
    { const int pq = (m0 + n) * dil + r; const bf16_t* qp = Qb + (size_t)AT_ROW(pq) * 64 + 8 * quad; qf[0] = *(const bf16x8*)qp; qf[1] = *(const bf16x8*)(qp + 32); }
    bf16x8 kf[9][2];
#pragma unroll
    for (int kt = 0; kt < 9; ++kt) {
        int mk = m0 - 64 + 16 * kt + n; mk = mk < 0 ? 0 : (mk >= Lsub ? Lsub - 1 : mk);
        const int pk = mk * dil + r;
        const bf16_t* kp = Kb + (size_t)AT_ROW(pk) * 64 + 8 * quad; kf[kt][0] = *(const bf16x8*)kp; kf[kt][1] = *(const bf16x8*)(kp + 32);
    }
    u32x4 vr[5][4];
#pragma unroll
    for (int t = 0; t < 5; ++t)
#pragma unroll
        for (int e = 0; e < 4; ++e) {
            const int id = lane + 64 * e, rho = id >> 3, ch = id & 7;
            int mk = m0 - 64 + 32 * t + rho; mk = mk < 0 ? 0 : (mk >= Lsub ? Lsub - 1 : mk);
            const int pv = mk * dil + r;
            vr[t][e] = *(const u32x4*)(Vb + (size_t)AT_ROW(pv) * 64 + 8 * ch);
        }
    unsigned pk[10][2];
    float lsum = 0.f;
#pragma unroll
    for (int kt = 0; kt < 9; ++kt) {
        f32x4 sc = {0.f, 0.f, 0.f, 0.f};
        sc = __builtin_amdgcn_mfma_f32_16x16x32_bf16(kf[kt][0], qf[0], sc, 0, 0, 0);
        sc = __builtin_amdgcn_mfma_f32_16x16x32_bf16(kf[kt][1], qf[1], sc, 0, 0, 0);
        float pv[4];
#pragma unroll
        for (int j = 0; j < 4; ++j) {
            const int ko = 16 * kt + 4 * quad + j, mk = m0 - 64 + ko;
            const bool valid = (ko >= n) && (ko <= n + 128) && (mk >= 0) && (mk < Lsub);
            const float e = __expf(fminf(sc[j], 80.f));
            pv[j] = valid ? e : 0.f; lsum += pv[j];
        }
        pk[kt][0] = cvt_pk_bf16(pv[0], pv[1]); pk[kt][1] = cvt_pk_bf16(pv[2], pv[3]);
    }
    pk[9][0] = 0u; pk[9][1] = 0u;
    lsum += __shfl_xor(lsum, 16); lsum += __shfl_xor(lsum, 32);
    f32x4 ot[4];
#pragma unroll
    for (int dt = 0; dt < 4; ++dt) ot[dt] = (f32x4){0.f, 0.f, 0.f, 0.f};
    LAS unsigned char* vs = lds + L_VS + w * VS_WAVE;
#pragma unroll
    for (int t = 0; t < 5; ++t) {
#pragma unroll
        for (int e = 0; e < 4; ++e) { const int id = lane + 64 * e, rho = id >> 3, ch = id & 7; *(LAS u32x4*)(vs + rho * VS_STRIDE + ch * 16) = vr[t][e]; }
        bf16x8 pf; { u32x4 pw = {pk[2 * t][0], pk[2 * t][1], pk[2 * t + 1][0], pk[2 * t + 1][1]}; pf = __builtin_bit_cast(bf16x8, pw); }
#pragma unroll
        for (int dt = 0; dt < 4; ++dt) {
            const int q = (lane & 15) >> 2, pp = lane & 3;
            const s16x4 lo = __builtin_amdgcn_ds_read_tr16_b64_v4i16((LAS s16x4*)(vs + (4 * quad + q) * VS_STRIDE + (16 * dt + 4 * pp) * 2));
            const s16x4 hi = __builtin_amdgcn_ds_read_tr16_b64_v4i16((LAS s16x4*)(vs + (16 + 4 * quad + q) * VS_STRIDE + (16 * dt + 4 * pp) * 2));
            const bf16x8 vf = {lo[0], lo[1], lo[2], lo[3], hi[0], hi[1], hi[2], hi[3]};
            ot[dt] = __builtin_amdgcn_mfma_f32_16x16x32_bf16(vf, pf, ot[dt], 0, 0, 0);
        }
    }
    const int posl = ((m0 + n) * dil + r) - P0;
    LAS float* op = (LAS float*)(lds + L_OUT) + (posl + (posl >> 4)) * OS + 4 * quad;
    LAS float* lp = (LAS float*)(lds + L_L) + posl;
    if (br == 0) {
#pragma unroll
        for (int dt = 0; dt < 4; ++dt) *(LAS f32x4*)(op + 16 * dt) = ot[dt];
        if (quad == 0) *lp = lsum;
    } else {
        f32x4 old[4];
#pragma unroll
        for (int dt = 0; dt < 4; ++dt) old[dt] = *(const LAS f32x4*)(op + 16 * dt);
        const float lo = *lp;
#pragma unroll
        for (int dt = 0; dt < 4; ++dt) *(LAS f32x4*)(op + 16 * dt) = old[dt] + ot[dt];
        if (quad == 0) *lp = lo + lsum;
    }
}
__device__ __forceinline__ void attn_phase(const bf16_t* XBp, bf16_t* MIXIN, LAS unsigned char* lds, int blk, int G) {
    const int tid = otid(), lane = tid & 63, w = __builtin_amdgcn_readfirstlane(tid >> 6);
    __syncthreads();
    for (int u = blk; u < 2048; u += G) {
        int grp = u >> 3, h = u & 7;
        if (G == 256) { const int x = u & 7, j = (u >> 3) & 31, e8 = u >> 8; h = j & 7; grp = 32 * x + 4 * e8 + (j >> 3); }
        const int row0 = grp * 256;
        const int base = row0 < ROWS_P ? (row0 & ~16383) : (ROWS_P + ((row0 - ROWS_P) & ~4095)), S = row0 < ROWS_P ? 16384 : 4096, P0 = row0 - base;
        for (int br = 0; br < 3; ++br) {
            wave_tile(XBp, lds, w, lane, base, S, P0, h, 16 * br + w);
            wave_tile(XBp, lds, w, lane, base, S, P0, h, 16 * br + w + 8);
            __syncthreads();
        }
        {
            const int pos = tid >> 1, half = tid & 1;
            const LAS float* op = (const LAS float*)(lds + L_OUT) + (pos + (pos >> 4)) * OS + 32 * half;
            const float inv = 1.f / ((const LAS float*)(lds + L_L))[pos];
            unsigned wv[16];
#pragma unroll
            for (int d = 0; d < 16; ++d) wv[d] = cvt_pk_bf16(op[2 * d] * inv, op[2 * d + 1] * inv);
            u32x4* gp = (u32x4*)(MIXIN + (size_t)(row0 + pos) * DM + h * 64 + 32 * half);
#pragma unroll
            for (int c = 0; c < 4; ++c) gp[c] = (u32x4){wv[4 * c], wv[4 * c + 1], wv[4 * c + 2], wv[4 * c + 3]};
        }
        __syncthreads();
    }
}
}

namespace hg {
typedef short bf16x8 __attribute__((ext_vector_type(8)));
constexpr int SEG = 1024, NCH = 16, NITEM = 512;
constexpr int RS = 272, TS = 144;
constexpr int L_QT = 0, L_QR = 17408, L_KR = 34816, L_K0 = 52224, L_Q4 = 56576, L_KT = 60928, L_VT = 79360, L_ST = 97792, L_AB = 132608, L_TOT = 141824, L_BV = 143872, L_END = 144384;
static_assert(L_END <= LDS_BYTES, "hgrn LDS map");
constexpr size_t DO_STATE = 140 * MiB, DO_DEC = 172 * MiB, DO_OB = 176 * MiB, DO_INIT = 240 * MiB;

__device__ __forceinline__ int phys_row(int g, int dir, int lt) { return dir ? (g * SEG + SEG - 1 - lt) : (g * SEG + lt); }
__device__ __forceinline__ unsigned short bf1(float x) { __bf16 b = (__bf16)x; return __builtin_bit_cast(unsigned short, b); }
__device__ __forceinline__ bf16x8 ldfrag(LAS unsigned char* lds, int off, int stride, int row0, int kel, int lane) {
    return *(const LAS bf16x8*)(lds + off + (row0 + (lane & 15)) * stride + (kel + 8 * (lane >> 4)) * 2);
}
template <bool FULL>
__device__ __forceinline__ void load_raw(const bf16_t* U, int g, int dir, int ch, int i, int zcol, int qcol, int vcol, unsigned short (&rz)[16], unsigned short (&rq)[16], unsigned short (&rv)[16]) {
#pragma unroll
    for (int r = 0; r < 16; ++r) {
        const bf16_t* pr = U + (size_t)phys_row(g, dir, 64 * ch + 16 * i + r) * UP;
        rz[r] = pr[zcol]; if (FULL) rq[r] = pr[qcol]; rv[r] = pr[vcol];
    }
}
template <bool FULL>
__device__ __forceinline__ void prep(LAS unsigned char* lds, int i, int c, float lb, const unsigned short (&rz)[16], const unsigned short (&rq)[16], const unsigned short (&rv)[16], float& bdec) {
    float f[16], e1[16], qs[16];
    float run = 1.f;
#pragma unroll
    for (int r = 0; r < 16; ++r) {
        const float fr = lb + (1.f - lb) * sigmoid_f(bf2f(rz[r]));
        f[r] = fr; run *= fr; e1[r] = run;
        if (FULL) qs[r] = silu_f(bf2f(rq[r])); else qs[r] = 0.f;
    }
    ((LAS float*)(lds + L_TOT))[i * 128 + c] = run;
    {
        u32x4 a, b;
        a.x = rv[0] | ((unsigned)rv[1] << 16); a.y = rv[2] | ((unsigned)rv[3] << 16); a.z = rv[4] | ((unsigned)rv[5] << 16); a.w = rv[6] | ((unsigned)rv[7] << 16);
        b.x = rv[8] | ((unsigned)rv[9] << 16); b.y = rv[10] | ((unsigned)rv[11] << 16); b.z = rv[12] | ((unsigned)rv[13] << 16); b.w = rv[14] | ((unsigned)rv[15] << 16);
        LAS u32x4* vp = (LAS u32x4*)(lds + L_VT + c * TS + 32 * i); vp[0] = a; vp[1] = b;
    }
    __syncthreads();
    const LAS float* tp = (const LAS float*)(lds + L_TOT) + c;
    const float p0 = tp[0], p1 = tp[128], p2 = tp[256], p3 = tp[384];
    const float cQT = i == 0 ? 1.f : i == 1 ? p0 : i == 2 ? p0 * p1 : p0 * p1 * p2;
    const float cKT = i == 0 ? p1 * p2 * p3 : i == 1 ? p2 * p3 : i == 2 ? p3 : 1.f;
    const float cQR = i == 0 ? 1.f : i == 1 ? __builtin_amdgcn_rcpf(p1) : i == 2 ? 1.f : p2;
    const float cKR = i == 0 ? p1 : i == 1 ? 1.f : i == 2 ? __builtin_amdgcn_rcpf(p2) : 1.f;
    const float cK0 = __builtin_amdgcn_rcpf(p0), cQ4 = __builtin_amdgcn_rcpf(p3);
    bdec = (p0 * p1) * (p2 * p3);
    if (i == 0) ((LAS float*)(lds + L_BV))[c] = bdec;
    unsigned short kt[16];
    float e2 = 1.f;
#pragma unroll
    for (int r = 15; r >= 0; --r) {
        const float kb = (1.f - f[r]) * e2;
        kt[r] = bf1(kb * cKT);
        if (FULL) {
            *(LAS unsigned short*)(lds + L_KR + (16 * i + r) * RS + c * 2) = bf1(kb * cKR);
            if (i == 0) *(LAS unsigned short*)(lds + L_K0 + r * RS + c * 2) = bf1(kb * cK0);
        }
        e2 *= f[r];
    }
    {
        u32x4 a, b;
        a.x = kt[0] | ((unsigned)kt[1] << 16); a.y = kt[2] | ((unsigned)kt[3] << 16); a.z = kt[4] | ((unsigned)kt[5] << 16); a.w = kt[6] | ((unsigned)kt[7] << 16);
        b.x = kt[8] | ((unsigned)kt[9] << 16); b.y = kt[10] | ((unsigned)kt[11] << 16); b.z = kt[12] | ((unsigned)kt[13] << 16); b.w = kt[14] | ((unsigned)kt[15] << 16);
        LAS u32x4* kp = (LAS u32x4*)(lds + L_KT + c * TS + 32 * i); kp[0] = a; kp[1] = b;
    }
    if (FULL) {
#pragma unroll
        for (int r = 0; r < 16; ++r) {
            const float qe = qs[r] * e1[r];
            *(LAS unsigned short*)(lds + L_QT + (16 * i + r) * RS + c * 2) = bf1(qe * cQT);
            *(LAS unsigned short*)(lds + L_QR + (16 * i + r) * RS + c * 2) = bf1(qe * cQR);
            if (i == 3) *(LAS unsigned short*)(lds + L_Q4 + r * RS + c * 2) = bf1(qe * cQ4);
        }
    }
}
__device__ __forceinline__ void state_update(LAS unsigned char* lds, f32x4 (&S)[8], int w, int gq, int lane) {
    bf16x8 ktf[2];
#pragma unroll
    for (int k2 = 0; k2 < 2; ++k2) ktf[k2] = ldfrag(lds, L_KT, TS, 16 * w, 32 * k2, lane);
    const f32x4 dk = *(const LAS f32x4*)(lds + L_BV + (16 * w + 4 * gq) * 4);
#pragma unroll
    for (int n = 0; n < 8; ++n) {
        S[n] = S[n] * dk;
#pragma unroll
        for (int k2 = 0; k2 < 2; ++k2) S[n] = __builtin_amdgcn_mfma_f32_16x16x32_bf16(ktf[k2], ldfrag(lds, L_VT, TS, 16 * n, 32 * k2, lane), S[n], 0, 0, 0);
    }
}
__device__ __forceinline__ int item_of(int lin, int G) {
    if (G != 256) return lin;
    const int x = lin & 7, j = (lin >> 3) & 31, e = lin >> 8, g = 8 * x + 2 * (j >> 3) + e, hd = j & 7;
    return g * 8 + hd;
}
__device__ __forceinline__ float lb_of(const Params& p, int dir, int col) { const float* lbr = dir ? p.lb_bwd : p.lb_fwd; return 1.f / (1.f + __expf(lbr[512 + col] - lbr[col])); }

__device__ __forceinline__ void pass1(const Params& p, const bf16_t* U, LAS unsigned char* lds, int item) {
    const int tid = otid(), lane = tid & 63, w = __builtin_amdgcn_readfirstlane(tid >> 6), i = w >> 1, c = tid & 127, gq = lane >> 4;
    const int dir = item & 1, hh = (item >> 1) & 3, g = item >> 3;
    float* STATE = (float*)((unsigned char*)p.out + DO_STATE); float* DEC = (float*)((unsigned char*)p.out + DO_DEC);
    const float lb = lb_of(p, dir, hh * 128 + c);
    const int zcol = (dir ? UC_ZB : UC_ZF) + hh * 128 + c, qcol = UC_QH + hh * 128 + c, vcol = UC_IH + hh * 128 + c;
    f32x4 S[8];
#pragma unroll
    for (int n = 0; n < 8; ++n) S[n] = (f32x4){0.f, 0.f, 0.f, 0.f};
    float dtot = 1.f;
    unsigned short rz[16], rq[16], rv[16];
    load_raw<false>(U, g, dir, 0, i, zcol, qcol, vcol, rz, rq, rv);
    for (int ch = 0; ch < NCH; ++ch) {
        float bdec;
        prep<false>(lds, i, c, lb, rz, rq, rv, bdec);
        dtot *= bdec;
        if (ch + 1 < NCH) load_raw<false>(U, g, dir, ch + 1, i, zcol, qcol, vcol, rz, rq, rv);
        __syncthreads();
        state_update(lds, S, w, gq, lane);
        __syncthreads();
    }
    float* sp = STATE + (size_t)item * 16384 + (16 * w + 4 * gq) * 128 + (lane & 15);
#pragma unroll
    for (int n = 0; n < 8; ++n)
#pragma unroll
        for (int jj = 0; jj < 4; ++jj) sp[jj * 128 + 16 * n] = S[n][jj];
    if (i == 0) DEC[item * 128 + c] = dtot;
}
__device__ __forceinline__ void scan(const Params& p, int gt, int ngt) {
    const float* STATE = (const float*)((unsigned char*)p.out + DO_STATE); const float* DEC = (const float*)((unsigned char*)p.out + DO_DEC);
    bf16_t* INIT = (bf16_t*)((unsigned char*)p.out + DO_INIT);
    for (int e = gt; e < 80 * 4096; e += ngt) {
        const int chain = e >> 12, q4 = e & 4095, k = q4 >> 5;
        const int dir = chain & 1, hh = (chain >> 1) & 3, sb = chain >> 3;
        const int nseg = sb < 2 ? 16 : 4, g0 = sb < 2 ? sb * 16 : 32 + (sb - 2) * 4;
        f32x4 s = {0.f, 0.f, 0.f, 0.f};
        for (int j = 0; j < nseg; ++j) {
            const int g = dir ? (g0 + nseg - 1 - j) : (g0 + j), item = (g * 4 + hh) * 2 + dir;
            const f32x4 en = *((const f32x4*)(STATE + (size_t)item * 16384) + q4);
            u32x2v wv; wv.x = cvt_pk_bf16(s[0], s[1]); wv.y = cvt_pk_bf16(s[2], s[3]);
            *((u32x2v*)(INIT + (size_t)item * 16384) + q4) = wv;
            s = s * DEC[item * 128 + k] + en;
        }
    }
}
__device__ __forceinline__ void pass2(const Params& p, const bf16_t* U, bf16_t* MIXIN, LAS unsigned char* lds, int item) {
    const int tid = otid(), lane = tid & 63, w = __builtin_amdgcn_readfirstlane(tid >> 6), i = w >> 1, c = tid & 127, gq = lane >> 4;
    const int dir = item & 1, hh = (item >> 1) & 3, g = item >> 3;
    const bf16_t* INIT = (const bf16_t*)((unsigned char*)p.out + DO_INIT);
    bf16_t* OUT = dir ? (bf16_t*)((unsigned char*)p.out + DO_OB) + hh * 128 : MIXIN + 512 + hh * 128;
    const int opitch = dir ? 512 : DM;
    const float lb = lb_of(p, dir, hh * 128 + c);
    const int zcol = (dir ? UC_ZB : UC_ZF) + hh * 128 + c, qcol = UC_QH + hh * 128 + c, vcol = UC_IH + hh * 128 + c;
    for (int idx = tid; idx < 64 * TS / 4; idx += 512) ((LAS unsigned*)(lds + L_AB))[idx] = 0u;
    f32x4 S[8];
    {
        const bf16_t* sp = INIT + (size_t)item * 16384 + (16 * w + 4 * gq) * 128 + (lane & 15);
#pragma unroll
        for (int n = 0; n < 8; ++n)
#pragma unroll
            for (int jj = 0; jj < 4; ++jj) S[n][jj] = bf2f(sp[jj * 128 + 16 * n]);
    }
#define HG_ST_WRITE() do { _Pragma("unroll") for (int n = 0; n < 8; ++n) { u32x2v wv; wv.x = cvt_pk_bf16(S[n][0], S[n][1]); wv.y = cvt_pk_bf16(S[n][2], S[n][3]); \
        *(LAS u32x2v*)(lds + L_ST + (16 * n + (lane & 15)) * RS + (16 * w + 4 * gq) * 2) = wv; } } while (0)
    HG_ST_WRITE();
    unsigned short rz[16], rq[16], rv[16];
    load_raw<true>(U, g, dir, 0, i, zcol, qcol, vcol, rz, rq, rv);
    for (int ch = 0; ch < NCH; ++ch) {
        float bdec;
        prep<true>(lds, i, c, lb, rz, rq, rv, bdec);
        if (ch + 1 < NCH) load_raw<true>(U, g, dir, ch + 1, i, zcol, qcol, vcol, rz, rq, rv);
        __syncthreads();
        for (int bi = w; bi < 10; bi += 8) {
            const int ti = bi >= 6 ? 3 : bi >= 3 ? 2 : bi >= 1 ? 1 : 0, tj = bi - ti * (ti + 1) / 2;
            const int qoff = (bi == 9) ? L_Q4 : L_QR + 16 * ti * RS, koff = (bi == 0) ? L_K0 : L_KR + 16 * tj * RS;
            f32x4 a = {0.f, 0.f, 0.f, 0.f};
#pragma unroll
            for (int ks = 0; ks < 4; ++ks) a = __builtin_amdgcn_mfma_f32_16x16x32_bf16(ldfrag(lds, qoff, RS, 0, 32 * ks, lane), ldfrag(lds, koff, RS, 0, 32 * ks, lane), a, 0, 0, 0);
#pragma unroll
            for (int jj = 0; jj < 4; ++jj) {
                float val = a[jj];
                if (ti == tj && (lane & 15) > 4 * gq + jj) val = 0.f;
                *(LAS unsigned short*)(lds + L_AB + (16 * ti + 4 * gq + jj) * TS + (16 * tj + (lane & 15)) * 2) = bf1(val);
            }
        }
        __syncthreads();
        {
            bf16x8 stf[4], vtf[2];
#pragma unroll
            for (int ks = 0; ks < 4; ++ks) stf[ks] = ldfrag(lds, L_ST, RS, 16 * w, 32 * ks, lane);
#pragma unroll
            for (int k2 = 0; k2 < 2; ++k2) vtf[k2] = ldfrag(lds, L_VT, TS, 16 * w, 32 * k2, lane);
#pragma unroll
            for (int mt = 0; mt < 4; ++mt) {
                f32x4 o = {0.f, 0.f, 0.f, 0.f};
#pragma unroll
                for (int ks = 0; ks < 4; ++ks) o = __builtin_amdgcn_mfma_f32_16x16x32_bf16(ldfrag(lds, L_QT, RS, 16 * mt, 32 * ks, lane), stf[ks], o, 0, 0, 0);
#pragma unroll
                for (int k2 = 0; k2 < 2; ++k2) o = __builtin_amdgcn_mfma_f32_16x16x32_bf16(ldfrag(lds, L_AB, TS, 16 * mt, 32 * k2, lane), vtf[k2], o, 0, 0, 0);
#pragma unroll
                for (int jj = 0; jj < 4; ++jj) {
                    const int row = phys_row(g, dir, 64 * ch + 16 * mt + 4 * gq + jj);
                    OUT[(size_t)row * opitch + 16 * w + (lane & 15)] = bf1(o[jj]);
                }
            }
        }
        state_update(lds, S, w, gq, lane);
        __syncthreads();
        HG_ST_WRITE();
    }
#undef HG_ST_WRITE
}
}

__device__ __forceinline__ void hg_finalize(const Params& p, const bf16_t* U, bf16_t* MIXIN, int blk, int G, int wave, int lane) {
    const float gn0 = p.g_hgrn[2 * lane], gn1 = p.g_hgrn[2 * lane + 1];
    const bf16_t* OB = (const bf16_t*)((const unsigned char*)p.out + hg::DO_OB);
    const int gw = blk * 8 + wave, ngw = G * 8;
    for (int row = gw; row < T_; row += ngw) {
#pragma unroll
        for (int hh = 0; hh < 4; ++hh) {
            unsigned* mp = (unsigned*)(MIXIN + (size_t)row * DM + 512 + hh * 128) + lane;
            const unsigned w = *mp, gw2 = *((const unsigned*)(U + (size_t)row * UP + UC_GH + hh * 128) + lane);
            const unsigned wb = *((const unsigned*)(OB + (size_t)row * 512 + hh * 128) + lane);
            const float o0 = __uint_as_float(w << 16) + __uint_as_float(wb << 16), o1 = __uint_as_float(w & 0xffff0000u) + __uint_as_float(wb & 0xffff0000u);
            const float g0 = __uint_as_float(gw2 << 16), g1 = __uint_as_float(gw2 & 0xffff0000u);
            const float rs = rsqrtf(wave_sum(o0 * o0 + o1 * o1) * (1.f / 128.f) + EPS);
            *mp = cvt_pk_bf16(o0 * rs * gn0 * silu_f(g0), o1 * rs * gn1 * silu_f(g1));
        }
    }
}

__device__ __forceinline__ void p6_rows(const Params& p, LAS unsigned char* lds, int gw, int ngw, int wave, int lane) {
    bf16_t* WGU = (bf16_t*)(p.ws + WS_WGU); bf16_t* WDN = (bf16_t*)(p.ws + WS_WDN);
    LAS float* scr = (LAS float*)(lds + wave * 16384);
    constexpr int I_G = 16 * 88, I_D = 44 * 32;
    for (int it = gw; it < 2 * I_G + I_D; it += ngw) {
        if (it < I_G) transpose_item(p.w_gate, DFF, 64 * (it / 88), 32 * (it % 88), p.g_pre_ffn, WGU, DM, RowGU{0}, scr, lane);
        else if (it < 2 * I_G) { const int r = it - I_G; transpose_item(p.w_up, DFF, 64 * (r / 88), 32 * (r % 88), p.g_pre_ffn, WGU, DM, RowGU{1}, scr, lane); }
        else { const int r = it - 2 * I_G; transpose_item(p.w_down, DM, 64 * (r / 32), 32 * (r % 32), nullptr, WDN, DFF, RowId{}, scr, lane); }
    }
    bf16_t* MIX = (bf16_t*)(p.ws + WS_MIX); const float* SS = (const float*)(p.ws + WS_SS1);
    f32x4 gp[4];
#pragma unroll
    for (int j = 0; j < 4; ++j) gp[j] = ((const f32x4*)p.g_post_mix)[lane + 64 * j];
    for (int m0 = gw * 4; m0 < T_; m0 += ngw * 4) {
        f32x4 xv[4][4]; u32x2v mw[4][4]; float r1[4];
#pragma unroll
        for (int k = 0; k < 4; ++k) {
            const int m = m0 + k;
            const f32x4* ssp = (const f32x4*)(SS + (size_t)m * 16);
            const f32x4 a = ssp[0], b = ssp[1], c = ssp[2], d = ssp[3];
            const float ss = ((a[0] + a[1]) + (a[2] + a[3])) + ((b[0] + b[1]) + (b[2] + b[3])) + ((c[0] + c[1]) + (c[2] + c[3])) + ((d[0] + d[1]) + (d[2] + d[3]));
            r1[k] = rsqrtf(ss * (1.f / DM) + EPS);
            const f32x4* xr = (const f32x4*)xrow_ptr(p, m) + lane;
            const u32x2v* mx = (const u32x2v*)(MIX + (size_t)m * DM) + lane;
#pragma unroll
            for (int jj = 0; jj < 4; ++jj) { xv[k][jj] = xr[64 * jj]; mw[k][jj] = mx[64 * jj]; }
        }
        float s2[4];
#pragma unroll
        for (int k = 0; k < 4; ++k) {
            f32x4* xo = (f32x4*)(p.out + (size_t)(m0 + k) * DM) + lane;
            s2[k] = 0.f;
#pragma unroll
            for (int jj = 0; jj < 4; ++jj) {
                const u32x2v w = mw[k][jj];
                f32x4 mv = {__uint_as_float(w.x << 16), __uint_as_float(w.x & 0xffff0000u), __uint_as_float(w.y << 16), __uint_as_float(w.y & 0xffff0000u)};
                xv[k][jj] = xv[k][jj] + mv * r1[k] * gp[jj];
                s2[k] += (xv[k][jj][0] * xv[k][jj][0] + xv[k][jj][1] * xv[k][jj][1]) + (xv[k][jj][2] * xv[k][jj][2] + xv[k][jj][3] * xv[k][jj][3]);
                xo[64 * jj] = xv[k][jj];
            }
        }
#pragma unroll
        for (int k = 0; k < 4; ++k) {
            const float r2 = rsqrtf(wave_sum(s2[k]) * (1.f / DM) + EPS);
            u32x2v* mx = (u32x2v*)(MIX + (size_t)(m0 + k) * DM) + lane;
#pragma unroll
            for (int jj = 0; jj < 4; ++jj) { u32x2v w; w.x = cvt_pk_bf16(xv[k][jj][0] * r2, xv[k][jj][1] * r2); w.y = cvt_pk_bf16(xv[k][jj][2] * r2, xv[k][jj][3] * r2); mx[64 * jj] = w; }
        }
    }
}
__device__ __forceinline__ void p9_rows(const Params& p, int gw, int ngw, int lane) {
    const bf16_t* FF = (const bf16_t*)(p.ws + WS_MIX); const float* SS = (const float*)(p.ws + WS_SS2);
    f32x4 gp[4];
#pragma unroll
    for (int j = 0; j < 4; ++j) gp[j] = ((const f32x4*)p.g_post_ffn)[lane + 64 * j];
    for (int m0 = gw * 4; m0 < T_; m0 += ngw * 4) {
        f32x4 xv[4][4]; u32x2v fw[4][4]; float r1[4];
#pragma unroll
        for (int k = 0; k < 4; ++k) {
            const int m = m0 + k;
            const f32x4* ssp = (const f32x4*)(SS + (size_t)m * 16);
            const f32x4 a = ssp[0], b = ssp[1], c = ssp[2], d = ssp[3];
            const float ss = ((a[0] + a[1]) + (a[2] + a[3])) + ((b[0] + b[1]) + (b[2] + b[3])) + ((c[0] + c[1]) + (c[2] + c[3])) + ((d[0] + d[1]) + (d[2] + d[3]));
            r1[k] = rsqrtf(ss * (1.f / DM) + EPS);
            const u32x2v* fx = (const u32x2v*)(FF + (size_t)m * DM) + lane;
            const f32x4* xo = (const f32x4*)(p.out + (size_t)m * DM) + lane;
#pragma unroll
            for (int jj = 0; jj < 4; ++jj) { xv[k][jj] = xo[64 * jj]; fw[k][jj] = fx[64 * jj]; }
        }
#pragma unroll
        for (int k = 0; k < 4; ++k) {
            f32x4* xo = (f32x4*)(p.out + (size_t)(m0 + k) * DM) + lane;
#pragma unroll
            for (int jj = 0; jj < 4; ++jj) {
                const u32x2v w = fw[k][jj];
                f32x4 fv = {__uint_as_float(w.x << 16), __uint_as_float(w.x & 0xffff0000u), __uint_as_float(w.y << 16), __uint_as_float(w.y & 0xffff0000u)};
                xo[64 * jj] = xv[k][jj] + fv * r1[k] * gp[jj];
            }
        }
    }
}

__global__ void __launch_bounds__(512, 2) fwd_megakernel(Params p) {
    extern __shared__ __attribute__((aligned(16))) unsigned char lds_raw[];
    LAS unsigned char* lds = (LAS unsigned char*)lds_raw;
    cg::grid_group grid = cg::this_grid();
#define GSYNC() do { asm volatile("s_waitcnt vmcnt(0)" ::: "memory"); grid.sync(); \
        if (wave == 0) { __builtin_amdgcn_fence(__ATOMIC_ACQUIRE, "agent"); asm volatile("s_waitcnt vmcnt(0)" ::: "memory"); } __syncthreads(); } while (0)
    const int tid = otid(), lane = tid & 63, wave = __builtin_amdgcn_readfirstlane(tid >> 6);
    const int G = gridDim.x, blk = blockIdx.x;
    const int gw = blk * 8 + wave, ngw = G * 8;
    unsigned char* dob = (unsigned char*)p.out;
    bf16_t* U = (bf16_t*)(p.ws + WS_U);
    bf16_t* MIXIN = (bf16_t*)(dob + DO_MIXIN);

    volatile LAS unsigned* bst = (volatile LAS unsigned*)(lds + LDS_BYTES - 16);
    if (tid < 2) bst[tid] = 0u;
    if (blk == 0) for (int i2 = tid; i2 < 3456; i2 += 512) __hip_atomic_store(g_bar + i2, 0u, __ATOMIC_RELAXED, __HIP_MEMORY_SCOPE_AGENT);
    p0_prologue(p, lds, gw, ngw, wave, lane);
    GSYNC();
    const XcdBarrier xbar = xcd_barrier_post(g_bar, bst);
#define XSYNC() xcd_barrier(xbar)
    {
        pg8::Gemm g{(const bf16_t*)(dob + DO_XN), (const bf16_t*)(dob + DO_WIN), T_, NIN, DM}; pg8::StaticOrder S; S.init(T_, NIN, G, blk);
        EpiU E{U, (bf16_t*)(p.ws + WS_QB), (const float*)(dob + DO_ROPE)};
        pg8::gemm_phase<EpiU, pg8::StaticOrder, true, true>(lds, g, S, E);
    }
    XSYNC();
    for (int lin = blk; lin < hg::NITEM; lin += G) hg::pass1(p, U, lds, hg::item_of(lin, G));
    at::attn_phase((const bf16_t*)(p.ws + WS_QB), MIXIN, lds, blk, G);
    XSYNC();
    hg::scan(p, blk * 512 + tid, G * 512);
    XSYNC();
    for (int lin = blk; lin < hg::NITEM; lin += G) hg::pass2(p, U, MIXIN, lds, hg::item_of(lin, G));
    XSYNC();
    hg_finalize(p, U, MIXIN, blk, G, wave, lane);
    XSYNC();
    {
        pg8::Gemm g{MIXIN, (const bf16_t*)(dob + DO_WOUT), T_, DM, DM}; pg8::StaticOrder S; S.init(T_, DM, G, blk);
        EpiRowSS E{(bf16_t*)(p.ws + WS_MIX), (float*)(p.ws + WS_SS1)};
        pg8::gemm_phase<EpiRowSS, pg8::StaticOrder, true, true>(lds, g, S, E);
    }
    XSYNC();
    p6_rows(p, lds, gw, ngw, wave, lane);
    XSYNC();
    {
        pg8::Gemm g{(const bf16_t*)(p.ws + WS_MIX), (const bf16_t*)(p.ws + WS_WGU), T_, 2 * DFF, DM}; pg8::StaticOrder S; S.init(T_, 2 * DFF, G, blk);
        EpiSwiGLU E{(bf16_t*)(p.ws + WS_HFF)};
        pg8::gemm_phase<EpiSwiGLU, pg8::StaticOrder, true, true>(lds, g, S, E);
    }
    XSYNC();
    {
        pg8::Gemm g{(const bf16_t*)(p.ws + WS_HFF), (const bf16_t*)(p.ws + WS_WDN), T_, DM, DFF}; pg8::StaticOrder S; S.init(T_, DM, G, blk);
        EpiRowSS E{(bf16_t*)(p.ws + WS_MIX), (float*)(p.ws + WS_SS2)};
        pg8::gemm_phase<EpiRowSS, pg8::StaticOrder, true, true>(lds, g, S, E);
    }
    XSYNC();
    p9_rows(p, gw, ngw, lane);
}

extern "C" void kernel_launch(void* const* d_in, const int* in_sizes, int n_in, void* d_out, int out_size, void* d_ws, size_t ws_size, hipStream_t stream) {
    static int grid_blocks = 0;
    if (grid_blocks == 0) {
        int dev = 0, cus = 0, per_cu = 0;
        hipGetDevice(&dev);
        hipDeviceGetAttribute(&cus, hipDeviceAttributeMultiprocessorCount, dev);
        hipFuncSetAttribute((const void*)fwd_megakernel, hipFuncAttributeMaxDynamicSharedMemorySize, LDS_BYTES);
        hipOccupancyMaxActiveBlocksPerMultiprocessor(&per_cu, (const void*)fwd_megakernel, 512, LDS_BYTES);
        if (per_cu < 1) { fprintf(stderr, "occupancy query reports %d blocks per CU\n", per_cu); per_cu = 1; }
        if (per_cu > 1) per_cu = 1;
        grid_blocks = cus * per_cu;
        if (ws_size < 512 * MiB) fprintf(stderr, "kernel_launch: workspace %zu smaller than the 512 MiB map\n", ws_size);
    }
    Params p{};
    p.xp = (const float*)d_in[0]; p.xs = (const float*)d_in[1]; p.w_in = (const float*)d_in[2]; p.w_out = (const float*)d_in[3];
    p.lb_fwd = (const float*)d_in[4]; p.lb_bwd = (const float*)d_in[5]; p.g_hgrn = (const float*)d_in[6]; p.g_pre_mix = (const float*)d_in[7];
    p.g_post_mix = (const float*)d_in[8]; p.g_pre_ffn = (const float*)d_in[9]; p.g_post_ffn = (const float*)d_in[10];
    p.w_gate = (const float*)d_in[11]; p.w_up = (const float*)d_in[12]; p.w_down = (const float*)d_in[13];
    p.out = (float*)d_out; p.ws = (unsigned char*)d_ws;
    void* args[] = {&p};
    hipError_t e = hipLaunchCooperativeKernel((const void*)fwd_megakernel, dim3(grid_blocks), dim3(512), args, LDS_BYTES, stream);
    if (e != hipSuccess) fprintf(stderr, "cooperative launch failed: %s (grid %d)\n", hipGetErrorString(e), grid_blocks);
}
```

```cpp
#include <hip/hip_runtime.h>
#include <hip/hip_cooperative_groups.h>
#include <cstdio>
#include <cstdint>
namespace cg = cooperative_groups;
namespace pg8 {
#define PG8_LAS __attribute__((address_space(3)))
typedef unsigned short bf16_t;
typedef short bf16x8 __attribute__((ext_vector_type(8)));
typedef float f32x4 __attribute__((ext_vector_type(4)));
typedef unsigned u32x4 __attribute__((ext_vector_type(4)));
constexpr int BM = 256, BK = 64, HALF = 128, HTB = HALF * BK * 2  , STAGE_BYTES = 8 * HTB, NXCD = 8, WGM = 8;

__host__ __device__ __forceinline__ int lds_byte(int r, int c) { const int st = (r >> 4) * 2 + (c >> 5), rr = r & 15, cc = c & 31, ob = rr * 64 + cc * 2; return st * 1024 + (ob ^ (((ob >> 9) & 1) << 5)); }
__host__ __device__ __forceinline__ void stage_rc(int b, int& R, int& C) { const int st = b / 1024, sb = b % 1024, swz = sb ^ (((sb >> 9) & 1) << 5); R = (st >> 1) * 16 + swz / 64; C = (st & 1) * 32 + (swz % 64) / 2; }
__host__ __device__ __forceinline__ int perm32(int rho) { const int n = rho >> 4, i = rho & 15; return 8 * (i >> 2) + 4 * n + (i & 3); }

struct Unit { int pm, pn; };
struct Gemm { const bf16_t* A; const bf16_t* Bt; int M, N, K; };

struct StaticOrder {
    int nM, nN, nwg, G, c;
    __host__ __device__ void init(int M, int N, int G_, int c_) { nM = M / BM; nN = N / BM; nwg = nM * nN; G = G_; c = c_; }
    __host__ __device__ bool next(int i, Unit& u) const {
        const long L = (long)i * G + c; if (L >= nwg) return false;
        int wgid = (int)L; { const int q = nwg / NXCD, r = nwg % NXCD, xcd = wgid % NXCD, off = wgid / NXCD; wgid = (xcd < r ? xcd * (q + 1) : r * (q + 1) + (xcd - r) * q) + off; }
        const int nig = WGM * nN, gid = wgid / nig, fm = gid * WGM, gsz = (nM - fm) < WGM ? (nM - fm) : WGM;
        u.pm = fm + ((wgid % nig) % gsz); u.pn = (wgid % nig) / gsz; return true;
    }
    __device__ __forceinline__ void a_ready(const Unit&) const {}
    __device__ __forceinline__ void done(const Unit&) const {}
};

typedef __bf16 bf16x2_t __attribute__((ext_vector_type(2)));
typedef float f32x2_t __attribute__((ext_vector_type(2)));
__device__ __forceinline__ unsigned cvt_pk_bf16(float lo, float hi) { f32x2_t v = {lo, hi}; bf16x2_t b = __builtin_convertvector(v, bf16x2_t); return __builtin_bit_cast(unsigned, b); }
typedef float f32x2 __attribute__((ext_vector_type(2)));
template <class Epi, class Sched, bool ALIGN_EPI = false, bool SP2 = false>
__device__ __forceinline__ void gemm_phase(PG8_LAS unsigned char* lds, const Gemm g, const Sched& S, const Epi& E) {
    int tid; asm volatile("v_mov_b32 %0, %1" : "=v"(tid) : "v"((int)threadIdx.x));
    const int wid = __builtin_amdgcn_readfirstlane(tid >> 6), lane = tid & 63, wr = wid >> 2, wc = wid & 3, fr = lane & 15, fq = lane >> 4;
    const int K = g.K, nt = K / BK;
    unsigned voffA[2], voffB[2];
#pragma unroll
    for (int i = 0; i < 2; ++i) { int R, C; stage_rc(tid * 16 + i * 8192, R, C); const int Rb = Epi::PERM ? ((R & ~31) + perm32(R & 31)) : R;
        voffA[i] = (unsigned)(R * K + C) * 2u; voffB[i] = (unsigned)(Rb * K + C) * 2u; }
    const size_t kstep = (size_t)(BK * 2);
    const size_t hstep = (size_t)HALF * K * 2;
    const size_t tstep = 2 * hstep;
    const unsigned ldsw = (unsigned)wid * 1024u;
    const int aoff = lds_byte(wr * 64 + fr, fq * 8), boff = lds_byte(wc * 32 + fr, fq * 8);
#define PG8_SA(b, h) (((b) * 2 + (h)) * HTB)
#define PG8_SB(b, h) ((4 + (b) * 2 + (h)) * HTB)
#define PG8_STAGE(bufoff, gbase, voff) do { _Pragma("unroll") for (int _i = 0; _i < 2; ++_i) \
        __builtin_amdgcn_global_load_lds((const unsigned*)((const char*)(gbase) + (voff)[_i]), (PG8_LAS unsigned*)(lds + (bufoff) + ldsw + _i * 8192), 16, 0, 0); } while (0)
#define PG8_LDA(dst, b, h) do { _Pragma("unroll") for (int m = 0; m < 4; ++m) _Pragma("unroll") for (int k = 0; k < 2; ++k) dst[m][k] = *(const PG8_LAS bf16x8*)(lds + PG8_SA(b, h) + aoff + m * 2048 + k * 1024); } while (0)
#define PG8_LDB(dst, b, h) do { _Pragma("unroll") for (int n = 0; n < 2; ++n) _Pragma("unroll") for (int k = 0; k < 2; ++k) dst[n][k] = *(const PG8_LAS bf16x8*)(lds + PG8_SB(b, h) + boff + n * 2048 + k * 1024); } while (0)
#define PG8_MMA(ai, bj, At, Bt) do { __builtin_amdgcn_s_setprio(1); _Pragma("unroll") for (int m = 0; m < 4; ++m) _Pragma("unroll") for (int n = 0; n < 2; ++n) _Pragma("unroll") for (int k = 0; k < 2; ++k) \
        acc[ai][bj][m][n] = __builtin_amdgcn_mfma_f32_16x16x32_bf16(Bt[n][k], At[m][k], acc[ai][bj][m][n], 0, 0, 0); __builtin_amdgcn_s_setprio(0); } while (0)
#define PG8_WAIT_V(n) asm volatile("s_waitcnt vmcnt(" #n ")" ::: "memory")
#define PG8_WAIT_L(n) asm volatile("s_waitcnt lgkmcnt(" #n ")" ::: "memory")
#define PG8_BAR __builtin_amdgcn_s_barrier()
#define PG8_SCHED __builtin_amdgcn_sched_barrier(0)
    Unit cur, nxt; int ui = 0;
    if (!S.next(0, cur)) return;
    f32x4 acc[2][2][4][2];
#pragma unroll
    for (int a = 0; a < 2; ++a)
#pragma unroll
        for (int b = 0; b < 2; ++b)
#pragma unroll
            for (int m = 0; m < 4; ++m)
#pragma unroll
                for (int n = 0; n < 2; ++n) acc[a][b][m][n] = (f32x4){0.f, 0.f, 0.f, 0.f};
    bf16x8 At[4][2], B0[2][2], B1[2][2];
    const char* cA = (const char*)g.A + (size_t)cur.pm * tstep; const char* cB = (const char*)g.Bt + (size_t)cur.pn * tstep;
    S.a_ready(cur);
    if constexpr (SP2) {
        PG8_STAGE(PG8_SB(0, 0), cB, voffB); PG8_STAGE(PG8_SB(0, 1), cB + hstep, voffB); PG8_STAGE(PG8_SA(0, 0), cA, voffA); PG8_STAGE(PG8_SA(0, 1), cA + hstep, voffA);
        if (wr == 1) PG8_BAR;
        PG8_WAIT_V(2); PG8_BAR;
        PG8_STAGE(PG8_SB(1, 0), cB + kstep, voffB); PG8_STAGE(PG8_SA(1, 0), cA + kstep, voffA); PG8_STAGE(PG8_SB(1, 1), cB + hstep + kstep, voffB);
        PG8_WAIT_V(6); PG8_BAR;
    } else {
        PG8_STAGE(PG8_SB(0, 0), cB, voffB); PG8_STAGE(PG8_SA(0, 0), cA, voffA); PG8_STAGE(PG8_SB(0, 1), cB + hstep, voffB); PG8_STAGE(PG8_SA(0, 1), cA + hstep, voffA);
        if (wr == 1) PG8_BAR;
        PG8_WAIT_V(4); PG8_BAR;
        PG8_STAGE(PG8_SB(1, 0), cB + kstep, voffB); PG8_STAGE(PG8_SA(1, 0), cA + kstep, voffA); PG8_STAGE(PG8_SB(1, 1), cB + hstep + kstep, voffB);
        PG8_WAIT_V(6); PG8_BAR;
    }
    for (;;) {
        const bool has_next = S.next(ui + 1, nxt);
        const char* nA = has_next ? (const char*)g.A + (size_t)nxt.pm * tstep : cA; const char* nB = has_next ? (const char*)g.Bt + (size_t)nxt.pn * tstep : cB;
        for (int t = 0; t < nt; t += 2) {
            const bool last = (t == nt - 2);
            const char* a1 = cA + (size_t)(t + 1) * kstep;
            const char* a2 = last ? nA : cA + (size_t)(t + 2) * kstep; const char* b2 = last ? nB : cB + (size_t)(t + 2) * kstep;
            const char* a3 = a2 + kstep; const char* b3 = b2 + kstep;
            if (last && has_next) S.a_ready(nxt);
            if constexpr (SP2) {
            PG8_LDB(B0, 0, 0); PG8_LDB(B1, 0, 1); PG8_SCHED; PG8_LDA(At, 0, 0); PG8_STAGE(PG8_SA(1, 1), a1 + hstep, voffA);
            PG8_WAIT_V(8); PG8_WAIT_L(0); PG8_BAR; PG8_MMA(0, 0, At, B0); PG8_MMA(0, 1, At, B1); PG8_BAR; PG8_SCHED;
            PG8_LDA(At, 0, 1); PG8_STAGE(PG8_SB(0, 0), b2, voffB); PG8_STAGE(PG8_SB(0, 1), b2 + hstep, voffB); PG8_STAGE(PG8_SA(0, 0), a2, voffA);
            PG8_WAIT_V(8); PG8_WAIT_L(0); PG8_BAR; PG8_MMA(1, 0, At, B0); PG8_MMA(1, 1, At, B1); PG8_BAR; PG8_SCHED;
            PG8_LDB(B0, 1, 0); PG8_LDB(B1, 1, 1); PG8_SCHED; PG8_LDA(At, 1, 0); PG8_STAGE(PG8_SA(0, 1), a2 + hstep, voffA);
            PG8_WAIT_V(8); PG8_WAIT_L(0); PG8_BAR; PG8_MMA(0, 0, At, B0); PG8_MMA(0, 1, At, B1); PG8_BAR; PG8_SCHED;
            PG8_LDA(At, 1, 1); PG8_STAGE(PG8_SB(1, 0), b3, voffB); PG8_STAGE(PG8_SB(1, 1), b3 + hstep, voffB); PG8_STAGE(PG8_SA(1, 0), a3, voffA);
            PG8_WAIT_V(8); PG8_WAIT_L(0); PG8_BAR; PG8_MMA(1, 0, At, B0); PG8_MMA(1, 1, At, B1); PG8_BAR; PG8_SCHED;
            } else {
            PG8_LDB(B0, 0, 0); PG8_SCHED; PG8_LDA(At, 0, 0); PG8_STAGE(PG8_SA(1, 1), a1 + hstep, voffA);
            PG8_WAIT_L(8); PG8_BAR; PG8_WAIT_L(0); PG8_MMA(0, 0, At, B0); PG8_BAR; PG8_SCHED;
            PG8_LDB(B1, 0, 1); PG8_STAGE(PG8_SB(0, 0), b2, voffB);
            PG8_BAR; PG8_WAIT_L(0); PG8_MMA(0, 1, At, B1); PG8_BAR;
            PG8_LDA(At, 0, 1); PG8_STAGE(PG8_SA(0, 0), a2, voffA);
            PG8_BAR; PG8_WAIT_L(0); PG8_MMA(1, 0, At, B0); PG8_BAR; PG8_SCHED;
            PG8_STAGE(PG8_SB(0, 1), b2 + hstep, voffB);
            PG8_WAIT_V(6); PG8_BAR; PG8_MMA(1, 1, At, B1); PG8_BAR;
            PG8_LDB(B0, 1, 0); PG8_SCHED; PG8_LDA(At, 1, 0); PG8_STAGE(PG8_SA(0, 1), a2 + hstep, voffA);
            PG8_WAIT_L(8); PG8_BAR; PG8_WAIT_L(0); PG8_MMA(0, 0, At, B0); PG8_BAR; PG8_SCHED;
            PG8_LDB(B1, 1, 1); PG8_STAGE(PG8_SB(1, 0), b3, voffB);
            PG8_BAR; PG8_WAIT_L(0); PG8_MMA(0, 1, At, B1); PG8_BAR;
            PG8_LDA(At, 1, 1); PG8_STAGE(PG8_SA(1, 0), a3, voffA);
            PG8_BAR; PG8_WAIT_L(0); PG8_MMA(1, 0, At, B0); PG8_BAR; PG8_SCHED;
            PG8_STAGE(PG8_SB(1, 1), b3 + hstep, voffB);
            PG8_WAIT_V(6); PG8_BAR; PG8_MMA(1, 1, At, B1); PG8_BAR;
            }
        }
        if constexpr (ALIGN_EPI) { if (wr == 0) PG8_BAR; }
        if constexpr (!Epi::AFTER_DRAIN) { E(acc, cur, wr, wc, fr, fq); S.done(cur); }
        if (!has_next) break;
#pragma unroll
        for (int a = 0; a < 2; ++a)
#pragma unroll
            for (int b = 0; b < 2; ++b)
#pragma unroll
                for (int m = 0; m < 4; ++m)
#pragma unroll
                    for (int n = 0; n < 2; ++n) acc[a][b][m][n] = (f32x4){0.f, 0.f, 0.f, 0.f};
        cur = nxt; cA = nA; cB = nB; ++ui;
        if constexpr (ALIGN_EPI) { if (wr == 1) PG8_BAR; }
    }
    PG8_WAIT_V(0);
    if constexpr (!ALIGN_EPI) { if (wr == 0) PG8_BAR; }
    PG8_BAR;
    if constexpr (Epi::AFTER_DRAIN) { E.fused(acc, cur, wr, wc, fr, fq, lds, wid, lane); S.done(cur); }
#undef PG8_SA
#undef PG8_SB
#undef PG8_STAGE
#undef PG8_LDA
#undef PG8_LDB
#undef PG8_MMA
#undef PG8_WAIT_V
#undef PG8_WAIT_L
#undef PG8_BAR
#undef PG8_SCHED
}
}

#define LAS __attribute__((address_space(3)))
typedef unsigned short bf16_t;
using pg8::f32x4; using pg8::u32x4; using pg8::Unit; using pg8::cvt_pk_bf16;
typedef float f32x2v __attribute__((ext_vector_type(2)));
typedef unsigned u32x2v __attribute__((ext_vector_type(2)));

constexpr int T_ = 65536, DM = 1024, NIN = 4096, DFF = 2816, ROWS_P = 32768;
constexpr size_t MiB = 1u << 20;
constexpr float EPS = 1e-6f;
constexpr int LDS_BYTES = 147456;
constexpr size_t DO_XN = 0, DO_MIXIN = 0, DO_WIN = 128 * MiB, DO_ROPE = 136 * MiB, DO_WOUT = 137 * MiB;
constexpr size_t WS_U = 0;
constexpr size_t WS_MIX = 0;
constexpr size_t WS_WGU = 128 * MiB, WS_WDN = 139 * MiB, WS_SS1 = 145 * MiB, WS_SS2 = 149 * MiB, WS_HFF = 160 * MiB;
constexpr int UP = 2560;
constexpr int UC_QH = 0, UC_ZF = 512, UC_ZB = 1024, UC_IH = 1536, UC_GH = 2048;
constexpr size_t WS_QB = 320 * MiB, WS_KB = 384 * MiB, WS_VB = 448 * MiB;
__device__ __forceinline__ int perm_row(int row) {
    if (row < ROWS_P) { const int pos = row & 16383; return (row & ~16383) + ((pos & 15) << 10) + (pos >> 4); }
    const int pos = row & 4095; return (row & ~4095) + ((pos & 15) << 8) + (pos >> 4);
}

__device__ __forceinline__ float bf2f(unsigned short h) { return __uint_as_float((unsigned)h << 16); }
__device__ __forceinline__ unsigned short f2bf(float f) { unsigned u = __float_as_uint(f); return (unsigned short)((u + 0x7fffu + ((u >> 16) & 1u)) >> 16); }
__device__ __forceinline__ unsigned pk2(float lo, float hi) { return cvt_pk_bf16(lo, hi); }
__device__ __forceinline__ float silu_f(float x) { return x * __builtin_amdgcn_rcpf(1.f + __expf(-x)); }
__device__ __forceinline__ float sigmoid_f(float x) { return __builtin_amdgcn_rcpf(1.f + __expf(-x)); }
__device__ __forceinline__ int row_pos(int row) { return row < ROWS_P ? (row & 16383) : (row & 4095); }
__device__ __forceinline__ int row_S(int row) { return row < ROWS_P ? 16384 : 4096; }
__device__ __forceinline__ float wave_sum(float v) {
#pragma unroll
    for (int o = 1; o < 64; o <<= 1) v += __shfl_xor(v, o);
    return v;
}
__device__ __forceinline__ float wave_max(float v) {
#pragma unroll
    for (int o = 1; o < 64; o <<= 1) v = fmaxf(v, __shfl_xor(v, o));
    return v;
}
#define LDS_WAIT() asm volatile("s_waitcnt lgkmcnt(0)" ::: "memory")
__device__ __forceinline__ int otid() { int t; asm volatile("v_mov_b32 %0, %1" : "=v"(t) : "v"((int)threadIdx.x)); return t; }


__device__ unsigned g_bar[3456];
struct XcdBarrier { unsigned* bar; unsigned x; volatile LAS unsigned* st; };
#define XB_TMO      128
#define XB_XCNT(j)  (256  + 64 * (j))
#define XB_XSUB(j)  (1280 + 64 * (j))
#define XB_XGEN(j)  (2304 + 64 * (j))
#define XB_TOP      3328
#define XB_TOPGEN   3392
#define XCD_BAR_WORDS 3456
#define XB_SPIN_CAP (1u << 18)

__device__ __forceinline__ unsigned xb_ld(unsigned* p)              { return __hip_atomic_load(p, __ATOMIC_RELAXED, __HIP_MEMORY_SCOPE_AGENT); }
__device__ __forceinline__ unsigned xb_add(unsigned* p, unsigned v) { return __hip_atomic_fetch_add(p, v, __ATOMIC_RELAXED, __HIP_MEMORY_SCOPE_AGENT); }
__device__ __forceinline__ unsigned xb_xcc_id() { return (unsigned)__builtin_amdgcn_s_getreg((3 << 11) | 20) & 0xFu; }
#define XB_SPIN(cond, bar) do { unsigned _sp = 0; while (cond) { __builtin_amdgcn_s_sleep(1); \
    if ((++_sp & 255u) == 0u) { if (xb_ld(&(bar)[XB_TMO])) break; if (_sp > XB_SPIN_CAP) { atomicAdd(&(bar)[XB_TMO], 1u); break; } } } } while (0)
__device__ __forceinline__ XcdBarrier xcd_barrier_post(unsigned* bar, volatile LAS unsigned* st) {
    XcdBarrier b; b.bar = bar; b.x = xb_xcc_id(); b.st = st;
    if (threadIdx.x == 0) (void)xb_add(&bar[XB_XCNT(b.x)], 1u);
    return b;
}
__device__ __forceinline__ void xcd_barrier_complete(unsigned* bar, unsigned x, unsigned& nloc, unsigned& nx) {
    const unsigned G = gridDim.x * gridDim.y * gridDim.z;
    unsigned sum, cnt, mine, sp = 0u;
    for (;;) {
        sum = 0u; cnt = 0u; mine = 0u;
#pragma unroll
        for (unsigned j = 0; j < 16; ++j) { const unsigned c = xb_ld(&bar[XB_XCNT(j)]); sum += c; cnt += (c > 0u) ? 1u : 0u; mine = (j == x) ? c : mine; }
        if (sum == G) break;
        __builtin_amdgcn_s_sleep(1);
        if ((++sp & 255u) == 0u) { if (xb_ld(&bar[XB_TMO])) break; if (sp > XB_SPIN_CAP) { atomicAdd(&bar[XB_TMO], 1u); break; } }
    }
    nloc = mine > 0u ? mine : 1u; nx = cnt > 0u ? cnt : 1u;
}

__device__ __forceinline__ void xcd_barrier(const XcdBarrier& b) {
    asm volatile("s_waitcnt vmcnt(0)" ::: "memory");
    __syncthreads();
    if (threadIdx.x == 0) {
        unsigned* bar = b.bar;
        __builtin_amdgcn_s_waitcnt(0);
        unsigned nloc = b.st[0], nx = b.st[1];
        if (nloc == 0u) { xcd_barrier_complete(bar, b.x, nloc, nx); b.st[0] = nloc; b.st[1] = nx; }
        const unsigned old = xb_add(&bar[XB_XSUB(b.x)], 1u);
        const unsigned gen = old / nloc;
        if (old + 1u == (gen + 1u) * nloc) {
            __builtin_amdgcn_fence(__ATOMIC_RELEASE, "agent");
            asm volatile("s_waitcnt vmcnt(0)" ::: "memory");
            const unsigned og = xb_add(&bar[XB_TOP], 1u);
            const unsigned tg = og / nx;
            if (og + 1u == (tg + 1u) * nx) xb_add(&bar[XB_TOPGEN], 1u);
            else XB_SPIN(xb_ld(&bar[XB_TOPGEN]) == tg, bar);
            __builtin_amdgcn_fence(__ATOMIC_ACQUIRE, "agent");
            xb_add(&bar[XB_XGEN(b.x)], 1u);
            asm volatile("s_waitcnt vmcnt(0)" ::: "memory");
        } else {
            XB_SPIN(xb_ld(&bar[XB_XGEN(b.x)]) == gen, bar);
            __builtin_amdgcn_fence(__ATOMIC_ACQUIRE, "agent");
            asm volatile("s_waitcnt vmcnt(0)" ::: "memory");
        }
    }
    __syncthreads();
}

struct EpiU {
    static constexpr bool PERM = true, AFTER_DRAIN = false;
    bf16_t* UH; bf16_t* XB; const float* rope;
    __device__ __forceinline__ void operator()(const f32x4 (&acc)[2][2][4][2], const Unit& u, int wr, int wc, int fr, int fq) const {
        const int row0 = u.pm * 256 + wr * 64 + fr;
        const bool attn = u.pn < 6;
        const bool rope_tile = (u.pn < 4) && ((wc & 1) == 0);
        const float sc = (u.pn < 2) ? 0.125f : 1.0f;
        const float sgn = (fq == 0) ? -1.f : 1.f;
#pragma unroll
        for (int ai = 0; ai < 2; ++ai)
#pragma unroll
            for (int m = 0; m < 4; ++m) {
                const int row = row0 + ai * 128 + m * 16;
                f32x4 r0 = {1.f, 0.f, 1.f, 0.f}, r1 = r0, r2 = r0, r3 = r0;
                if (rope_tile) { const f32x4* rp = (const f32x4*)(rope + (size_t)row_pos(row) * 16); r0 = rp[0]; r1 = rp[1]; r2 = rp[2]; r3 = rp[3]; }
                const size_t prow = attn ? (size_t)perm_row(row) : 0;
#pragma unroll
                for (int bj = 0; bj < 2; ++bj) {
                    f32x4 v0 = acc[ai][bj][m][0], v1 = acc[ai][bj][m][1];
                    if (rope_tile) {
                        f32x4 p0, p1;
#pragma unroll
                        for (int j = 0; j < 4; ++j) { p0[j] = __shfl_xor(v0[j], 16); p1[j] = __shfl_xor(v1[j], 16); }
                        if (fq < 2) {
                            v0[0] = v0[0] * r0[0] + sgn * p0[0] * r0[1]; v0[1] = v0[1] * r0[2] + sgn * p0[1] * r0[3];
                            v0[2] = v0[2] * r1[0] + sgn * p0[2] * r1[1]; v0[3] = v0[3] * r1[2] + sgn * p0[3] * r1[3];
                            v1[0] = v1[0] * r2[0] + sgn * p1[0] * r2[1]; v1[1] = v1[1] * r2[2] + sgn * p1[1] * r2[3];
                            v1[2] = v1[2] * r3[0] + sgn * p1[2] * r3[1]; v1[3] = v1[3] * r3[2] + sgn * p1[3] * r3[3];
                        }
                    }
                    v0 = v0 * sc; v1 = v1 * sc;
                    u32x4 w; w.x = cvt_pk_bf16(v0[0], v0[1]); w.y = cvt_pk_bf16(v0[2], v0[3]); w.z = cvt_pk_bf16(v1[0], v1[1]); w.w = cvt_pk_bf16(v1[2], v1[3]);
                    bf16_t* dst;
                    if (attn) {
                        const int cs = (u.pn & 1) * 256 + bj * 128 + wc * 32 + 8 * fq;
                        dst = XB + (size_t)(u.pn >> 1) * ((size_t)T_ * 512) + ((size_t)(cs >> 6) * T_ + prow) * 64 + (cs & 63);
                    } else dst = UH + (size_t)row * UP + (u.pn * 256 - 1536) + bj * 128 + wc * 32 + 8 * fq;
                    *(u32x4*)dst = w;
                }
            }
    }
};
struct EpiRowSS {
    static constexpr bool PERM = true, AFTER_DRAIN = false;
    bf16_t* O; float* SS;
    __device__ __forceinline__ void operator()(const f32x4 (&acc)[2][2][4][2], const Unit& u, int wr, int wc, int fr, int fq) const {
        const int row0 = u.pm * 256 + wr * 64 + fr, col0 = u.pn * 256 + wc * 32 + 8 * fq;
#pragma unroll
        for (int ai = 0; ai < 2; ++ai)
#pragma unroll
            for (int m = 0; m < 4; ++m) {
                const int row = row0 + ai * 128 + m * 16;
                bf16_t* rowp = O + (size_t)row * DM + col0;
                float s = 0.f;
#pragma unroll
                for (int bj = 0; bj < 2; ++bj) {
                    const f32x4 v0 = acc[ai][bj][m][0], v1 = acc[ai][bj][m][1];
                    s += (v0[0] * v0[0] + v0[1] * v0[1]) + (v0[2] * v0[2] + v0[3] * v0[3]) + (v1[0] * v1[0] + v1[1] * v1[1]) + (v1[2] * v1[2] + v1[3] * v1[3]);
                    u32x4 w; w.x = cvt_pk_bf16(v0[0], v0[1]); w.y = cvt_pk_bf16(v0[2], v0[3]); w.z = cvt_pk_bf16(v1[0], v1[1]); w.w = cvt_pk_bf16(v1[2], v1[3]);
                    *(u32x4*)(rowp + bj * 128) = w;
                }
                s += __shfl_xor(s, 16); s += __shfl_xor(s, 32);
                if (fq == 0) SS[(size_t)row * 16 + u.pn * 4 + wc] = s;
            }
    }
};
struct EpiSwiGLU {
    static constexpr bool PERM = true, AFTER_DRAIN = false;
    bf16_t* H;
    __device__ __forceinline__ void operator()(const f32x4 (&acc)[2][2][4][2], const Unit& u, int wr, int wc, int fr, int fq) const {
        const int row0 = u.pm * 256 + wr * 64 + fr, col0 = u.pn * 128 + wc * 32 + 8 * fq;
#pragma unroll
        for (int ai = 0; ai < 2; ++ai)
#pragma unroll
            for (int m = 0; m < 4; ++m) {
                const int row = row0 + ai * 128 + m * 16;
                const f32x4 g0 = acc[ai][0][m][0], g1 = acc[ai][0][m][1], u0 = acc[ai][1][m][0], u1 = acc[ai][1][m][1];
                f32x4 h0, h1;
#pragma unroll
                for (int j = 0; j < 4; ++j) { h0[j] = silu_f(g0[j]) * u0[j]; h1[j] = silu_f(g1[j]) * u1[j]; }
                u32x4 w; w.x = cvt_pk_bf16(h0[0], h0[1]); w.y = cvt_pk_bf16(h0[2], h0[3]); w.z = cvt_pk_bf16(h1[0], h1[1]); w.w = cvt_pk_bf16(h1[2], h1[3]);
                *(u32x4*)(H + (size_t)row * DFF + col0) = w;
            }
    }
};

template <class RowMap>
__device__ __forceinline__ void transpose_item(const float* W, int N, int k0, int n0, const float* kscale, bf16_t* WT, int K, RowMap rowmap, LAS float* scr, int lane) {
    float wv[32];
#pragma unroll
    for (int i = 0; i < 32; ++i) wv[i] = W[(size_t)(k0 + 2 * i + (lane >> 5)) * N + n0 + (lane & 31)];
#pragma unroll
    for (int i = 0; i < 32; ++i) { const int kk = 2 * i + (lane >> 5); float w = wv[i]; if (kscale) w *= kscale[k0 + kk]; scr[kk * 33 + (lane & 31)] = w; }
    LDS_WAIT();
    const int c = lane & 7;
#pragma unroll
    for (int j = 0; j < 4; ++j) { const int n = (lane >> 3) + 8 * j; const LAS float* s = scr + (8 * c) * 33 + n;
        u32x4 o; o.x = pk2(s[0 * 33], s[1 * 33]); o.y = pk2(s[2 * 33], s[3 * 33]); o.z = pk2(s[4 * 33], s[5 * 33]); o.w = pk2(s[6 * 33], s[7 * 33]);
        *(u32x4*)(WT + (size_t)rowmap(n0 + n) * K + k0 + 8 * c) = o; }
    LDS_WAIT();
}
struct RowId { __device__ __forceinline__ int operator()(int n) const { return n; } };
struct RowGU { int half; __device__ __forceinline__ int operator()(int n) const { return (n >> 7) * 256 + half * 128 + (n & 127); } };

struct Params {
    const float* xp; const float* xs; const float* w_in; const float* w_out; const float* lb_fwd; const float* lb_bwd; const float* g_hgrn;
    const float* g_pre_mix; const float* g_post_mix; const float* g_pre_ffn; const float* g_post_ffn; const float* w_gate; const float* w_up; const float* w_down;
    float* out; unsigned char* ws;
};
__device__ __forceinline__ const float* xrow_ptr(const Params& p, int row) { return row < ROWS_P ? p.xp + (size_t)row * DM : p.xs + (size_t)(row - ROWS_P) * DM; }

__device__ __forceinline__ void p0_prologue(const Params& p, LAS unsigned char* lds, int gw, int ngw, int wave, int lane) {
    unsigned char* dob = (unsigned char*)p.out;
    bf16_t* WIN = (bf16_t*)(dob + DO_WIN); bf16_t* WOUT = (bf16_t*)(dob + DO_WOUT); float* rope = (float*)(dob + DO_ROPE); bf16_t* XN = (bf16_t*)(dob + DO_XN);
    LAS float* scr = (LAS float*)(lds + wave * 16384);
    constexpr int I_IN = 16 * 128, I_OUT = 16 * 32;
    for (int it = gw; it < I_IN + I_OUT; it += ngw) {
        if (it < I_IN) transpose_item(p.w_in, NIN, 64 * (it / 128), 32 * (it % 128), p.g_pre_mix, WIN, DM, RowId{}, scr, lane);
        else { const int r = it - I_IN; transpose_item(p.w_out, DM, 64 * (r / 32), 32 * (r % 32), nullptr, WOUT, DM, RowId{}, scr, lane); }
    }
    {
        const int gt = gw * 64 + lane, ngt = ngw * 64;
        for (int e = gt; e < 16384 * 8; e += ngt) {
            const int pos = e >> 3, i = e & 7;
            const double rv = i == 0 ? 0.15915494309189535 : i == 1 ? 0.03086376340470123 : i == 2 ? 0.005985185712713705 : i == 3 ? 0.001160663641240061
                            : i == 4 ? 0.00022507907903927653 : i == 5 ? 4.364795279280289e-05 : i == 6 ? 8.464330808241401e-06 : 1.6414262627950345e-06;
            double a = (double)pos * rv; a -= floor(a);
            const float af = (float)a;
            rope[2 * e] = __builtin_amdgcn_cosf(af); rope[2 * e + 1] = __builtin_amdgcn_sinf(af);
        }
    }
    for (int m0 = gw * 4; m0 < T_; m0 += ngw * 4) {
        f32x4 v[4][4]; float s[4];
#pragma unroll
        for (int k = 0; k < 4; ++k) { const f32x4* xr = (const f32x4*)xrow_ptr(p, m0 + k) + lane;
#pragma unroll
            for (int j = 0; j < 4; ++j) v[k][j] = xr[64 * j]; }
#pragma unroll
        for (int k = 0; k < 4; ++k) { s[k] = 0.f;
#pragma unroll
            for (int j = 0; j < 4; ++j) s[k] += (v[k][j][0] * v[k][j][0] + v[k][j][1] * v[k][j][1]) + (v[k][j][2] * v[k][j][2] + v[k][j][3] * v[k][j][3]); }
#pragma unroll
        for (int k = 0; k < 4; ++k) {
            const float rstd = rsqrtf(wave_sum(s[k]) * (1.f / DM) + EPS);
            u32x2v* o8 = (u32x2v*)(XN + (size_t)(m0 + k) * DM) + lane;
#pragma unroll
            for (int j = 0; j < 4; ++j) { u32x2v w; w.x = cvt_pk_bf16(v[k][j][0] * rstd, v[k][j][1] * rstd); w.y = cvt_pk_bf16(v[k][j][2] * rstd, v[k][j][3] * rstd); o8[64 * j] = w; }
        }
    }
}

namespace at {
typedef short bf16x8 __attribute__((ext_vector_type(8)));
typedef short s16x4 __attribute__((ext_vector_type(4)));
constexpr int OS = 68;
constexpr int L_OUT = 0, L_L = 272 * OS * 4, L_VS = L_L + 1024, VS_STRIDE = 144, VS_WAVE = 32 * VS_STRIDE, L_END = L_VS + 8 * VS_WAVE;
static_assert(L_END <= LDS_BYTES, "attention LDS map");

__device__ __forceinline__ void wave_tile(const bf16_t* XBp, LAS unsigned char* lds, int w, int lane, int base, int S, int P0, int h, int idx) {
    const int n = lane & 15, quad = lane >> 4;
    const int br = idx >> 4, sub = idx & 15;
    const int dsh = 2 * br, dil = 1 << dsh;
    const int r = br == 0 ? 0 : (br == 1 ? (sub & 3) : sub);
    const int mt = br == 0 ? sub : (br == 1 ? (sub >> 2) : 0);
    const int Lsub = S >> dsh, m0 = (P0 >> dsh) + 16 * mt;
    const bf16_t* Qb = XBp + ((size_t)h * T_ + base) * 64;
    const bf16_t* Kb = Qb + (size_t)T_ * 512, * Vb = Kb + (size_t)T_ * 512;
    const int sh16 = (S == 16384) ? 10 : 8;
#define AT_ROW(pos) ((((pos) & 15) << sh16) + ((pos) >> 4))
    bf16x8 qf[2];
    { const int pq = (m0 + n) * dil + r; const bf16_t* qp = Qb + (size_t)AT_ROW(pq) * 64 + 8 * quad; qf[0] = *(const bf16x8*)qp; qf[1] = *(const bf16x8*)(qp + 32); }
    bf16x8 kf[9][2];
#pragma unroll
    for (int kt = 0; kt < 9; ++kt) {
        int mk = m0 - 64 + 16 * kt + n; mk = mk < 0 ? 0 : (mk >= Lsub ? Lsub - 1 : mk);
        const int pk = mk * dil + r;
        const bf16_t* kp = Kb + (size_t)AT_ROW(pk) * 64 + 8 * quad; kf[kt][0] = *(const bf16x8*)kp; kf[kt][1] = *(const bf16x8*)(kp + 32);
    }
    u32x4 vr[5][4];
#pragma unroll
    for (int t = 0; t < 5; ++t)
#pragma unroll
        for (int e = 0; e < 4; ++e) {
            const int id = lane + 64 * e, rho = id >> 3, ch = id & 7;
            int mk = m0 - 64 + 32 * t + rho; mk = mk < 0 ? 0 : (mk >= Lsub ? Lsub - 1 : mk);
            const int pv = mk * dil + r;
            vr[t][e] = *(const u32x4*)(Vb + (size_t)AT_ROW(pv) * 64 + 8 * ch);
        }
    unsigned pk[10][2];
    float lsum = 0.f;
#pragma unroll
    for (int kt = 0; kt < 9; ++kt) {
        f32x4 sc = {0.f, 0.f, 0.f, 0.f};
        sc = __builtin_amdgcn_mfma_f32_16x16x32_bf16(kf[kt][0], qf[0], sc, 0, 0, 0);
        sc = __builtin_amdgcn_mfma_f32_16x16x32_bf16(kf[kt][1], qf[1], sc, 0, 0, 0);
        float pv[4];
#pragma unroll
        for (int j = 0; j < 4; ++j) {
            const int ko = 16 * kt + 4 * quad + j, mk = m0 - 64 + ko;
            const bool valid = (ko >= n) && (ko <= n + 128) && (mk >= 0) && (mk < Lsub);
            const float e = __expf(fminf(sc[j], 80.f));
            pv[j] = valid ? e : 0.f; lsum += pv[j];
        }
        pk[kt][0] = cvt_pk_bf16(pv[0], pv[1]); pk[kt][1] = cvt_pk_bf16(pv[2], pv[3]);
    }
    pk[9][0] = 0u; pk[9][1] = 0u;
    lsum += __shfl_xor(lsum, 16); lsum += __shfl_xor(lsum, 32);
    f32x4 ot[4];
#pragma unroll
    for (int dt = 0; dt < 4; ++dt) ot[dt] = (f32x4){0.f, 0.f, 0.f, 0.f};
    LAS unsigned char* vs = lds + L_VS + w * VS_WAVE;
#pragma unroll
    for (int t = 0; t < 5; ++t) {
#pragma unroll
        for (int e = 0; e < 4; ++e) { const int id = lane + 64 * e, rho = id >> 3, ch = id & 7; *(LAS u32x4*)(vs + rho * VS_STRIDE + ch * 16) = vr[t][e]; }
        bf16x8 pf; { u32x4 pw = {pk[2 * t][0], pk[2 * t][1], pk[2 * t + 1][0], pk[2 * t + 1][1]}; pf = __builtin_bit_cast(bf16x8, pw); }
#pragma unroll
        for (int dt = 0; dt < 4; ++dt) {
            const int q = (lane & 15) >> 2, pp = lane & 3;
            const s16x4 lo = __builtin_amdgcn_ds_read_tr16_b64_v4i16((LAS s16x4*)(vs + (4 * quad + q) * VS_STRIDE + (16 * dt + 4 * pp) * 2));
            const s16x4 hi = __builtin_amdgcn_ds_read_tr16_b64_v4i16((LAS s16x4*)(vs + (16 + 4 * quad + q) * VS_STRIDE + (16 * dt + 4 * pp) * 2));
            const bf16x8 vf = {lo[0], lo[1], lo[2], lo[3], hi[0], hi[1], hi[2], hi[3]};
            ot[dt] = __builtin_amdgcn_mfma_f32_16x16x32_bf16(vf, pf, ot[dt], 0, 0, 0);
        }
    }
    const int posl = ((m0 + n) * dil + r) - P0;
    LAS float* op = (LAS float*)(lds + L_OUT) + (posl + (posl >> 4)) * OS + 4 * quad;
    LAS float* lp = (LAS float*)(lds + L_L) + posl;
    if (br == 0) {
#pragma unroll
        for (int dt = 0; dt < 4; ++dt) *(LAS f32x4*)(op + 16 * dt) = ot[dt];
        if (quad == 0) *lp = lsum;
    } else {
        f32x4 old[4];
#pragma unroll
        for (int dt = 0; dt < 4; ++dt) old[dt] = *(const LAS f32x4*)(op + 16 * dt);
        const float lo = *lp;
#pragma unroll
        for (int dt = 0; dt < 4; ++dt) *(LAS f32x4*)(op + 16 * dt) = old[dt] + ot[dt];
        if (quad == 0) *lp = lo + lsum;
    }
}
__device__ __forceinline__ void attn_phase(const bf16_t* XBp, bf16_t* MIXIN, LAS unsigned char* lds, int blk, int G) {
    const int tid = otid(), lane = tid & 63, w = __builtin_amdgcn_readfirstlane(tid >> 6);
    __syncthreads();
    for (int u = blk; u < 2048; u += G) {
        int grp = u >> 3, h = u & 7;
        if (G == 256) { const int x = u & 7, j = (u >> 3) & 31, e8 = u >> 8; h = j & 7; grp = 32 * x + 4 * e8 + (j >> 3); }
        const int row0 = grp * 256;
        const int base = row0 < ROWS_P ? (row0 & ~16383) : (ROWS_P + ((row0 - ROWS_P) & ~4095)), S = row0 < ROWS_P ? 16384 : 4096, P0 = row0 - base;
        for (int br = 0; br < 3; ++br) {
            wave_tile(XBp, lds, w, lane, base, S, P0, h, 16 * br + w);
            wave_tile(XBp, lds, w, lane, base, S, P0, h, 16 * br + w + 8);
            __syncthreads();
        }
        {
            const int pos = tid >> 1, half = tid & 1;
            const LAS float* op = (const LAS float*)(lds + L_OUT) + (pos + (pos >> 4)) * OS + 32 * half;
            const float inv = 1.f / ((const LAS float*)(lds + L_L))[pos];
            unsigned wv[16];
#pragma unroll
            for (int d = 0; d < 16; ++d) wv[d] = cvt_pk_bf16(op[2 * d] * inv, op[2 * d + 1] * inv);
            u32x4* gp = (u32x4*)(MIXIN + (size_t)(row0 + pos) * DM + h * 64 + 32 * half);
#pragma unroll
            for (int c = 0; c < 4; ++c) gp[c] = (u32x4){wv[4 * c], wv[4 * c + 1], wv[4 * c + 2], wv[4 * c + 3]};
        }
        __syncthreads();
    }
}
}

namespace hg {
typedef short bf16x8 __attribute__((ext_vector_type(8)));
constexpr int SEG = 1024, NCH = 16, NITEM = 512;
constexpr int RS = 272, TS = 144;
constexpr int L_QT = 0, L_QR = 17408, L_KR = 34816, L_K0 = 52224, L_Q4 = 56576, L_KT = 60928, L_VT = 79360, L_ST = 97792, L_AB = 132608, L_TOT = 141824, L_BV = 143872, L_END = 144384;
static_assert(L_END <= LDS_BYTES, "hgrn LDS map");
constexpr size_t DO_STATE = 140 * MiB, DO_DEC = 172 * MiB, DO_OB = 176 * MiB, DO_INIT = 240 * MiB;

__device__ __forceinline__ int phys_row(int g, int dir, int lt) { return dir ? (g * SEG + SEG - 1 - lt) : (g * SEG + lt); }
__device__ __forceinline__ unsigned short bf1(float x) { __bf16 b = (__bf16)x; return __builtin_bit_cast(unsigned short, b); }
__device__ __forceinline__ bf16x8 ldfrag(LAS unsigned char* lds, int off, int stride, int row0, int kel, int lane) {
    return *(const LAS bf16x8*)(lds + off + (row0 + (lane & 15)) * stride + (kel + 8 * (lane >> 4)) * 2);
}
template <bool FULL>
__device__ __forceinline__ void load_raw(const bf16_t* U, int g, int dir, int ch, int i, int zcol, int qcol, int vcol, unsigned short (&rz)[16], unsigned short (&rq)[16], unsigned short (&rv)[16]) {
#pragma unroll
    for (int r = 0; r < 16; ++r) {
        const bf16_t* pr = U + (size_t)phys_row(g, dir, 64 * ch + 16 * i + r) * UP;
        rz[r] = pr[zcol]; if (FULL) rq[r] = pr[qcol]; rv[r] = pr[vcol];
    }
}
template <bool FULL>
__device__ __forceinline__ void prep(LAS unsigned char* lds, int i, int c, float lb, const unsigned short (&rz)[16], const unsigned short (&rq)[16], const unsigned short (&rv)[16], float& bdec) {
    float f[16], e1[16], qs[16];
    float run = 1.f;
#pragma unroll
    for (int r = 0; r < 16; ++r) {
        const float fr = lb + (1.f - lb) * sigmoid_f(bf2f(rz[r]));
        f[r] = fr; run *= fr; e1[r] = run;
        if (FULL) qs[r] = silu_f(bf2f(rq[r])); else qs[r] = 0.f;
    }
    ((LAS float*)(lds + L_TOT))[i * 128 + c] = run;
    {
        u32x4 a, b;
        a.x = rv[0] | ((unsigned)rv[1] << 16); a.y = rv[2] | ((unsigned)rv[3] << 16); a.z = rv[4] | ((unsigned)rv[5] << 16); a.w = rv[6] | ((unsigned)rv[7] << 16);
        b.x = rv[8] | ((unsigned)rv[9] << 16); b.y = rv[10] | ((unsigned)rv[11] << 16); b.z = rv[12] | ((unsigned)rv[13] << 16); b.w = rv[14] | ((unsigned)rv[15] << 16);
        LAS u32x4* vp = (LAS u32x4*)(lds + L_VT + c * TS + 32 * i); vp[0] = a; vp[1] = b;
    }
    __syncthreads();
    const LAS float* tp = (const LAS float*)(lds + L_TOT) + c;
    const float p0 = tp[0], p1 = tp[128], p2 = tp[256], p3 = tp[384];
    const float cQT = i == 0 ? 1.f : i == 1 ? p0 : i == 2 ? p0 * p1 : p0 * p1 * p2;
    const float cKT = i == 0 ? p1 * p2 * p3 : i == 1 ? p2 * p3 : i == 2 ? p3 : 1.f;
    const float cQR = i == 0 ? 1.f : i == 1 ? __builtin_amdgcn_rcpf(p1) : i == 2 ? 1.f : p2;
    const float cKR = i == 0 ? p1 : i == 1 ? 1.f : i == 2 ? __builtin_amdgcn_rcpf(p2) : 1.f;
    const float cK0 = __builtin_amdgcn_rcpf(p0), cQ4 = __builtin_amdgcn_rcpf(p3);
    bdec = (p0 * p1) * (p2 * p3);
    if (i == 0) ((LAS float*)(lds + L_BV))[c] = bdec;
    unsigned short kt[16];
    float e2 = 1.f;
#pragma unroll
    for (int r = 15; r >= 0; --r) {
        const float kb = (1.f - f[r]) * e2;
        kt[r] = bf1(kb * cKT);
        if (FULL) {
            *(LAS unsigned short*)(lds + L_KR + (16 * i + r) * RS + c * 2) = bf1(kb * cKR);
            if (i == 0) *(LAS unsigned short*)(lds + L_K0 + r * RS + c * 2) = bf1(kb * cK0);
        }
        e2 *= f[r];
    }
    {
        u32x4 a, b;
        a.x = kt[0] | ((unsigned)kt[1] << 16); a.y = kt[2] | ((unsigned)kt[3] << 16); a.z = kt[4] | ((unsigned)kt[5] << 16); a.w = kt[6] | ((unsigned)kt[7] << 16);
        b.x = kt[8] | ((unsigned)kt[9] << 16); b.y = kt[10] | ((unsigned)kt[11] << 16); b.z = kt[12] | ((unsigned)kt[13] << 16); b.w = kt[14] | ((unsigned)kt[15] << 16);
        LAS u32x4* kp = (LAS u32x4*)(lds + L_KT + c * TS + 32 * i); kp[0] = a; kp[1] = b;
    }
    if (FULL) {
#pragma unroll
        for (int r = 0; r < 16; ++r) {
            const float qe = qs[r] * e1[r];
            *(LAS unsigned short*)(lds + L_QT + (16 * i + r) * RS + c * 2) = bf1(qe * cQT);
            *(LAS unsigned short*)(lds + L_QR + (16 * i + r) * RS + c * 2) = bf1(qe * cQR);
            if (i == 3) *(LAS unsigned short*)(lds + L_Q4 + r * RS + c * 2) = bf1(qe * cQ4);
        }
    }
}
__device__ __forceinline__ void state_update(LAS unsigned char* lds, f32x4 (&S)[8], int w, int gq, int lane) {
    bf16x8 ktf[2];
#pragma unroll
    for (int k2 = 0; k2 < 2; ++k2) ktf[k2] = ldfrag(lds, L_KT, TS, 16 * w, 32 * k2, lane);
    const f32x4 dk = *(const LAS f32x4*)(lds + L_BV + (16 * w + 4 * gq) * 4);
#pragma unroll
    for (int n = 0; n < 8; ++n) {
        S[n] = S[n] * dk;
#pragma unroll
        for (int k2 = 0; k2 < 2; ++k2) S[n] = __builtin_amdgcn_mfma_f32_16x16x32_bf16(ktf[k2], ldfrag(lds, L_VT, TS, 16 * n, 32 * k2, lane), S[n], 0, 0, 0);
    }
}
__device__ __forceinline__ int item_of(int lin, int G) {
    if (G != 256) return lin;
    const int x = lin & 7, j = (lin >> 3) & 31, e = lin >> 8, g = 8 * x + 2 * (j >> 3) + e, hd = j & 7;
    return g * 8 + hd;
}
__device__ __forceinline__ float lb_of(const Params& p, int dir, int col) { const float* lbr = dir ? p.lb_bwd : p.lb_fwd; return 1.f / (1.f + __expf(lbr[512 + col] - lbr[col])); }

__device__ __forceinline__ void pass1(const Params& p, const bf16_t* U, LAS unsigned char* lds, int item) {
    const int tid = otid(), lane = tid & 63, w = __builtin_amdgcn_readfirstlane(tid >> 6), i = w >> 1, c = tid & 127, gq = lane >> 4;
    const int dir = item & 1, hh = (item >> 1) & 3, g = item >> 3;
    float* STATE = (float*)((unsigned char*)p.out + DO_STATE); float* DEC = (float*)((unsigned char*)p.out + DO_DEC);
    const float lb = lb_of(p, dir, hh * 128 + c);
    const int zcol = (dir ? UC_ZB : UC_ZF) + hh * 128 + c, qcol = UC_QH + hh * 128 + c, vcol = UC_IH + hh * 128 + c;
    f32x4 S[8];
#pragma unroll
    for (int n = 0; n < 8; ++n) S[n] = (f32x4){0.f, 0.f, 0.f, 0.f};
    float dtot = 1.f;
    unsigned short rz[16], rq[16], rv[16];
    load_raw<false>(U, g, dir, 0, i, zcol, qcol, vcol, rz, rq, rv);
    for (int ch = 0; ch < NCH; ++ch) {
        float bdec;
        prep<false>(lds, i, c, lb, rz, rq, rv, bdec);
        dtot *= bdec;
        if (ch + 1 < NCH) load_raw<false>(U, g, dir, ch + 1, i, zcol, qcol, vcol, rz, rq, rv);
        __syncthreads();
        state_update(lds, S, w, gq, lane);
        __syncthreads();
    }
    float* sp = STATE + (size_t)item * 16384 + (16 * w + 4 * gq) * 128 + (lane & 15);
#pragma unroll
    for (int n = 0; n < 8; ++n)
#pragma unroll
        for (int jj = 0; jj < 4; ++jj) sp[jj * 128 + 16 * n] = S[n][jj];
    if (i == 0) DEC[item * 128 + c] = dtot;
}
__device__ __forceinline__ void scan(const Params& p, int gt, int ngt) {
    const float* STATE = (const float*)((unsigned char*)p.out + DO_STATE); const float* DEC = (const float*)((unsigned char*)p.out + DO_DEC);
    bf16_t* INIT = (bf16_t*)((unsigned char*)p.out + DO_INIT);
    for (int e = gt; e < 80 * 4096; e += ngt) {
        const int chain = e >> 12, q4 = e & 4095, k = q4 >> 5;
        const int dir = chain & 1, hh = (chain >> 1) & 3, sb = chain >> 3;
        const int nseg = sb < 2 ? 16 : 4, g0 = sb < 2 ? sb * 16 : 32 + (sb - 2) * 4;
        f32x4 s = {0.f, 0.f, 0.f, 0.f};
        for (int j = 0; j < nseg; ++j) {
            const int g = dir ? (g0 + nseg - 1 - j) : (g0 + j), item = (g * 4 + hh) * 2 + dir;
            const f32x4 en = *((const f32x4*)(STATE + (size_t)item * 16384) + q4);
            u32x2v wv; wv.x = cvt_pk_bf16(s[0], s[1]); wv.y = cvt_pk_bf16(s[2], s[3]);
            *((u32x2v*)(INIT + (size_t)item * 16384) + q4) = wv;
            s = s * DEC[item * 128 + k] + en;
        }
    }
}
__device__ __forceinline__ void pass2(const Params& p, const bf16_t* U, bf16_t* MIXIN, LAS unsigned char* lds, int item) {
    const int tid = otid(), lane = tid & 63, w = __builtin_amdgcn_readfirstlane(tid >> 6), i = w >> 1, c = tid & 127, gq = lane >> 4;
    const int dir = item & 1, hh = (item >> 1) & 3, g = item >> 3;
    const bf16_t* INIT = (const bf16_t*)((unsigned char*)p.out + DO_INIT);
    bf16_t* OUT = dir ? (bf16_t*)((unsigned char*)p.out + DO_OB) + hh * 128 : MIXIN + 512 + hh * 128;
    const int opitch = dir ? 512 : DM;
    const float lb = lb_of(p, dir, hh * 128 + c);
    const int zcol = (dir ? UC_ZB : UC_ZF) + hh * 128 + c, qcol = UC_QH + hh * 128 + c, vcol = UC_IH + hh * 128 + c;
    for (int idx = tid; idx < 64 * TS / 4; idx += 512) ((LAS unsigned*)(lds + L_AB))[idx] = 0u;
    f32x4 S[8];
    {
        const bf16_t* sp = INIT + (size_t)item * 16384 + (16 * w + 4 * gq) * 128 + (lane & 15);
#pragma unroll
        for (int n = 0; n < 8; ++n)
#pragma unroll
            for (int jj = 0; jj < 4; ++jj) S[n][jj] = bf2f(sp[jj * 128 + 16 * n]);
    }
#define HG_ST_WRITE() do { _Pragma("unroll") for (int n = 0; n < 8; ++n) { u32x2v wv; wv.x = cvt_pk_bf16(S[n][0], S[n][1]); wv.y = cvt_pk_bf16(S[n][2], S[n][3]); \
        *(LAS u32x2v*)(lds + L_ST + (16 * n + (lane & 15)) * RS + (16 * w + 4 * gq) * 2) = wv; } } while (0)
    HG_ST_WRITE();
    unsigned short rz[16], rq[16], rv[16];
    load_raw<true>(U, g, dir, 0, i, zcol, qcol, vcol, rz, rq, rv);
    for (int ch = 0; ch < NCH; ++ch) {
        float bdec;
        prep<true>(lds, i, c, lb, rz, rq, rv, bdec);
        if (ch + 1 < NCH) load_raw<true>(U, g, dir, ch + 1, i, zcol, qcol, vcol, rz, rq, rv);
        __syncthreads();
        for (int bi = w; bi < 10; bi += 8) {
            const int ti = bi >= 6 ? 3 : bi >= 3 ? 2 : bi >= 1 ? 1 : 0, tj = bi - ti * (ti + 1) / 2;
            const int qoff = (bi == 9) ? L_Q4 : L_QR + 16 * ti * RS, koff = (bi == 0) ? L_K0 : L_KR + 16 * tj * RS;
            f32x4 a = {0.f, 0.f, 0.f, 0.f};
#pragma unroll
            for (int ks = 0; ks < 4; ++ks) a = __builtin_amdgcn_mfma_f32_16x16x32_bf16(ldfrag(lds, qoff, RS, 0, 32 * ks, lane), ldfrag(lds, koff, RS, 0, 32 * ks, lane), a, 0, 0, 0);
#pragma unroll
            for (int jj = 0; jj < 4; ++jj) {
                float val = a[jj];
                if (ti == tj && (lane & 15) > 4 * gq + jj) val = 0.f;
                *(LAS unsigned short*)(lds + L_AB + (16 * ti + 4 * gq + jj) * TS + (16 * tj + (lane & 15)) * 2) = bf1(val);
            }
        }
        __syncthreads();
        {
            bf16x8 stf[4], vtf[2];
#pragma unroll
            for (int ks = 0; ks < 4; ++ks) stf[ks] = ldfrag(lds, L_ST, RS, 16 * w, 32 * ks, lane);
#pragma unroll
            for (int k2 = 0; k2 < 2; ++k2) vtf[k2] = ldfrag(lds, L_VT, TS, 16 * w, 32 * k2, lane);
#pragma unroll
            for (int mt = 0; mt < 4; ++mt) {
                f32x4 o = {0.f, 0.f, 0.f, 0.f};
#pragma unroll
                for (int ks = 0; ks < 4; ++ks) o = __builtin_amdgcn_mfma_f32_16x16x32_bf16(ldfrag(lds, L_QT, RS, 16 * mt, 32 * ks, lane), stf[ks], o, 0, 0, 0);
#pragma unroll
                for (int k2 = 0; k2 < 2; ++k2) o = __builtin_amdgcn_mfma_f32_16x16x32_bf16(ldfrag(lds, L_AB, TS, 16 * mt, 32 * k2, lane), vtf[k2], o, 0, 0, 0);
#pragma unroll
                for (int jj = 0; jj < 4; ++jj) {
                    const int row = phys_row(g, dir, 64 * ch + 16 * mt + 4 * gq + jj);
                    OUT[(size_t)row * opitch + 16 * w + (lane & 15)] = bf1(o[jj]);
                }
            }
        }
        state_update(lds, S, w, gq, lane);
        __syncthreads();
        HG_ST_WRITE();
    }
#undef HG_ST_WRITE
}
}

__device__ __forceinline__ void hg_finalize(const Params& p, const bf16_t* U, bf16_t* MIXIN, int blk, int G, int wave, int lane) {
    const float gn0 = p.g_hgrn[2 * lane], gn1 = p.g_hgrn[2 * lane + 1];
    const bf16_t* OB = (const bf16_t*)((const unsigned char*)p.out + hg::DO_OB);
    const int gw = blk * 8 + wave, ngw = G * 8;
    for (int r0 = gw * 4; r0 < T_; r0 += ngw * 4) {
        unsigned wm[4][4], wg[4][4], wo[4][4];
#pragma unroll
        for (int k = 0; k < 4; ++k)
#pragma unroll
            for (int hh = 0; hh < 4; ++hh) {
                const int row = r0 + k;
                wm[k][hh] = *((const unsigned*)(MIXIN + (size_t)row * DM + 512 + hh * 128) + lane);
                wg[k][hh] = *((const unsigned*)(U + (size_t)row * UP + UC_GH + hh * 128) + lane);
                wo[k][hh] = *((const unsigned*)(OB + (size_t)row * 512 + hh * 128) + lane);
            }
#pragma unroll
        for (int k = 0; k < 4; ++k)
#pragma unroll
            for (int hh = 0; hh < 4; ++hh) {
                const unsigned w = wm[k][hh], gw2 = wg[k][hh], wb = wo[k][hh];
                const float o0 = __uint_as_float(w << 16) + __uint_as_float(wb << 16), o1 = __uint_as_float(w & 0xffff0000u) + __uint_as_float(wb & 0xffff0000u);
                const float g0 = __uint_as_float(gw2 << 16), g1 = __uint_as_float(gw2 & 0xffff0000u);
                const float rs = rsqrtf(wave_sum(o0 * o0 + o1 * o1) * (1.f / 128.f) + EPS);
                *((unsigned*)(MIXIN + (size_t)(r0 + k) * DM + 512 + hh * 128) + lane) = cvt_pk_bf16(o0 * rs * gn0 * silu_f(g0), o1 * rs * gn1 * silu_f(g1));
            }
    }
}

__device__ __forceinline__ void p6_rows(const Params& p, LAS unsigned char* lds, int gw, int ngw, int wave, int lane) {
    bf16_t* WGU = (bf16_t*)(p.ws + WS_WGU); bf16_t* WDN = (bf16_t*)(p.ws + WS_WDN);
    LAS float* scr = (LAS float*)(lds + wave * 16384);
    constexpr int I_G = 16 * 88, I_D = 44 * 32;
    for (int it = gw; it < 2 * I_G + I_D; it += ngw) {
        if (it < I_G) transpose_item(p.w_gate, DFF, 64 * (it / 88), 32 * (it % 88), p.g_pre_ffn, WGU, DM, RowGU{0}, scr, lane);
        else if (it < 2 * I_G) { const int r = it - I_G; transpose_item(p.w_up, DFF, 64 * (r / 88), 32 * (r % 88), p.g_pre_ffn, WGU, DM, RowGU{1}, scr, lane); }
        else { const int r = it - 2 * I_G; transpose_item(p.w_down, DM, 64 * (r / 32), 32 * (r % 32), nullptr, WDN, DFF, RowId{}, scr, lane); }
    }
    bf16_t* MIX = (bf16_t*)(p.ws + WS_MIX); const float* SS = (const float*)(p.ws + WS_SS1);
    f32x4 gp[4];
#pragma unroll
    for (int j = 0; j < 4; ++j) gp[j] = ((const f32x4*)p.g_post_mix)[lane + 64 * j];
    for (int m0 = gw * 4; m0 < T_; m0 += ngw * 4) {
        f32x4 xv[4][4]; u32x2v mw[4][4]; float r1[4];
#pragma unroll
        for (int k = 0; k < 4; ++k) {
            const int m = m0 + k;
            const f32x4* ssp = (const f32x4*)(SS + (size_t)m * 16);
            const f32x4 a = ssp[0], b = ssp[1], c = ssp[2], d = ssp[3];
            const float ss = ((a[0] + a[1]) + (a[2] + a[3])) + ((b[0] + b[1]) + (b[2] + b[3])) + ((c[0] + c[1]) + (c[2] + c[3])) + ((d[0] + d[1]) + (d[2] + d[3]));
            r1[k] = rsqrtf(ss * (1.f / DM) + EPS);
            const f32x4* xr = (const f32x4*)xrow_ptr(p, m) + lane;
            const u32x2v* mx = (const u32x2v*)(MIX + (size_t)m * DM) + lane;
#pragma unroll
            for (int jj = 0; jj < 4; ++jj) { xv[k][jj] = xr[64 * jj]; mw[k][jj] = mx[64 * jj]; }
        }
        float s2[4];
#pragma unroll
        for (int k = 0; k < 4; ++k) {
            f32x4* xo = (f32x4*)(p.out + (size_t)(m0 + k) * DM) + lane;
            s2[k] = 0.f;
#pragma unroll
            for (int jj = 0; jj < 4; ++jj) {
                const u32x2v w = mw[k][jj];
                f32x4 mv = {__uint_as_float(w.x << 16), __uint_as_float(w.x & 0xffff0000u), __uint_as_float(w.y << 16), __uint_as_float(w.y & 0xffff0000u)};
                xv[k][jj] = xv[k][jj] + mv * r1[k] * gp[jj];
                s2[k] += (xv[k][jj][0] * xv[k][jj][0] + xv[k][jj][1] * xv[k][jj][1]) + (xv[k][jj][2] * xv[k][jj][2] + xv[k][jj][3] * xv[k][jj][3]);
                xo[64 * jj] = xv[k][jj];
            }
        }
#pragma unroll
        for (int k = 0; k < 4; ++k) {
            const float r2 = rsqrtf(wave_sum(s2[k]) * (1.f / DM) + EPS);
            u32x2v* mx = (u32x2v*)(MIX + (size_t)(m0 + k) * DM) + lane;
#pragma unroll
            for (int jj = 0; jj < 4; ++jj) { u32x2v w; w.x = cvt_pk_bf16(xv[k][jj][0] * r2, xv[k][jj][1] * r2); w.y = cvt_pk_bf16(xv[k][jj][2] * r2, xv[k][jj][3] * r2); mx[64 * jj] = w; }
        }
    }
}
__device__ __forceinline__ void p9_rows(const Params& p, int gw, int ngw, int lane) {
    const bf16_t* FF = (const bf16_t*)(p.ws + WS_MIX); const float* SS = (const float*)(p.ws + WS_SS2);
    f32x4 gp[4];
#pragma unroll
    for (int j = 0; j < 4; ++j) gp[j] = ((const f32x4*)p.g_post_ffn)[lane + 64 * j];
    for (int m0 = gw * 4; m0 < T_; m0 += ngw * 4) {
        f32x4 xv[4][4]; u32x2v fw[4][4]; float r1[4];
#pragma unroll
        for (int k = 0; k < 4; ++k) {
            const int m = m0 + k;
            const f32x4* ssp = (const f32x4*)(SS + (size_t)m * 16);
            const f32x4 a = ssp[0], b = ssp[1], c = ssp[2], d = ssp[3];
            const float ss = ((a[0] + a[1]) + (a[2] + a[3])) + ((b[0] + b[1]) + (b[2] + b[3])) + ((c[0] + c[1]) + (c[2] + c[3])) + ((d[0] + d[1]) + (d[2] + d[3]));
            r1[k] = rsqrtf(ss * (1.f / DM) + EPS);
            const u32x2v* fx = (const u32x2v*)(FF + (size_t)m * DM) + lane;
            const f32x4* xo = (const f32x4*)(p.out + (size_t)m * DM) + lane;
#pragma unroll
            for (int jj = 0; jj < 4; ++jj) { xv[k][jj] = xo[64 * jj]; fw[k][jj] = fx[64 * jj]; }
        }
#pragma unroll
        for (int k = 0; k < 4; ++k) {
            f32x4* xo = (f32x4*)(p.out + (size_t)(m0 + k) * DM) + lane;
#pragma unroll
            for (int jj = 0; jj < 4; ++jj) {
                const u32x2v w = fw[k][jj];
                f32x4 fv = {__uint_as_float(w.x << 16), __uint_as_float(w.x & 0xffff0000u), __uint_as_float(w.y << 16), __uint_as_float(w.y & 0xffff0000u)};
                xo[64 * jj] = xv[k][jj] + fv * r1[k] * gp[jj];
            }
        }
    }
}

__global__ void __launch_bounds__(512, 2) fwd_megakernel(Params p) {
    extern __shared__ __attribute__((aligned(16))) unsigned char lds_raw[];
    LAS unsigned char* lds = (LAS unsigned char*)lds_raw;
    cg::grid_group grid = cg::this_grid();
#define GSYNC() do { asm volatile("s_waitcnt vmcnt(0)" ::: "memory"); grid.sync(); \
        if (wave == 0) { __builtin_amdgcn_fence(__ATOMIC_ACQUIRE, "agent"); asm volatile("s_waitcnt vmcnt(0)" ::: "memory"); } __syncthreads(); } while (0)
    const int tid = otid(), lane = tid & 63, wave = __builtin_amdgcn_readfirstlane(tid >> 6);
    const int G = gridDim.x, blk = blockIdx.x;
    const int gw = blk * 8 + wave, ngw = G * 8;
    unsigned char* dob = (unsigned char*)p.out;
    bf16_t* U = (bf16_t*)(p.ws + WS_U);
    bf16_t* MIXIN = (bf16_t*)(dob + DO_MIXIN);

    volatile LAS unsigned* bst = (volatile LAS unsigned*)(lds + LDS_BYTES - 16);
    if (tid < 2) bst[tid] = 0u;
    if (blk == 0) for (int i2 = tid; i2 < 3456; i2 += 512) __hip_atomic_store(g_bar + i2, 0u, __ATOMIC_RELAXED, __HIP_MEMORY_SCOPE_AGENT);
    p0_prologue(p, lds, gw, ngw, wave, lane);
    GSYNC();
    const XcdBarrier xbar = xcd_barrier_post(g_bar, bst);
#define XSYNC() xcd_barrier(xbar)
    {
        pg8::Gemm g{(const bf16_t*)(dob + DO_XN), (const bf16_t*)(dob + DO_WIN), T_, NIN, DM}; pg8::StaticOrder S; S.init(T_, NIN, G, blk);
        EpiU E{U, (bf16_t*)(p.ws + WS_QB), (const float*)(dob + DO_ROPE)};
        pg8::gemm_phase<EpiU, pg8::StaticOrder, true, true>(lds, g, S, E);
    }
    XSYNC();
    for (int lin = blk; lin < hg::NITEM; lin += G) hg::pass1(p, U, lds, hg::item_of(lin, G));
    at::attn_phase((const bf16_t*)(p.ws + WS_QB), MIXIN, lds, blk, G);
    XSYNC();
    hg::scan(p, blk * 512 + tid, G * 512);
    XSYNC();
    for (int lin = blk; lin < hg::NITEM; lin += G) hg::pass2(p, U, MIXIN, lds, hg::item_of(lin, G));
    XSYNC();
    hg_finalize(p, U, MIXIN, blk, G, wave, lane);
    XSYNC();
    {
        pg8::Gemm g{MIXIN, (const bf16_t*)(dob + DO_WOUT), T_, DM, DM}; pg8::StaticOrder S; S.init(T_, DM, G, blk);
        EpiRowSS E{(bf16_t*)(p.ws + WS_MIX), (float*)(p.ws + WS_SS1)};
        pg8::gemm_phase<EpiRowSS, pg8::StaticOrder, true, true>(lds, g, S, E);
    }
    XSYNC();
    p6_rows(p, lds, gw, ngw, wave, lane);
    XSYNC();
    {
        pg8::Gemm g{(const bf16_t*)(p.ws + WS_MIX), (const bf16_t*)(p.ws + WS_WGU), T_, 2 * DFF, DM}; pg8::StaticOrder S; S.init(T_, 2 * DFF, G, blk);
        EpiSwiGLU E{(bf16_t*)(p.ws + WS_HFF)};
        pg8::gemm_phase<EpiSwiGLU, pg8::StaticOrder, true, true>(lds, g, S, E);
    }
    XSYNC();
    {
        pg8::Gemm g{(const bf16_t*)(p.ws + WS_HFF), (const bf16_t*)(p.ws + WS_WDN), T_, DM, DFF}; pg8::StaticOrder S; S.init(T_, DM, G, blk);
        EpiRowSS E{(bf16_t*)(p.ws + WS_MIX), (float*)(p.ws + WS_SS2)};
        pg8::gemm_phase<EpiRowSS, pg8::StaticOrder, true, true>(lds, g, S, E);
    }
    XSYNC();
    p9_rows(p, gw, ngw, lane);
}

extern "C" void kernel_launch(void* const* d_in, const int* in_sizes, int n_in, void* d_out, int out_size, void* d_ws, size_t ws_size, hipStream_t stream) {
    static int grid_blocks = 0;
    if (grid_blocks == 0) {
        int dev = 0, cus = 0, per_cu = 0;
        hipGetDevice(&dev);
        hipDeviceGetAttribute(&cus, hipDeviceAttributeMultiprocessorCount, dev);
        hipFuncSetAttribute((const void*)fwd_megakernel, hipFuncAttributeMaxDynamicSharedMemorySize, LDS_BYTES);
        hipOccupancyMaxActiveBlocksPerMultiprocessor(&per_cu, (const void*)fwd_megakernel, 512, LDS_BYTES);
        if (per_cu < 1) { fprintf(stderr, "occupancy query reports %d blocks per CU\n", per_cu); per_cu = 1; }
        if (per_cu > 1) per_cu = 1;
        grid_blocks = cus * per_cu;
        if (ws_size < 512 * MiB) fprintf(stderr, "kernel_launch: workspace %zu smaller than the 512 MiB map\n", ws_size);
    }
    Params p{};
    p.xp = (const float*)d_in[0]; p.xs = (const float*)d_in[1]; p.w_in = (const float*)d_in[2]; p.w_out = (const float*)d_in[3];
    p.lb_fwd = (const float*)d_in[4]; p.lb_bwd = (const float*)d_in[5]; p.g_hgrn = (const float*)d_in[6]; p.g_pre_mix = (const float*)d_in[7];
    p.g_post_mix = (const float*)d_in[8]; p.g_pre_ffn = (const float*)d_in[9]; p.g_post_ffn = (const float*)d_in[10];
    p.w_gate = (const float*)d_in[11]; p.w_up = (const float*)d_in[12]; p.w_down = (const float*)d_in[13];
    p.out = (float*)d_out; p.ws = (unsigned char*)d_ws;
    void* args[] = {&p};
    hipError_t e = hipLaunchCooperativeKernel((const void*)fwd_megakernel, dim3(grid_blocks), dim3(512), args, LDS_BYTES, stream);
    if (e != hipSuccess) fprintf(stderr, "cooperative launch failed: %s (grid %d)\n", hipGetErrorString(e), grid_blocks);
}
```

```cpp
#include <hip/hip_runtime.h>
#include <hip/hip_cooperative_groups.h>
#include <cstdio>
#include <cstdint>
namespace cg = cooperative_groups;
namespace pg8 {
#define PG8_LAS __attribute__((address_space(3)))
typedef unsigned short bf16_t;
typedef short bf16x8 __attribute__((ext_vector_type(8)));
typedef float f32x4 __attribute__((ext_vector_type(4)));
typedef unsigned u32x4 __attribute__((ext_vector_type(4)));
constexpr int BM = 256, BK = 64, HALF = 128, HTB = HALF * BK * 2  , STAGE_BYTES = 8 * HTB, NXCD = 8, WGM = 8;

__host__ __device__ __forceinline__ int lds_byte(int r, int c) { const int st = (r >> 4) * 2 + (c >> 5), rr = r & 15, cc = c & 31, ob = rr * 64 + cc * 2; return st * 1024 + (ob ^ (((ob >> 9) & 1) << 5)); }
__host__ __device__ __forceinline__ void stage_rc(int b, int& R, int& C) { const int st = b / 1024, sb = b % 1024, swz = sb ^ (((sb >> 9) & 1) << 5); R = (st >> 1) * 16 + swz / 64; C = (st & 1) * 32 + (swz % 64) / 2; }
__host__ __device__ __forceinline__ int perm32(int rho) { const int n = rho >> 4, i = rho & 15; return 8 * (i >> 2) + 4 * n + (i & 3); }

struct Unit { int pm, pn; };
struct Gemm { const bf16_t* A; const bf16_t* Bt; int M, N, K; };

struct StaticOrder {
    int nM, nN, nwg, G, c;
    __host__ __device__ void init(int M, int N, int G_, int c_) { nM = M / BM; nN = N / BM; nwg = nM * nN; G = G_; c = c_; }
    __host__ __device__ bool next(int i, Unit& u) const {
        const long L = (long)i * G + c; if (L >= nwg) return false;
        int wgid = (int)L; { const int q = nwg / NXCD, r = nwg % NXCD, xcd = wgid % NXCD, off = wgid / NXCD; wgid = (xcd < r ? xcd * (q + 1) : r * (q + 1) + (xcd - r) * q) + off; }
        const int nig = WGM * nN, gid = wgid / nig, fm = gid * WGM, gsz = (nM - fm) < WGM ? (nM - fm) : WGM;
        u.pm = fm + ((wgid % nig) % gsz); u.pn = (wgid % nig) / gsz; return true;
    }
    __device__ __forceinline__ void a_ready(const Unit&) const {}
    __device__ __forceinline__ void done(const Unit&) const {}
};

typedef __bf16 bf16x2_t __attribute__((ext_vector_type(2)));
typedef float f32x2_t __attribute__((ext_vector_type(2)));
__device__ __forceinline__ unsigned cvt_pk_bf16(float lo, float hi) { f32x2_t v = {lo, hi}; bf16x2_t b = __builtin_convertvector(v, bf16x2_t); return __builtin_bit_cast(unsigned, b); }
typedef float f32x2 __attribute__((ext_vector_type(2)));
template <class Epi, class Sched, bool ALIGN_EPI = false, bool SP2 = false>
__device__ __forceinline__ void gemm_phase(PG8_LAS unsigned char* lds, const Gemm g, const Sched& S, const Epi& E) {
    int tid; asm volatile("v_mov_b32 %0, %1" : "=v"(tid) : "v"((int)threadIdx.x));
    const int wid = __builtin_amdgcn_readfirstlane(tid >> 6), lane = tid & 63, wr = wid >> 2, wc = wid & 3, fr = lane & 15, fq = lane >> 4;
    const int K = g.K, nt = K / BK;
    unsigned voffA[2], voffB[2];
#pragma unroll
    for (int i = 0; i < 2; ++i) { int R, C; stage_rc(tid * 16 + i * 8192, R, C); const int Rb = Epi::PERM ? ((R & ~31) + perm32(R & 31)) : R;
        voffA[i] = (unsigned)(R * K + C) * 2u; voffB[i] = (unsigned)(Rb * K + C) * 2u; }
    const size_t kstep = (size_t)(BK * 2);
    const size_t hstep = (size_t)HALF * K * 2;
    const size_t tstep = 2 * hstep;
    const unsigned ldsw = (unsigned)wid * 1024u;
    const int aoff = lds_byte(wr * 64 + fr, fq * 8), boff = lds_byte(wc * 32 + fr, fq * 8);
#define PG8_SA(b, h) (((b) * 2 + (h)) * HTB)
#define PG8_SB(b, h) ((4 + (b) * 2 + (h)) * HTB)
#define PG8_STAGE(bufoff, gbase, voff) do { _Pragma("unroll") for (int _i = 0; _i < 2; ++_i) \
        __builtin_amdgcn_global_load_lds((const unsigned*)((const char*)(gbase) + (voff)[_i]), (PG8_LAS unsigned*)(lds + (bufoff) + ldsw + _i * 8192), 16, 0, 0); } while (0)
#define PG8_LDA(dst, b, h) do { _Pragma("unroll") for (int m = 0; m < 4; ++m) _Pragma("unroll") for (int k = 0; k < 2; ++k) dst[m][k] = *(const PG8_LAS bf16x8*)(lds + PG8_SA(b, h) + aoff + m * 2048 + k * 1024); } while (0)
#define PG8_LDB(dst, b, h) do { _Pragma("unroll") for (int n = 0; n < 2; ++n) _Pragma("unroll") for (int k = 0; k < 2; ++k) dst[n][k] = *(const PG8_LAS bf16x8*)(lds + PG8_SB(b, h) + boff + n * 2048 + k * 1024); } while (0)
#define PG8_MMA(ai, bj, At, Bt) do { __builtin_amdgcn_s_setprio(1); _Pragma("unroll") for (int m = 0; m < 4; ++m) _Pragma("unroll") for (int n = 0; n < 2; ++n) _Pragma("unroll") for (int k = 0; k < 2; ++k) \
        acc[ai][bj][m][n] = __builtin_amdgcn_mfma_f32_16x16x32_bf16(Bt[n][k], At[m][k], acc[ai][bj][m][n], 0, 0, 0); __builtin_amdgcn_s_setprio(0); } while (0)
#define PG8_WAIT_V(n) asm volatile("s_waitcnt vmcnt(" #n ")" ::: "memory")
#define PG8_WAIT_L(n) asm volatile("s_waitcnt lgkmcnt(" #n ")" ::: "memory")
#define PG8_BAR __builtin_amdgcn_s_barrier()
#define PG8_SCHED __builtin_amdgcn_sched_barrier(0)
    Unit cur, nxt; int ui = 0;
    if (!S.next(0, cur)) return;
    f32x4 acc[2][2][4][2];
#pragma unroll
    for (int a = 0; a < 2; ++a)
#pragma unroll
        for (int b = 0; b < 2; ++b)
#pragma unroll
            for (int m = 0; m < 4; ++m)
#pragma unroll
                for (int n = 0; n < 2; ++n) acc[a][b][m][n] = (f32x4){0.f, 0.f, 0.f, 0.f};
    bf16x8 At[4][2], B0[2][2], B1[2][2];
    const char* cA = (const char*)g.A + (size_t)cur.pm * tstep; const char* cB = (const char*)g.Bt + (size_t)cur.pn * tstep;
    S.a_ready(cur);
    if constexpr (SP2) {
        PG8_STAGE(PG8_SB(0, 0), cB, voffB); PG8_STAGE(PG8_SB(0, 1), cB + hstep, voffB); PG8_STAGE(PG8_SA(0, 0), cA, voffA); PG8_STAGE(PG8_SA(0, 1), cA + hstep, voffA);
        if (wr == 1) PG8_BAR;
        PG8_WAIT_V(2); PG8_BAR;
        PG8_STAGE(PG8_SB(1, 0), cB + kstep, voffB); PG8_STAGE(PG8_SA(1, 0), cA + kstep, voffA); PG8_STAGE(PG8_SB(1, 1), cB + hstep + kstep, voffB);
        PG8_WAIT_V(6); PG8_BAR;
    } else {
        PG8_STAGE(PG8_SB(0, 0), cB, voffB); PG8_STAGE(PG8_SA(0, 0), cA, voffA); PG8_STAGE(PG8_SB(0, 1), cB + hstep, voffB); PG8_STAGE(PG8_SA(0, 1), cA + hstep, voffA);
        if (wr == 1) PG8_BAR;
        PG8_WAIT_V(4); PG8_BAR;
        PG8_STAGE(PG8_SB(1, 0), cB + kstep, voffB); PG8_STAGE(PG8_SA(1, 0), cA + kstep, voffA); PG8_STAGE(PG8_SB(1, 1), cB + hstep + kstep, voffB);
        PG8_WAIT_V(6); PG8_BAR;
    }
    for (;;) {
        const bool has_next = S.next(ui + 1, nxt);
        const char* nA = has_next ? (const char*)g.A + (size_t)nxt.pm * tstep : cA; const char* nB = has_next ? (const char*)g.Bt + (size_t)nxt.pn * tstep : cB;
        for (int t = 0; t < nt; t += 2) {
            const bool last = (t == nt - 2);
            const char* a1 = cA + (size_t)(t + 1) * kstep;
            const char* a2 = last ? nA : cA + (size_t)(t + 2) * kstep; const char* b2 = last ? nB : cB + (size_t)(t + 2) * kstep;
            const char* a3 = a2 + kstep; const char* b3 = b2 + kstep;
            if (last && has_next) S.a_ready(nxt);
            if constexpr (SP2) {
            PG8_LDB(B0, 0, 0); PG8_LDB(B1, 0, 1); PG8_SCHED; PG8_LDA(At, 0, 0); PG8_STAGE(PG8_SA(1, 1), a1 + hstep, voffA);
            PG8_WAIT_V(8); PG8_WAIT_L(0); PG8_BAR; PG8_MMA(0, 0, At, B0); PG8_MMA(0, 1, At, B1); PG8_BAR; PG8_SCHED;
            PG8_LDA(At, 0, 1); PG8_STAGE(PG8_SB(0, 0), b2, voffB); PG8_STAGE(PG8_SB(0, 1), b2 + hstep, voffB); PG8_STAGE(PG8_SA(0, 0), a2, voffA);
            PG8_WAIT_V(8); PG8_WAIT_L(0); PG8_BAR; PG8_MMA(1, 0, At, B0); PG8_MMA(1, 1, At, B1); PG8_BAR; PG8_SCHED;
            PG8_LDB(B0, 1, 0); PG8_LDB(B1, 1, 1); PG8_SCHED; PG8_LDA(At, 1, 0); PG8_STAGE(PG8_SA(0, 1), a2 + hstep, voffA);
            PG8_WAIT_V(8); PG8_WAIT_L(0); PG8_BAR; PG8_MMA(0, 0, At, B0); PG8_MMA(0, 1, At, B1); PG8_BAR; PG8_SCHED;
            PG8_LDA(At, 1, 1); PG8_STAGE(PG8_SB(1, 0), b3, voffB); PG8_STAGE(PG8_SB(1, 1), b3 + hstep, voffB); PG8_STAGE(PG8_SA(1, 0), a3, voffA);
            PG8_WAIT_V(8); PG8_WAIT_L(0); PG8_BAR; PG8_MMA(1, 0, At, B0); PG8_MMA(1, 1, At, B1); PG8_BAR; PG8_SCHED;
            } else {
            PG8_LDB(B0, 0, 0); PG8_SCHED; PG8_LDA(At, 0, 0); PG8_STAGE(PG8_SA(1, 1), a1 + hstep, voffA);
            PG8_WAIT_L(8); PG8_BAR; PG8_WAIT_L(0); PG8_MMA(0, 0, At, B0); PG8_BAR; PG8_SCHED;
            PG8_LDB(B1, 0, 1); PG8_STAGE(PG8_SB(0, 0), b2, voffB);
            PG8_BAR; PG8_WAIT_L(0); PG8_MMA(0, 1, At, B1); PG8_BAR;
            PG8_LDA(At, 0, 1); PG8_STAGE(PG8_SA(0, 0), a2, voffA);
            PG8_BAR; PG8_WAIT_L(0); PG8_MMA(1, 0, At, B0); PG8_BAR; PG8_SCHED;
            PG8_STAGE(PG8_SB(0, 1), b2 + hstep, voffB);
            PG8_WAIT_V(6); PG8_BAR; PG8_MMA(1, 1, At, B1); PG8_BAR;
            PG8_LDB(B0, 1, 0); PG8_SCHED; PG8_LDA(At, 1, 0); PG8_STAGE(PG8_SA(0, 1), a2 + hstep, voffA);
            PG8_WAIT_L(8); PG8_BAR; PG8_WAIT_L(0); PG8_MMA(0, 0, At, B0); PG8_BAR; PG8_SCHED;
            PG8_LDB(B1, 1, 1); PG8_STAGE(PG8_SB(1, 0), b3, voffB);
            PG8_BAR; PG8_WAIT_L(0); PG8_MMA(0, 1, At, B1); PG8_BAR;
            PG8_LDA(At, 1, 1); PG8_STAGE(PG8_SA(1, 0), a3, voffA);
            PG8_BAR; PG8_WAIT_L(0); PG8_MMA(1, 0, At, B0); PG8_BAR; PG8_SCHED;
            PG8_STAGE(PG8_SB(1, 1), b3 + hstep, voffB);
            PG8_WAIT_V(6); PG8_BAR; PG8_MMA(1, 1, At, B1); PG8_BAR;
            }
        }
        if constexpr (ALIGN_EPI) { if (wr == 0) PG8_BAR; }
        if constexpr (!Epi::AFTER_DRAIN) { E(acc, cur, wr, wc, fr, fq); S.done(cur); }
        if (!has_next) break;
#pragma unroll
        for (int a = 0; a < 2; ++a)
#pragma unroll
            for (int b = 0; b < 2; ++b)
#pragma unroll
                for (int m = 0; m < 4; ++m)
#pragma unroll
                    for (int n = 0; n < 2; ++n) acc[a][b][m][n] = (f32x4){0.f, 0.f, 0.f, 0.f};
        cur = nxt; cA = nA; cB = nB; ++ui;
        if constexpr (ALIGN_EPI) { if (wr == 1) PG8_BAR; }
    }
    PG8_WAIT_V(0);
    if constexpr (!ALIGN_EPI) { if (wr == 0) PG8_BAR; }
    PG8_BAR;
    if constexpr (Epi::AFTER_DRAIN) { E.fused(acc, cur, wr, wc, fr, fq, lds, wid, lane); S.done(cur); }
#undef PG8_SA
#undef PG8_SB
#undef PG8_STAGE
#undef PG8_LDA
#undef PG8_LDB
#undef PG8_MMA
#undef PG8_WAIT_V
#undef PG8_WAIT_L
#undef PG8_BAR
#undef PG8_SCHED
}
}

#define LAS __attribute__((address_space(3)))
typedef unsigned short bf16_t;
using pg8::f32x4; using pg8::u32x4; using pg8::Unit; using pg8::cvt_pk_bf16;
typedef float f32x2v __attribute__((ext_vector_type(2)));
typedef unsigned u32x2v __attribute__((ext_vector_type(2)));

constexpr int T_ = 65536, DM = 1024, NIN = 4096, DFF = 2816, ROWS_P = 32768;
constexpr size_t MiB = 1u << 20;
constexpr float EPS = 1e-6f;
constexpr int LDS_BYTES = 147456;
constexpr size_t DO_XN = 0, DO_MIXIN = 0, DO_WIN = 128 * MiB, DO_ROPE = 136 * MiB, DO_WOUT = 137 * MiB;
constexpr size_t WS_U = 0;
constexpr size_t WS_MIX = 0;
constexpr size_t WS_WGU = 128 * MiB, WS_WDN = 139 * MiB, WS_SS1 = 145 * MiB, WS_SS2 = 149 * MiB, WS_HFF = 160 * MiB;
constexpr int UP = 2560;
constexpr int UC_QH = 0, UC_ZF = 512, UC_ZB = 1024, UC_IH = 1536, UC_GH = 2048;
constexpr size_t WS_QB = 320 * MiB, WS_KB = 384 * MiB, WS_VB = 448 * MiB;
__device__ __forceinline__ int perm_row(int row) {
    if (row < ROWS_P) { const int pos = row & 16383; return (row & ~16383) + ((pos & 15) << 10) + (pos >> 4); }
    const int pos = row & 4095; return (row & ~4095) + ((pos & 15) << 8) + (pos >> 4);
}

__device__ __forceinline__ float bf2f(unsigned short h) { return __uint_as_float((unsigned)h << 16); }
__device__ __forceinline__ unsigned short f2bf(float f) { unsigned u = __float_as_uint(f); return (unsigned short)((u + 0x7fffu + ((u >> 16) & 1u)) >> 16); }
__device__ __forceinline__ unsigned pk2(float lo, float hi) { return cvt_pk_bf16(lo, hi); }
__device__ __forceinline__ float silu_f(float x) { return x * __builtin_amdgcn_rcpf(1.f + __expf(-x)); }
__device__ __forceinline__ float sigmoid_f(float x) { return __builtin_amdgcn_rcpf(1.f + __expf(-x)); }
__device__ __forceinline__ int row_pos(int row) { return row < ROWS_P ? (row & 16383) : (row & 4095); }
__device__ __forceinline__ int row_S(int row) { return row < ROWS_P ? 16384 : 4096; }
__device__ __forceinline__ float wave_sum(float v) {
#pragma unroll
    for (int o = 1; o < 64; o <<= 1) v += __shfl_xor(v, o);
    return v;
}
__device__ __forceinline__ float wave_max(float v) {
#pragma unroll
    for (int o = 1; o < 64; o <<= 1) v = fmaxf(v, __shfl_xor(v, o));
    return v;
}
#define LDS_WAIT() asm volatile("s_waitcnt lgkmcnt(0)" ::: "memory")
__device__ __forceinline__ int otid() { int t; asm volatile("v_mov_b32 %0, %1" : "=v"(t) : "v"((int)threadIdx.x)); return t; }


__device__ unsigned g_bar[3456];
struct XcdBarrier { unsigned* bar; unsigned x; volatile LAS unsigned* st; };
#define XB_TMO      128
#define XB_XCNT(j)  (256  + 64 * (j))
#define XB_XSUB(j)  (1280 + 64 * (j))
#define XB_XGEN(j)  (2304 + 64 * (j))
#define XB_TOP      3328
#define XB_TOPGEN   3392
#define XCD_BAR_WORDS 3456
#define XB_SPIN_CAP (1u << 18)

__device__ __forceinline__ unsigned xb_ld(unsigned* p)              { return __hip_atomic_load(p, __ATOMIC_RELAXED, __HIP_MEMORY_SCOPE_AGENT); }
__device__ __forceinline__ unsigned xb_add(unsigned* p, unsigned v) { return __hip_atomic_fetch_add(p, v, __ATOMIC_RELAXED, __HIP_MEMORY_SCOPE_AGENT); }
__device__ __forceinline__ unsigned xb_xcc_id() { return (unsigned)__builtin_amdgcn_s_getreg((3 << 11) | 20) & 0xFu; }
#define XB_SPIN(cond, bar) do { unsigned _sp = 0; while (cond) { __builtin_amdgcn_s_sleep(1); \
    if ((++_sp & 255u) == 0u) { if (xb_ld(&(bar)[XB_TMO])) break; if (_sp > XB_SPIN_CAP) { atomicAdd(&(bar)[XB_TMO], 1u); break; } } } } while (0)
__device__ __forceinline__ XcdBarrier xcd_barrier_post(unsigned* bar, volatile LAS unsigned* st) {
    XcdBarrier b; b.bar = bar; b.x = xb_xcc_id(); b.st = st;
    if (threadIdx.x == 0) (void)xb_add(&bar[XB_XCNT(b.x)], 1u);
    return b;
}
__device__ __forceinline__ void xcd_barrier_complete(unsigned* bar, unsigned x, unsigned& nloc, unsigned& nx) {
    const unsigned G = gridDim.x * gridDim.y * gridDim.z;
    unsigned sum, cnt, mine, sp = 0u;
    for (;;) {
        sum = 0u; cnt = 0u; mine = 0u;
#pragma unroll
        for (unsigned j = 0; j < 16; ++j) { const unsigned c = xb_ld(&bar[XB_XCNT(j)]); sum += c; cnt += (c > 0u) ? 1u : 0u; mine = (j == x) ? c : mine; }
        if (sum == G) break;
        __builtin_amdgcn_s_sleep(1);
        if ((++sp & 255u) == 0u) { if (xb_ld(&bar[XB_TMO])) break; if (sp > XB_SPIN_CAP) { atomicAdd(&bar[XB_TMO], 1u); break; } }
    }
    nloc = mine > 0u ? mine : 1u; nx = cnt > 0u ? cnt : 1u;
}

__device__ __forceinline__ void xcd_barrier(const XcdBarrier& b) {
    asm volatile("s_waitcnt vmcnt(0)" ::: "memory");
    __syncthreads();
    if (threadIdx.x == 0) {
        unsigned* bar = b.bar;
        __builtin_amdgcn_s_waitcnt(0);
        unsigned nloc = b.st[0], nx = b.st[1];
        if (nloc == 0u) { xcd_barrier_complete(bar, b.x, nloc, nx); b.st[0] = nloc; b.st[1] = nx; }
        const unsigned old = xb_add(&bar[XB_XSUB(b.x)], 1u);
        const unsigned gen = old / nloc;
        if (old + 1u == (gen + 1u) * nloc) {
            __builtin_amdgcn_fence(__ATOMIC_RELEASE, "agent");
            asm volatile("s_waitcnt vmcnt(0)" ::: "memory");
            const unsigned og = xb_add(&bar[XB_TOP], 1u);
            const unsigned tg = og / nx;
            if (og + 1u == (tg + 1u) * nx) xb_add(&bar[XB_TOPGEN], 1u);
            else XB_SPIN(xb_ld(&bar[XB_TOPGEN]) == tg, bar);
            __builtin_amdgcn_fence(__ATOMIC_ACQUIRE, "agent");
            xb_add(&bar[XB_XGEN(b.x)], 1u);
            asm volatile("s_waitcnt vmcnt(0)" ::: "memory");
        } else {
            XB_SPIN(xb_ld(&bar[XB_XGEN(b.x)]) == gen, bar);
            __builtin_amdgcn_fence(__ATOMIC_ACQUIRE, "agent");
            asm volatile("s_waitcnt vmcnt(0)" ::: "memory");
        }
    }
    __syncthreads();
}

struct EpiU {
    static constexpr bool PERM = true, AFTER_DRAIN = false;
    bf16_t* UH; bf16_t* XB; const float* rope;
    __device__ __forceinline__ void operator()(const f32x4 (&acc)[2][2][4][2], const Unit& u, int wr, int wc, int fr, int fq) const {
        const int row0 = u.pm * 256 + wr * 64 + fr;
        const bool attn = u.pn < 6;
        const bool rope_tile = (u.pn < 4) && ((wc & 1) == 0);
        const float sc = (u.pn < 2) ? 0.125f : 1.0f;
        const float sgn = (fq == 0) ? -1.f : 1.f;
#pragma unroll
        for (int ai = 0; ai < 2; ++ai)
#pragma unroll
            for (int m = 0; m < 4; ++m) {
                const int row = row0 + ai * 128 + m * 16;
                f32x4 r0 = {1.f, 0.f, 1.f, 0.f}, r1 = r0, r2 = r0, r3 = r0;
                if (rope_tile) { const f32x4* rp = (const f32x4*)(rope + (size_t)row_pos(row) * 16); r0 = rp[0]; r1 = rp[1]; r2 = rp[2]; r3 = rp[3]; }
                const size_t prow = attn ? (size_t)perm_row(row) : 0;
#pragma unroll
                for (int bj = 0; bj < 2; ++bj) {
                    f32x4 v0 = acc[ai][bj][m][0], v1 = acc[ai][bj][m][1];
                    if (rope_tile) {
                        f32x4 p0, p1;
#pragma unroll
                        for (int j = 0; j < 4; ++j) { p0[j] = __shfl_xor(v0[j], 16); p1[j] = __shfl_xor(v1[j], 16); }
                        if (fq < 2) {
                            v0[0] = v0[0] * r0[0] + sgn * p0[0] * r0[1]; v0[1] = v0[1] * r0[2] + sgn * p0[1] * r0[3];
                            v0[2] = v0[2] * r1[0] + sgn * p0[2] * r1[1]; v0[3] = v0[3] * r1[2] + sgn * p0[3] * r1[3];
                            v1[0] = v1[0] * r2[0] + sgn * p1[0] * r2[1]; v1[1] = v1[1] * r2[2] + sgn * p1[1] * r2[3];
                            v1[2] = v1[2] * r3[0] + sgn * p1[2] * r3[1]; v1[3] = v1[3] * r3[2] + sgn * p1[3] * r3[3];
                        }
                    }
                    v0 = v0 * sc; v1 = v1 * sc;
                    u32x4 w; w.x = cvt_pk_bf16(v0[0], v0[1]); w.y = cvt_pk_bf16(v0[2], v0[3]); w.z = cvt_pk_bf16(v1[0], v1[1]); w.w = cvt_pk_bf16(v1[2], v1[3]);
                    bf16_t* dst;
                    if (attn) {
                        const int cs = (u.pn & 1) * 256 + bj * 128 + wc * 32 + 8 * fq;
                        dst = XB + (size_t)(u.pn >> 1) * ((size_t)T_ * 512) + ((size_t)(cs >> 6) * T_ + prow) * 64 + (cs & 63);
                    } else dst = UH + (size_t)row * UP + (u.pn * 256 - 1536) + bj * 128 + wc * 32 + 8 * fq;
                    *(u32x4*)dst = w;
                }
            }
    }
};
struct EpiRowSS {
    static constexpr bool PERM = true, AFTER_DRAIN = false;
    bf16_t* O; float* SS;
    __device__ __forceinline__ void operator()(const f32x4 (&acc)[2][2][4][2], const Unit& u, int wr, int wc, int fr, int fq) const {
        const int row0 = u.pm * 256 + wr * 64 + fr, col0 = u.pn * 256 + wc * 32 + 8 * fq;
#pragma unroll
        for (int ai = 0; ai < 2; ++ai)
#pragma unroll
            for (int m = 0; m < 4; ++m) {
                const int row = row0 + ai * 128 + m * 16;
                bf16_t* rowp = O + (size_t)row * DM + col0;
                float s = 0.f;
#pragma unroll
                for (int bj = 0; bj < 2; ++bj) {
                    const f32x4 v0 = acc[ai][bj][m][0], v1 = acc[ai][bj][m][1];
                    s += (v0[0] * v0[0] + v0[1] * v0[1]) + (v0[2] * v0[2] + v0[3] * v0[3]) + (v1[0] * v1[0] + v1[1] * v1[1]) + (v1[2] * v1[2] + v1[3] * v1[3]);
                    u32x4 w; w.x = cvt_pk_bf16(v0[0], v0[1]); w.y = cvt_pk_bf16(v0[2], v0[3]); w.z = cvt_pk_bf16(v1[0], v1[1]); w.w = cvt_pk_bf16(v1[2], v1[3]);
                    *(u32x4*)(rowp + bj * 128) = w;
                }
                s += __shfl_xor(s, 16); s += __shfl_xor(s, 32);
                if (fq == 0) SS[(size_t)row * 16 + u.pn * 4 + wc] = s;
            }
    }
};
struct EpiSwiGLU {
    static constexpr bool PERM = true, AFTER_DRAIN = false;
    bf16_t* H;
    __device__ __forceinline__ void operator()(const f32x4 (&acc)[2][2][4][2], const Unit& u, int wr, int wc, int fr, int fq) const {
        const int row0 = u.pm * 256 + wr * 64 + fr, col0 = u.pn * 128 + wc * 32 + 8 * fq;
#pragma unroll
        for (int ai = 0; ai < 2; ++ai)
#pragma unroll
            for (int m = 0; m < 4; ++m) {
                const int row = row0 + ai * 128 + m * 16;
                const f32x4 g0 = acc[ai][0][m][0], g1 = acc[ai][0][m][1], u0 = acc[ai][1][m][0], u1 = acc[ai][1][m][1];
                f32x4 h0, h1;
#pragma unroll
                for (int j = 0; j < 4; ++j) { h0[j] = silu_f(g0[j]) * u0[j]; h1[j] = silu_f(g1[j]) * u1[j]; }
                u32x4 w; w.x = cvt_pk_bf16(h0[0], h0[1]); w.y = cvt_pk_bf16(h0[2], h0[3]); w.z = cvt_pk_bf16(h1[0], h1[1]); w.w = cvt_pk_bf16(h1[2], h1[3]);
                *(u32x4*)(H + (size_t)row * DFF + col0) = w;
            }
    }
};

template <class RowMap>
__device__ __forceinline__ void transpose_item(const float* W, int N, int k0, int n0, const float* kscale, bf16_t* WT, int K, RowMap rowmap, LAS float* scr, int lane) {
    float wv[32];
#pragma unroll
    for (int i = 0; i < 32; ++i) wv[i] = W[(size_t)(k0 + 2 * i + (lane >> 5)) * N + n0 + (lane & 31)];
#pragma unroll
    for (int i = 0; i < 32; ++i) { const int kk = 2 * i + (lane >> 5); float w = wv[i]; if (kscale) w *= kscale[k0 + kk]; scr[kk * 33 + (lane & 31)] = w; }
    LDS_WAIT();
    const int c = lane & 7;
#pragma unroll
    for (int j = 0; j < 4; ++j) { const int n = (lane >> 3) + 8 * j; const LAS float* s = scr + (8 * c) * 33 + n;
        u32x4 o; o.x = pk2(s[0 * 33], s[1 * 33]); o.y = pk2(s[2 * 33], s[3 * 33]); o.z = pk2(s[4 * 33], s[5 * 33]); o.w = pk2(s[6 * 33], s[7 * 33]);
        *(u32x4*)(WT + (size_t)rowmap(n0 + n) * K + k0 + 8 * c) = o; }
    LDS_WAIT();
}
struct RowId { __device__ __forceinline__ int operator()(int n) const { return n; } };
struct RowGU { int half; __device__ __forceinline__ int operator()(int n) const { return (n >> 7) * 256 + half * 128 + (n & 127); } };

struct Params {
    const float* xp; const float* xs; const float* w_in; const float* w_out; const float* lb_fwd; const float* lb_bwd; const float* g_hgrn;
    const float* g_pre_mix; const float* g_post_mix; const float* g_pre_ffn; const float* g_post_ffn; const float* w_gate; const float* w_up; const float* w_down;
    float* out; unsigned char* ws;
};
__device__ __forceinline__ const float* xrow_ptr(const Params& p, int row) { return row < ROWS_P ? p.xp + (size_t)row * DM : p.xs + (size_t)(row - ROWS_P) * DM; }

__device__ __forceinline__ void p0_prologue(const Params& p, LAS unsigned char* lds, int gw, int ngw, int wave, int lane) {
    unsigned char* dob = (unsigned char*)p.out;
    bf16_t* WIN = (bf16_t*)(dob + DO_WIN); bf16_t* WOUT = (bf16_t*)(dob + DO_WOUT); float* rope = (float*)(dob + DO_ROPE); bf16_t* XN = (bf16_t*)(dob + DO_XN);
    LAS float* scr = (LAS float*)(lds + wave * 16384);
    constexpr int I_IN = 16 * 128, I_OUT = 16 * 32;
    for (int it = gw; it < I_IN + I_OUT; it += ngw) {
        if (it < I_IN) transpose_item(p.w_in, NIN, 64 * (it / 128), 32 * (it % 128), p.g_pre_mix, WIN, DM, RowId{}, scr, lane);
        else { const int r = it - I_IN; transpose_item(p.w_out, DM, 64 * (r / 32), 32 * (r % 32), nullptr, WOUT, DM, RowId{}, scr, lane); }
    }
    {
        const int gt = gw * 64 + lane, ngt = ngw * 64;
        for (int e = gt; e < 16384 * 8; e += ngt) {
            const int pos = e >> 3, i = e & 7;
            const double rv = i == 0 ? 0.15915494309189535 : i == 1 ? 0.03086376340470123 : i == 2 ? 0.005985185712713705 : i == 3 ? 0.001160663641240061
                            : i == 4 ? 0.00022507907903927653 : i == 5 ? 4.364795279280289e-05 : i == 6 ? 8.464330808241401e-06 : 1.6414262627950345e-06;
            double a = (double)pos * rv; a -= floor(a);
            const float af = (float)a;
            rope[2 * e] = __builtin_amdgcn_cosf(af); rope[2 * e + 1] = __builtin_amdgcn_sinf(af);
        }
    }
    for (int m0 = gw * 4; m0 < T_; m0 += ngw * 4) {
        f32x4 v[4][4]; float s[4];
#pragma unroll
        for (int k = 0; k < 4; ++k) { const f32x4* xr = (const f32x4*)xrow_ptr(p, m0 + k) + lane;
#pragma unroll
            for (int j = 0; j < 4; ++j) v[k][j] = __builtin_nontemporal_load(&xr[64 * j]); }
#pragma unroll
        for (int k = 0; k < 4; ++k) { s[k] = 0.f;
#pragma unroll
            for (int j = 0; j < 4; ++j) s[k] += (v[k][j][0] * v[k][j][0] + v[k][j][1] * v[k][j][1]) + (v[k][j][2] * v[k][j][2] + v[k][j][3] * v[k][j][3]); }
#pragma unroll
        for (int k = 0; k < 4; ++k) {
            const float rstd = rsqrtf(wave_sum(s[k]) * (1.f / DM) + EPS);
            u32x2v* o8 = (u32x2v*)(XN + (size_t)(m0 + k) * DM) + lane;
#pragma unroll
            for (int j = 0; j < 4; ++j) { u32x2v w; w.x = cvt_pk_bf16(v[k][j][0] * rstd, v[k][j][1] * rstd); w.y = cvt_pk_bf16(v[k][j][2] * rstd, v[k][j][3] * rstd); __builtin_nontemporal_store(w, &o8[64 * j]); }
        }
    }
}

namespace at {
typedef short bf16x8 __attribute__((ext_vector_type(8)));
typedef short s16x4 __attribute__((ext_vector_type(4)));
constexpr int OS = 68;
constexpr int L_OUT = 0, L_L = 272 * OS * 4, L_VS = L_L + 1024, VS_STRIDE = 144, VS_WAVE = 32 * VS_STRIDE, L_END = L_VS + 8 * VS_WAVE;
static_assert(L_END <= LDS_BYTES, "attention LDS map");

__device__ __forceinline__ void wave_tile(const bf16_t* XBp, LAS unsigned char* lds, int w, int lane, int base, int S, int P0, int h, int idx) {
    const int n = lane & 15, quad = lane >> 4;
    const int br = idx >> 4, sub = idx & 15;
    const int dsh = 2 * br, dil = 1 << dsh;
    const int r = br == 0 ? 0 : (br == 1 ? (sub & 3) : sub);
    const int mt = br == 0 ? sub : (br == 1 ? (sub >> 2) : 0);
    const int Lsub = S >> dsh, m0 = (P0 >> dsh) + 16 * mt;
    const bf16_t* Qb = XBp + ((size_t)h * T_ + base) * 64;
    const bf16_t* Kb = Qb + (size_t)T_ * 512, * Vb = Kb + (size_t)T_ * 512;
    const int sh16 = (S == 16384) ? 10 : 8;
#define AT_ROW(pos) ((((pos) & 15) << sh16) + ((pos) >> 4))
    bf16x8 qf[2];
    { const int pq = (m0 + n) * dil + r; const bf16_t* qp = Qb + (size_t)AT_ROW(pq) * 64 + 8 * quad; qf[0] = *(const bf16x8*)qp; qf[1] = *(const bf16x8*)(qp + 32); }
    bf16x8 kf[9][2];
#pragma unroll
    for (int kt = 0; kt < 9; ++kt) {
        int mk = m0 - 64 + 16 * kt + n; mk = mk < 0 ? 0 : (mk >= Lsub ? Lsub - 1 : mk);
        const int pk = mk * dil + r;
        const bf16_t* kp = Kb + (size_t)AT_ROW(pk) * 64 + 8 * quad; kf[kt][0] = *(const bf16x8*)kp; kf[kt][1] = *(const bf16x8*)(kp + 32);
    }
    u32x4 vr[5][4];
#pragma unroll
    for (int t = 0; t < 5; ++t)
#pragma unroll
        for (int e = 0; e < 4; ++e) {
            const int id = lane + 64 * e, rho = id >> 3, ch = id & 7;
            int mk = m0 - 64 + 32 * t + rho; mk = mk < 0 ? 0 : (mk >= Lsub ? Lsub - 1 : mk);
            const int pv = mk * dil + r;
            vr[t][e] = *(const u32x4*)(Vb + (size_t)AT_ROW(pv) * 64 + 8 * ch);
        }
    unsigned pk[10][2];
    float lsum = 0.f;
#pragma unroll
    for (int kt = 0; kt < 9; ++kt) {
        f32x4 sc = {0.f, 0.f, 0.f, 0.f};
        sc = __builtin_amdgcn_mfma_f32_16x16x32_bf16(kf[kt][0], qf[0], sc, 0, 0, 0);
        sc = __builtin_amdgcn_mfma_f32_16x16x32_bf16(kf[kt][1], qf[1], sc, 0, 0, 0);
        float pv[4];
#pragma unroll
        for (int j = 0; j < 4; ++j) {
            const int ko = 16 * kt + 4 * quad + j, mk = m0 - 64 + ko;
            const bool valid = (ko >= n) && (ko <= n + 128) && (mk >= 0) && (mk < Lsub);
            const float e = __expf(fminf(sc[j], 80.f));
            pv[j] = valid ? e : 0.f; lsum += pv[j];
        }
        pk[kt][0] = cvt_pk_bf16(pv[0], pv[1]); pk[kt][1] = cvt_pk_bf16(pv[2], pv[3]);
    }
    pk[9][0] = 0u; pk[9][1] = 0u;
    lsum += __shfl_xor(lsum, 16); lsum += __shfl_xor(lsum, 32);
    f32x4 ot[4];
#pragma unroll
    for (int dt = 0; dt < 4; ++dt) ot[dt] = (f32x4){0.f, 0.f, 0.f, 0.f};
    LAS unsigned char* vs = lds + L_VS + w * VS_WAVE;
#pragma unroll
    for (int t = 0; t < 5; ++t) {
#pragma unroll
        for (int e = 0; e < 4; ++e) { const int id = lane + 64 * e, rho = id >> 3, ch = id & 7; *(LAS u32x4*)(vs + rho * VS_STRIDE + ch * 16) = vr[t][e]; }
        bf16x8 pf; { u32x4 pw = {pk[2 * t][0], pk[2 * t][1], pk[2 * t + 1][0], pk[2 * t + 1][1]}; pf = __builtin_bit_cast(bf16x8, pw); }
#pragma unroll
        for (int dt = 0; dt < 4; ++dt) {
            const int q = (lane & 15) >> 2, pp = lane & 3;
            const s16x4 lo = __builtin_amdgcn_ds_read_tr16_b64_v4i16((LAS s16x4*)(vs + (4 * quad + q) * VS_STRIDE + (16 * dt + 4 * pp) * 2));
            const s16x4 hi = __builtin_amdgcn_ds_read_tr16_b64_v4i16((LAS s16x4*)(vs + (16 + 4 * quad + q) * VS_STRIDE + (16 * dt + 4 * pp) * 2));
            const bf16x8 vf = {lo[0], lo[1], lo[2], lo[3], hi[0], hi[1], hi[2], hi[3]};
            ot[dt] = __builtin_amdgcn_mfma_f32_16x16x32_bf16(vf, pf, ot[dt], 0, 0, 0);
        }
    }
    const int posl = ((m0 + n) * dil + r) - P0;
    LAS float* op = (LAS float*)(lds + L_OUT) + (posl + (posl >> 4)) * OS + 4 * quad;
    LAS float* lp = (LAS float*)(lds + L_L) + posl;
    if (br == 0) {
#pragma unroll
        for (int dt = 0; dt < 4; ++dt) *(LAS f32x4*)(op + 16 * dt) = ot[dt];
        if (quad == 0) *lp = lsum;
    } else {
        f32x4 old[4];
#pragma unroll
        for (int dt = 0; dt < 4; ++dt) old[dt] = *(const LAS f32x4*)(op + 16 * dt);
        const float lo = *lp;
#pragma unroll
        for (int dt = 0; dt < 4; ++dt) *(LAS f32x4*)(op + 16 * dt) = old[dt] + ot[dt];
        if (quad == 0) *lp = lo + lsum;
    }
}
__device__ __forceinline__ void attn_phase(const bf16_t* XBp, bf16_t* MIXIN, LAS unsigned char* lds, int blk, int G) {
    const int tid = otid(), lane = tid & 63, w = __builtin_amdgcn_readfirstlane(tid >> 6);
    __syncthreads();
    for (int u = blk; u < 2048; u += G) {
        int grp = u >> 3, h = u & 7;
        if (G == 256) { const int x = u & 7, j = (u >> 3) & 31, e8 = u >> 8; h = j & 7; grp = 32 * x + 4 * e8 + (j >> 3); }
        const int row0 = grp * 256;
        const int base = row0 < ROWS_P ? (row0 & ~16383) : (ROWS_P + ((row0 - ROWS_P) & ~4095)), S = row0 < ROWS_P ? 16384 : 4096, P0 = row0 - base;
        for (int br = 0; br < 3; ++br) {
            wave_tile(XBp, lds, w, lane, base, S, P0, h, 16 * br + w);
            wave_tile(XBp, lds, w, lane, base, S, P0, h, 16 * br + w + 8);
            __syncthreads();
        }
        {
            const int pos = tid >> 1, half = tid & 1;
            const LAS float* op = (const LAS float*)(lds + L_OUT) + (pos + (pos >> 4)) * OS + 32 * half;
            const float inv = 1.f / ((const LAS float*)(lds + L_L))[pos];
            unsigned wv[16];
#pragma unroll
            for (int d = 0; d < 16; ++d) wv[d] = cvt_pk_bf16(op[2 * d] * inv, op[2 * d + 1] * inv);
            u32x4* gp = (u32x4*)(MIXIN + (size_t)(row0 + pos) * DM + h * 64 + 32 * half);
#pragma unroll
            for (int c = 0; c < 4; ++c) gp[c] = (u32x4){wv[4 * c], wv[4 * c + 1], wv[4 * c + 2], wv[4 * c + 3]};
        }
        __syncthreads();
    }
}
}

namespace hg {
typedef short bf16x8 __attribute__((ext_vector_type(8)));
constexpr int SEG = 1024, NCH = 16, NITEM = 512;
constexpr int RS = 272, TS = 144;
constexpr int L_QT = 0, L_QR = 17408, L_KR = 34816, L_K0 = 52224, L_Q4 = 56576, L_KT = 60928, L_VT = 79360, L_ST = 97792, L_AB = 132608, L_TOT = 141824, L_BV = 143872, L_END = 144384;
static_assert(L_END <= LDS_BYTES, "hgrn LDS map");
constexpr size_t DO_STATE = 140 * MiB, DO_DEC = 172 * MiB, DO_OB = 176 * MiB, DO_INIT = 240 * MiB;

__device__ __forceinline__ int phys_row(int g, int dir, int lt) { return dir ? (g * SEG + SEG - 1 - lt) : (g * SEG + lt); }
__device__ __forceinline__ unsigned short bf1(float x) { __bf16 b = (__bf16)x; return __builtin_bit_cast(unsigned short, b); }
__device__ __forceinline__ bf16x8 ldfrag(LAS unsigned char* lds, int off, int stride, int row0, int kel, int lane) {
    return *(const LAS bf16x8*)(lds + off + (row0 + (lane & 15)) * stride + (kel + 8 * (lane >> 4)) * 2);
}
template <bool FULL>
__device__ __forceinline__ void load_raw(const bf16_t* U, int g, int dir, int ch, int i, int zcol, int qcol, int vcol, unsigned short (&rz)[16], unsigned short (&rq)[16], unsigned short (&rv)[16]) {
#pragma unroll
    for (int r = 0; r < 16; ++r) {
        const bf16_t* pr = U + (size_t)phys_row(g, dir, 64 * ch + 16 * i + r) * UP;
        rz[r] = pr[zcol]; if (FULL) rq[r] = pr[qcol]; rv[r] = pr[vcol];
    }
}
template <bool FULL>
__device__ __forceinline__ void prep(LAS unsigned char* lds, int i, int c, float lb, const unsigned short (&rz)[16], const unsigned short (&rq)[16], const unsigned short (&rv)[16], float& bdec) {
    float f[16], e1[16], qs[16];
    float run = 1.f;
#pragma unroll
    for (int r = 0; r < 16; ++r) {
        const float fr = lb + (1.f - lb) * sigmoid_f(bf2f(rz[r]));
        f[r] = fr; run *= fr; e1[r] = run;
        if (FULL) qs[r] = silu_f(bf2f(rq[r])); else qs[r] = 0.f;
    }
    ((LAS float*)(lds + L_TOT))[i * 128 + c] = run;
    {
        u32x4 a, b;
        a.x = rv[0] | ((unsigned)rv[1] << 16); a.y = rv[2] | ((unsigned)rv[3] << 16); a.z = rv[4] | ((unsigned)rv[5] << 16); a.w = rv[6] | ((unsigned)rv[7] << 16);
        b.x = rv[8] | ((unsigned)rv[9] << 16); b.y = rv[10] | ((unsigned)rv[11] << 16); b.z = rv[12] | ((unsigned)rv[13] << 16); b.w = rv[14] | ((unsigned)rv[15] << 16);
        LAS u32x4* vp = (LAS u32x4*)(lds + L_VT + c * TS + 32 * i); vp[0] = a; vp[1] = b;
    }
    __syncthreads();
    const LAS float* tp = (const LAS float*)(lds + L_TOT) + c;
    const float p0 = tp[0], p1 = tp[128], p2 = tp[256], p3 = tp[384];
    const float cQT = i == 0 ? 1.f : i == 1 ? p0 : i == 2 ? p0 * p1 : p0 * p1 * p2;
    const float cKT = i == 0 ? p1 * p2 * p3 : i == 1 ? p2 * p3 : i == 2 ? p3 : 1.f;
    const float cQR = i == 0 ? 1.f : i == 1 ? __builtin_amdgcn_rcpf(p1) : i == 2 ? 1.f : p2;
    const float cKR = i == 0 ? p1 : i == 1 ? 1.f : i == 2 ? __builtin_amdgcn_rcpf(p2) : 1.f;
    const float cK0 = __builtin_amdgcn_rcpf(p0), cQ4 = __builtin_amdgcn_rcpf(p3);
    bdec = (p0 * p1) * (p2 * p3);
    if (i == 0) ((LAS float*)(lds + L_BV))[c] = bdec;
    unsigned short kt[16];
    float e2 = 1.f;
#pragma unroll
    for (int r = 15; r >= 0; --r) {
        const float kb = (1.f - f[r]) * e2;
        kt[r] = bf1(kb * cKT);
        if (FULL) {
            *(LAS unsigned short*)(lds + L_KR + (16 * i + r) * RS + c * 2) = bf1(kb * cKR);
            if (i == 0) *(LAS unsigned short*)(lds + L_K0 + r * RS + c * 2) = bf1(kb * cK0);
        }
        e2 *= f[r];
    }
    {
        u32x4 a, b;
        a.x = kt[0] | ((unsigned)kt[1] << 16); a.y = kt[2] | ((unsigned)kt[3] << 16); a.z = kt[4] | ((unsigned)kt[5] << 16); a.w = kt[6] | ((unsigned)kt[7] << 16);
        b.x = kt[8] | ((unsigned)kt[9] << 16); b.y = kt[10] | ((unsigned)kt[11] << 16); b.z = kt[12] | ((unsigned)kt[13] << 16); b.w = kt[14] | ((unsigned)kt[15] << 16);
        LAS u32x4* kp = (LAS u32x4*)(lds + L_KT + c * TS + 32 * i); kp[0] = a; kp[1] = b;
    }
    if (FULL) {
#pragma unroll
        for (int r = 0; r < 16; ++r) {
            const float qe = qs[r] * e1[r];
            *(LAS unsigned short*)(lds + L_QT + (16 * i + r) * RS + c * 2) = bf1(qe * cQT);
            *(LAS unsigned short*)(lds + L_QR + (16 * i + r) * RS + c * 2) = bf1(qe * cQR);
            if (i == 3) *(LAS unsigned short*)(lds + L_Q4 + r * RS + c * 2) = bf1(qe * cQ4);
        }
    }
}
__device__ __forceinline__ void state_update(LAS unsigned char* lds, f32x4 (&S)[8], int w, int gq, int lane) {
    bf16x8 ktf[2];
#pragma unroll
    for (int k2 = 0; k2 < 2; ++k2) ktf[k2] = ldfrag(lds, L_KT, TS, 16 * w, 32 * k2, lane);
    const f32x4 dk = *(const LAS f32x4*)(lds + L_BV + (16 * w + 4 * gq) * 4);
#pragma unroll
    for (int n = 0; n < 8; ++n) {
        S[n] = S[n] * dk;
#pragma unroll
        for (int k2 = 0; k2 < 2; ++k2) S[n] = __builtin_amdgcn_mfma_f32_16x16x32_bf16(ktf[k2], ldfrag(lds, L_VT, TS, 16 * n, 32 * k2, lane), S[n], 0, 0, 0);
    }
}
__device__ __forceinline__ int item_of(int lin, int G) {
    if (G != 256) return lin;
    const int x = lin & 7, j = (lin >> 3) & 31, e = lin >> 8, g = 8 * x + 2 * (j >> 3) + e, hd = j & 7;
    return g * 8 + hd;
}
__device__ __forceinline__ float lb_of(const Params& p, int dir, int col) { const float* lbr = dir ? p.lb_bwd : p.lb_fwd; return 1.f / (1.f + __expf(lbr[512 + col] - lbr[col])); }

__device__ __forceinline__ void pass1(const Params& p, const bf16_t* U, LAS unsigned char* lds, int item) {
    const int tid = otid(), lane = tid & 63, w = __builtin_amdgcn_readfirstlane(tid >> 6), i = w >> 1, c = tid & 127, gq = lane >> 4;
    const int dir = item & 1, hh = (item >> 1) & 3, g = item >> 3;
    float* STATE = (float*)((unsigned char*)p.out + DO_STATE); float* DEC = (float*)((unsigned char*)p.out + DO_DEC);
    const float lb = lb_of(p, dir, hh * 128 + c);
    const int zcol = (dir ? UC_ZB : UC_ZF) + hh * 128 + c, qcol = UC_QH + hh * 128 + c, vcol = UC_IH + hh * 128 + c;
    f32x4 S[8];
#pragma unroll
    for (int n = 0; n < 8; ++n) S[n] = (f32x4){0.f, 0.f, 0.f, 0.f};
    float dtot = 1.f;
    unsigned short rz[16], rq[16], rv[16];
    load_raw<false>(U, g, dir, 0, i, zcol, qcol, vcol, rz, rq, rv);
    for (int ch = 0; ch < NCH; ++ch) {
        float bdec;
        prep<false>(lds, i, c, lb, rz, rq, rv, bdec);
        dtot *= bdec;
        if (ch + 1 < NCH) load_raw<false>(U, g, dir, ch + 1, i, zcol, qcol, vcol, rz, rq, rv);
        __syncthreads();
        state_update(lds, S, w, gq, lane);
        __syncthreads();
    }
    float* sp = STATE + (size_t)item * 16384 + (16 * w + 4 * gq) * 128 + (lane & 15);
#pragma unroll
    for (int n = 0; n < 8; ++n)
#pragma unroll
        for (int jj = 0; jj < 4; ++jj) sp[jj * 128 + 16 * n] = S[n][jj];
    if (i == 0) DEC[item * 128 + c] = dtot;
}
__device__ __forceinline__ void scan(const Params& p, int gt, int ngt) {
    const float* STATE = (const float*)((unsigned char*)p.out + DO_STATE); const float* DEC = (const float*)((unsigned char*)p.out + DO_DEC);
    bf16_t* INIT = (bf16_t*)((unsigned char*)p.out + DO_INIT);
    for (int e = gt; e < 80 * 4096; e += ngt) {
        const int chain = e >> 12, q4 = e & 4095, k = q4 >> 5;
        const int dir = chain & 1, hh = (chain >> 1) & 3, sb = chain >> 3;
        const int nseg = sb < 2 ? 16 : 4, g0 = sb < 2 ? sb * 16 : 32 + (sb - 2) * 4;
        f32x4 s = {0.f, 0.f, 0.f, 0.f};
        for (int j = 0; j < nseg; ++j) {
            const int g = dir ? (g0 + nseg - 1 - j) : (g0 + j), item = (g * 4 + hh) * 2 + dir;
            const f32x4 en = *((const f32x4*)(STATE + (size_t)item * 16384) + q4);
            u32x2v wv; wv.x = cvt_pk_bf16(s[0], s[1]); wv.y = cvt_pk_bf16(s[2], s[3]);
            *((u32x2v*)(INIT + (size_t)item * 16384) + q4) = wv;
            s = s * DEC[item * 128 + k] + en;
        }
    }
}
__device__ __forceinline__ void pass2(const Params& p, const bf16_t* U, bf16_t* MIXIN, LAS unsigned char* lds, int item) {
    const int tid = otid(), lane = tid & 63, w = __builtin_amdgcn_readfirstlane(tid >> 6), i = w >> 1, c = tid & 127, gq = lane >> 4;
    const int dir = item & 1, hh = (item >> 1) & 3, g = item >> 3;
    const bf16_t* INIT = (const bf16_t*)((unsigned char*)p.out + DO_INIT);
    bf16_t* OUT = dir ? (bf16_t*)((unsigned char*)p.out + DO_OB) + hh * 128 : MIXIN + 512 + hh * 128;
    const int opitch = dir ? 512 : DM;
    const float lb = lb_of(p, dir, hh * 128 + c);
    const int zcol = (dir ? UC_ZB : UC_ZF) + hh * 128 + c, qcol = UC_QH + hh * 128 + c, vcol = UC_IH + hh * 128 + c;
    for (int idx = tid; idx < 64 * TS / 4; idx += 512) ((LAS unsigned*)(lds + L_AB))[idx] = 0u;
    f32x4 S[8];
    {
        const bf16_t* sp = INIT + (size_t)item * 16384 + (16 * w + 4 * gq) * 128 + (lane & 15);
#pragma unroll
        for (int n = 0; n < 8; ++n)
#pragma unroll
            for (int jj = 0; jj < 4; ++jj) S[n][jj] = bf2f(sp[jj * 128 + 16 * n]);
    }
#define HG_ST_WRITE() do { _Pragma("unroll") for (int n = 0; n < 8; ++n) { u32x2v wv; wv.x = cvt_pk_bf16(S[n][0], S[n][1]); wv.y = cvt_pk_bf16(S[n][2], S[n][3]); \
        *(LAS u32x2v*)(lds + L_ST + (16 * n + (lane & 15)) * RS + (16 * w + 4 * gq) * 2) = wv; } } while (0)
    HG_ST_WRITE();
    unsigned short rz[16], rq[16], rv[16];
    load_raw<true>(U, g, dir, 0, i, zcol, qcol, vcol, rz, rq, rv);
    for (int ch = 0; ch < NCH; ++ch) {
        float bdec;
        prep<true>(lds, i, c, lb, rz, rq, rv, bdec);
        if (ch + 1 < NCH) load_raw<true>(U, g, dir, ch + 1, i, zcol, qcol, vcol, rz, rq, rv);
        __syncthreads();
        for (int bi = w; bi < 10; bi += 8) {
            const int ti = bi >= 6 ? 3 : bi >= 3 ? 2 : bi >= 1 ? 1 : 0, tj = bi - ti * (ti + 1) / 2;
            const int qoff = (bi == 9) ? L_Q4 : L_QR + 16 * ti * RS, koff = (bi == 0) ? L_K0 : L_KR + 16 * tj * RS;
            f32x4 a = {0.f, 0.f, 0.f, 0.f};
#pragma unroll
            for (int ks = 0; ks < 4; ++ks) a = __builtin_amdgcn_mfma_f32_16x16x32_bf16(ldfrag(lds, qoff, RS, 0, 32 * ks, lane), ldfrag(lds, koff, RS, 0, 32 * ks, lane), a, 0, 0, 0);
#pragma unroll
            for (int jj = 0; jj < 4; ++jj) {
                float val = a[jj];
                if (ti == tj && (lane & 15) > 4 * gq + jj) val = 0.f;
                *(LAS unsigned short*)(lds + L_AB + (16 * ti + 4 * gq + jj) * TS + (16 * tj + (lane & 15)) * 2) = bf1(val);
            }
        }
        __syncthreads();
        {
            bf16x8 stf[4], vtf[2];
#pragma unroll
            for (int ks = 0; ks < 4; ++ks) stf[ks] = ldfrag(lds, L_ST, RS, 16 * w, 32 * ks, lane);
#pragma unroll
            for (int k2 = 0; k2 < 2; ++k2) vtf[k2] = ldfrag(lds, L_VT, TS, 16 * w, 32 * k2, lane);
#pragma unroll
            for (int mt = 0; mt < 4; ++mt) {
                f32x4 o = {0.f, 0.f, 0.f, 0.f};
#pragma unroll
                for (int ks = 0; ks < 4; ++ks) o = __builtin_amdgcn_mfma_f32_16x16x32_bf16(ldfrag(lds, L_QT, RS, 16 * mt, 32 * ks, lane), stf[ks], o, 0, 0, 0);
#pragma unroll
                for (int k2 = 0; k2 < 2; ++k2) o = __builtin_amdgcn_mfma_f32_16x16x32_bf16(ldfrag(lds, L_AB, TS, 16 * mt, 32 * k2, lane), vtf[k2], o, 0, 0, 0);
#pragma unroll
                for (int jj = 0; jj < 4; ++jj) {
                    const int row = phys_row(g, dir, 64 * ch + 16 * mt + 4 * gq + jj);
                    OUT[(size_t)row * opitch + 16 * w + (lane & 15)] = bf1(o[jj]);
                }
            }
        }
        state_update(lds, S, w, gq, lane);
        __syncthreads();
        HG_ST_WRITE();
    }
#undef HG_ST_WRITE
}
}

__device__ __forceinline__ void hg_finalize(const Params& p, const bf16_t* U, bf16_t* MIXIN, int blk, int G, int wave, int lane) {
    const float gn0 = p.g_hgrn[2 * lane], gn1 = p.g_hgrn[2 * lane + 1];
    const bf16_t* OB = (const bf16_t*)((const unsigned char*)p.out + hg::DO_OB);
    const int gw = blk * 8 + wave, ngw = G * 8;
    for (int r0 = gw * 4; r0 < T_; r0 += ngw * 4) {
        unsigned wm[4][4], wg[4][4], wo[4][4];
#pragma unroll
        for (int k = 0; k < 4; ++k)
#pragma unroll
            for (int hh = 0; hh < 4; ++hh) {
                const int row = r0 + k;
                wm[k][hh] = *((const unsigned*)(MIXIN + (size_t)row * DM + 512 + hh * 128) + lane);
                wg[k][hh] = *((const unsigned*)(U + (size_t)row * UP + UC_GH + hh * 128) + lane);
                wo[k][hh] = *((const unsigned*)(OB + (size_t)row * 512 + hh * 128) + lane);
            }
#pragma unroll
        for (int k = 0; k < 4; ++k)
#pragma unroll
            for (int hh = 0; hh < 4; ++hh) {
                const unsigned w = wm[k][hh], gw2 = wg[k][hh], wb = wo[k][hh];
                const float o0 = __uint_as_float(w << 16) + __uint_as_float(wb << 16), o1 = __uint_as_float(w & 0xffff0000u) + __uint_as_float(wb & 0xffff0000u);
                const float g0 = __uint_as_float(gw2 << 16), g1 = __uint_as_float(gw2 & 0xffff0000u);
                const float rs = rsqrtf(wave_sum(o0 * o0 + o1 * o1) * (1.f / 128.f) + EPS);
                *((unsigned*)(MIXIN + (size_t)(r0 + k) * DM + 512 + hh * 128) + lane) = cvt_pk_bf16(o0 * rs * gn0 * silu_f(g0), o1 * rs * gn1 * silu_f(g1));
            }
    }
}

__device__ __forceinline__ void p6_rows(const Params& p, LAS unsigned char* lds, int gw, int ngw, int wave, int lane) {
    bf16_t* WGU = (bf16_t*)(p.ws + WS_WGU); bf16_t* WDN = (bf16_t*)(p.ws + WS_WDN);
    LAS float* scr = (LAS float*)(lds + wave * 16384);
    constexpr int I_G = 16 * 88, I_D = 44 * 32;
    for (int it = gw; it < 2 * I_G + I_D; it += ngw) {
        if (it < I_G) transpose_item(p.w_gate, DFF, 64 * (it / 88), 32 * (it % 88), p.g_pre_ffn, WGU, DM, RowGU{0}, scr, lane);
        else if (it < 2 * I_G) { const int r = it - I_G; transpose_item(p.w_up, DFF, 64 * (r / 88), 32 * (r % 88), p.g_pre_ffn, WGU, DM, RowGU{1}, scr, lane); }
        else { const int r = it - 2 * I_G; transpose_item(p.w_down, DM, 64 * (r / 32), 32 * (r % 32), nullptr, WDN, DFF, RowId{}, scr, lane); }
    }
    bf16_t* MIX = (bf16_t*)(p.ws + WS_MIX); const float* SS = (const float*)(p.ws + WS_SS1);
    f32x4 gp[4];
#pragma unroll
    for (int j = 0; j < 4; ++j) gp[j] = ((const f32x4*)p.g_post_mix)[lane + 64 * j];
    for (int m0 = gw * 4; m0 < T_; m0 += ngw * 4) {
        f32x4 xv[4][4]; u32x2v mw[4][4]; float r1[4];
#pragma unroll
        for (int k = 0; k < 4; ++k) {
            const int m = m0 + k;
            const f32x4* ssp = (const f32x4*)(SS + (size_t)m * 16);
            const f32x4 a = ssp[0], b = ssp[1], c = ssp[2], d = ssp[3];
            const float ss = ((a[0] + a[1]) + (a[2] + a[3])) + ((b[0] + b[1]) + (b[2] + b[3])) + ((c[0] + c[1]) + (c[2] + c[3])) + ((d[0] + d[1]) + (d[2] + d[3]));
            r1[k] = rsqrtf(ss * (1.f / DM) + EPS);
            const f32x4* xr = (const f32x4*)xrow_ptr(p, m) + lane;
            const u32x2v* mx = (const u32x2v*)(MIX + (size_t)m * DM) + lane;
#pragma unroll
            for (int jj = 0; jj < 4; ++jj) { xv[k][jj] = __builtin_nontemporal_load(&xr[64 * jj]); mw[k][jj] = __builtin_nontemporal_load(&mx[64 * jj]); }
        }
        float s2[4];
#pragma unroll
        for (int k = 0; k < 4; ++k) {
            f32x4* xo = (f32x4*)(p.out + (size_t)(m0 + k) * DM) + lane;
            s2[k] = 0.f;
#pragma unroll
            for (int jj = 0; jj < 4; ++jj) {
                const u32x2v w = mw[k][jj];
                f32x4 mv = {__uint_as_float(w.x << 16), __uint_as_float(w.x & 0xffff0000u), __uint_as_float(w.y << 16), __uint_as_float(w.y & 0xffff0000u)};
                xv[k][jj] = xv[k][jj] + mv * r1[k] * gp[jj];
                s2[k] += (xv[k][jj][0] * xv[k][jj][0] + xv[k][jj][1] * xv[k][jj][1]) + (xv[k][jj][2] * xv[k][jj][2] + xv[k][jj][3] * xv[k][jj][3]);
                __builtin_nontemporal_store(xv[k][jj], &xo[64 * jj]);
            }
        }
#pragma unroll
        for (int k = 0; k < 4; ++k) {
            const float r2 = rsqrtf(wave_sum(s2[k]) * (1.f / DM) + EPS);
            u32x2v* mx = (u32x2v*)(MIX + (size_t)(m0 + k) * DM) + lane;
#pragma unroll
            for (int jj = 0; jj < 4; ++jj) { u32x2v w; w.x = cvt_pk_bf16(xv[k][jj][0] * r2, xv[k][jj][1] * r2); w.y = cvt_pk_bf16(xv[k][jj][2] * r2, xv[k][jj][3] * r2); __builtin_nontemporal_store(w, &mx[64 * jj]); }
        }
    }
}
__device__ __forceinline__ void p9_rows(const Params& p, int gw, int ngw, int lane) {
    const bf16_t* FF = (const bf16_t*)(p.ws + WS_MIX); const float* SS = (const float*)(p.ws + WS_SS2);
    f32x4 gp[4];
#pragma unroll
    for (int j = 0; j < 4; ++j) gp[j] = ((const f32x4*)p.g_post_ffn)[lane + 64 * j];
    for (int m0 = gw * 4; m0 < T_; m0 += ngw * 4) {
        f32x4 xv[4][4]; u32x2v fw[4][4]; float r1[4];
#pragma unroll
        for (int k = 0; k < 4; ++k) {
            const int m = m0 + k;
            const f32x4* ssp = (const f32x4*)(SS + (size_t)m * 16);
            const f32x4 a = ssp[0], b = ssp[1], c = ssp[2], d = ssp[3];
            const float ss = ((a[0] + a[1]) + (a[2] + a[3])) + ((b[0] + b[1]) + (b[2] + b[3])) + ((c[0] + c[1]) + (c[2] + c[3])) + ((d[0] + d[1]) + (d[2] + d[3]));
            r1[k] = rsqrtf(ss * (1.f / DM) + EPS);
            const u32x2v* fx = (const u32x2v*)(FF + (size_t)m * DM) + lane;
            const f32x4* xo = (const f32x4*)(p.out + (size_t)m * DM) + lane;
#pragma unroll
            for (int jj = 0; jj < 4; ++jj) { xv[k][jj] = __builtin_nontemporal_load(&xo[64 * jj]); fw[k][jj] = __builtin_nontemporal_load(&fx[64 * jj]); }
        }
#pragma unroll
        for (int k = 0; k < 4; ++k) {
            f32x4* xo = (f32x4*)(p.out + (size_t)(m0 + k) * DM) + lane;
#pragma unroll
            for (int jj = 0; jj < 4; ++jj) {
                const u32x2v w = fw[k][jj];
                f32x4 fv = {__uint_as_float(w.x << 16), __uint_as_float(w.x & 0xffff0000u), __uint_as_float(w.y << 16), __uint_as_float(w.y & 0xffff0000u)};
                __builtin_nontemporal_store(xv[k][jj] + fv * r1[k] * gp[jj], &xo[64 * jj]);
            }
        }
    }
}

__global__ void __launch_bounds__(512, 2) fwd_megakernel(Params p) {
    extern __shared__ __attribute__((aligned(16))) unsigned char lds_raw[];
    LAS unsigned char* lds = (LAS unsigned char*)lds_raw;
    cg::grid_group grid = cg::this_grid();
#define GSYNC() do { asm volatile("s_waitcnt vmcnt(0)" ::: "memory"); grid.sync(); \
        if (wave == 0) { __builtin_amdgcn_fence(__ATOMIC_ACQUIRE, "agent"); asm volatile("s_waitcnt vmcnt(0)" ::: "memory"); } __syncthreads(); } while (0)
    const int tid = otid(), lane = tid & 63, wave = __builtin_amdgcn_readfirstlane(tid >> 6);
    const int G = gridDim.x, blk = blockIdx.x;
    const int gw = blk * 8 + wave, ngw = G * 8;
    unsigned char* dob = (unsigned char*)p.out;
    bf16_t* U = (bf16_t*)(p.ws + WS_U);
    bf16_t* MIXIN = (bf16_t*)(dob + DO_MIXIN);

    volatile LAS unsigned* bst = (volatile LAS unsigned*)(lds + LDS_BYTES - 16);
    if (tid < 2) bst[tid] = 0u;
    if (blk == 0) for (int i2 = tid; i2 < 3456; i2 += 512) __hip_atomic_store(g_bar + i2, 0u, __ATOMIC_RELAXED, __HIP_MEMORY_SCOPE_AGENT);
    p0_prologue(p, lds, gw, ngw, wave, lane);
    GSYNC();
    const XcdBarrier xbar = xcd_barrier_post(g_bar, bst);
#define XSYNC() xcd_barrier(xbar)
    {
        pg8::Gemm g{(const bf16_t*)(dob + DO_XN), (const bf16_t*)(dob + DO_WIN), T_, NIN, DM}; pg8::StaticOrder S; S.init(T_, NIN, G, blk);
        EpiU E{U, (bf16_t*)(p.ws + WS_QB), (const float*)(dob + DO_ROPE)};
        pg8::gemm_phase<EpiU, pg8::StaticOrder, true, true>(lds, g, S, E);
    }
    XSYNC();
    for (int lin = blk; lin < hg::NITEM; lin += G) hg::pass1(p, U, lds, hg::item_of(lin, G));
    at::attn_phase((const bf16_t*)(p.ws + WS_QB), MIXIN, lds, blk, G);
    XSYNC();
    hg::scan(p, blk * 512 + tid, G * 512);
    XSYNC();
    for (int lin = blk; lin < hg::NITEM; lin += G) hg::pass2(p, U, MIXIN, lds, hg::item_of(lin, G));
    XSYNC();
    hg_finalize(p, U, MIXIN, blk, G, wave, lane);
    XSYNC();
    {
        pg8::Gemm g{MIXIN, (const bf16_t*)(dob + DO_WOUT), T_, DM, DM}; pg8::StaticOrder S; S.init(T_, DM, G, blk);
        EpiRowSS E{(bf16_t*)(p.ws + WS_MIX), (float*)(p.ws + WS_SS1)};
        pg8::gemm_phase<EpiRowSS, pg8::StaticOrder, true, true>(lds, g, S, E);
    }
    XSYNC();
    p6_rows(p, lds, gw, ngw, wave, lane);
    XSYNC();
    {
        pg8::Gemm g{(const bf16_t*)(p.ws + WS_MIX), (const bf16_t*)(p.ws + WS_WGU), T_, 2 * DFF, DM}; pg8::StaticOrder S; S.init(T_, 2 * DFF, G, blk);
        EpiSwiGLU E{(bf16_t*)(p.ws + WS_HFF)};
        pg8::gemm_phase<EpiSwiGLU, pg8::StaticOrder, true, true>(lds, g, S, E);
    }
    XSYNC();
    {
        pg8::Gemm g{(const bf16_t*)(p.ws + WS_HFF), (const bf16_t*)(p.ws + WS_WDN), T_, DM, DFF}; pg8::StaticOrder S; S.init(T_, DM, G, blk);
        EpiRowSS E{(bf16_t*)(p.ws + WS_MIX), (float*)(p.ws + WS_SS2)};
        pg8::gemm_phase<EpiRowSS, pg8::StaticOrder, true, true>(lds, g, S, E);
    }
    XSYNC();
    p9_rows(p, gw, ngw, lane);
}

extern "C" void kernel_launch(void* const* d_in, const int* in_sizes, int n_in, void* d_out, int out_size, void* d_ws, size_t ws_size, hipStream_t stream) {
    static int grid_blocks = 0;
    if (grid_blocks == 0) {
        int dev = 0, cus = 0, per_cu = 0;
        hipGetDevice(&dev);
        hipDeviceGetAttribute(&cus, hipDeviceAttributeMultiprocessorCount, dev);
        hipFuncSetAttribute((const void*)fwd_megakernel, hipFuncAttributeMaxDynamicSharedMemorySize, LDS_BYTES);
        hipOccupancyMaxActiveBlocksPerMultiprocessor(&per_cu, (const void*)fwd_megakernel, 512, LDS_BYTES);
        if (per_cu < 1) { fprintf(stderr, "occupancy query reports %d blocks per CU\n", per_cu); per_cu = 1; }
        if (per_cu > 1) per_cu = 1;
        grid_blocks = cus * per_cu;
        if (ws_size < 512 * MiB) fprintf(stderr, "kernel_launch: workspace %zu smaller than the 512 MiB map\n", ws_size);
    }
    Params p{};
    p.xp = (const float*)d_in[0]; p.xs = (const float*)d_in[1]; p.w_in = (const float*)d_in[2]; p.w_out = (const float*)d_in[3];
    p.lb_fwd = (const float*)d_in[4]; p.lb_bwd = (const float*)d_in[5]; p.g_hgrn = (const float*)d_in[6]; p.g_pre_mix = (const float*)d_in[7];
    p.g_post_mix = (const float*)d_in[8]; p.g_pre_ffn = (const float*)d_in[9]; p.g_post_ffn = (const float*)d_in[10];
    p.w_gate = (const float*)d_in[11]; p.w_up = (const float*)d_in[12]; p.w_down = (const float*)d_in[13];
    p.out = (float*)d_out; p.ws = (unsigned char*)d_ws;
    void* args[] = {&p};
    hipError_t e = hipLaunchCooperativeKernel((const void*)fwd_megakernel, dim3(grid_blocks), dim3(512), args, LDS_BYTES, stream);
    if (e != hipSuccess) fprintf(stderr, "cooperative launch failed: %s (grid %d)\n", hipGetErrorString(e), grid_blocks);
}
```

```cpp
#include <hip/hip_runtime.h>
#include <hip/hip_cooperative_groups.h>
#include <cstdio>
#include <cstdint>
namespace cg = cooperative_groups;
namespace pg8 {
#define PG8_LAS __attribute__((address_space(3)))
typedef unsigned short bf16_t;
typedef short bf16x8 __attribute__((ext_vector_type(8)));
typedef float f32x4 __attribute__((ext_vector_type(4)));
typedef unsigned u32x4 __attribute__((ext_vector_type(4)));
constexpr int BM = 256, BK = 64, HALF = 128, HTB = HALF * BK * 2  , STAGE_BYTES = 8 * HTB, NXCD = 8, WGM = 8;

__host__ __device__ __forceinline__ int lds_byte(int r, int c) { const int st = (r >> 4) * 2 + (c >> 5), rr = r & 15, cc = c & 31, ob = rr * 64 + cc * 2; return st * 1024 + (ob ^ (((ob >> 9) & 1) << 5)); }
__host__ __device__ __forceinline__ void stage_rc(int b, int& R, int& C) { const int st = b / 1024, sb = b % 1024, swz = sb ^ (((sb >> 9) & 1) << 5); R = (st >> 1) * 16 + swz / 64; C = (st & 1) * 32 + (swz % 64) / 2; }
__host__ __device__ __forceinline__ int perm32(int rho) { const int n = rho >> 4, i = rho & 15; return 8 * (i >> 2) + 4 * n + (i & 3); }

struct Unit { int pm, pn; };
struct Gemm { const bf16_t* A; const bf16_t* Bt; int M, N, K; };

struct StaticOrder {
    int nM, nN, nwg, G, c;
    __host__ __device__ void init(int M, int N, int G_, int c_) { nM = M / BM; nN = N / BM; nwg = nM * nN; G = G_; c = c_; }
    __host__ __device__ bool next(int i, Unit& u) const {
        const long L = (long)i * G + c; if (L >= nwg) return false;
        int wgid = (int)L; { const int q = nwg / NXCD, r = nwg % NXCD, xcd = wgid % NXCD, off = wgid / NXCD; wgid = (xcd < r ? xcd * (q + 1) : r * (q + 1) + (xcd - r) * q) + off; }
        const int nig = WGM * nN, gid = wgid / nig, fm = gid * WGM, gsz = (nM - fm) < WGM ? (nM - fm) : WGM;
        u.pm = fm + ((wgid % nig) % gsz); u.pn = (wgid % nig) / gsz; return true;
    }
    __device__ __forceinline__ void a_ready(const Unit&) const {}
    __device__ __forceinline__ void done(const Unit&) const {}
};

typedef __bf16 bf16x2_t __attribute__((ext_vector_type(2)));
typedef float f32x2_t __attribute__((ext_vector_type(2)));
__device__ __forceinline__ unsigned cvt_pk_bf16(float lo, float hi) { f32x2_t v = {lo, hi}; bf16x2_t b = __builtin_convertvector(v, bf16x2_t); return __builtin_bit_cast(unsigned, b); }
typedef float f32x2 __attribute__((ext_vector_type(2)));
template <class Epi, class Sched, bool ALIGN_EPI = false, bool SP2 = false>
__device__ __forceinline__ void gemm_phase(PG8_LAS unsigned char* lds, const Gemm g, const Sched& S, const Epi& E) {
    int tid; asm volatile("v_mov_b32 %0, %1" : "=v"(tid) : "v"((int)threadIdx.x));
    const int wid = __builtin_amdgcn_readfirstlane(tid >> 6), lane = tid & 63, wr = wid >> 2, wc = wid & 3, fr = lane & 15, fq = lane >> 4;
    const int K = g.K, nt = K / BK;
    unsigned voffA[2], voffB[2];
#pragma unroll
    for (int i = 0; i < 2; ++i) { int R, C; stage_rc(tid * 16 + i * 8192, R, C); const int Rb = Epi::PERM ? ((R & ~31) + perm32(R & 31)) : R;
        voffA[i] = (unsigned)(R * K + C) * 2u; voffB[i] = (unsigned)(Rb * K + C) * 2u; }
    const size_t kstep = (size_t)(BK * 2);
    const size_t hstep = (size_t)HALF * K * 2;
    const size_t tstep = 2 * hstep;
    const unsigned ldsw = (unsigned)wid * 1024u;
    const int aoff = lds_byte(wr * 64 + fr, fq * 8), boff = lds_byte(wc * 32 + fr, fq * 8);
#define PG8_SA(b, h) (((b) * 2 + (h)) * HTB)
#define PG8_SB(b, h) ((4 + (b) * 2 + (h)) * HTB)
#define PG8_STAGE(bufoff, gbase, voff) do { _Pragma("unroll") for (int _i = 0; _i < 2; ++_i) \
        __builtin_amdgcn_global_load_lds((const unsigned*)((const char*)(gbase) + (voff)[_i]), (PG8_LAS unsigned*)(lds + (bufoff) + ldsw + _i * 8192), 16, 0, 0); } while (0)
#define PG8_LDA(dst, b, h) do { _Pragma("unroll") for (int m = 0; m < 4; ++m) _Pragma("unroll") for (int k = 0; k < 2; ++k) dst[m][k] = *(const PG8_LAS bf16x8*)(lds + PG8_SA(b, h) + aoff + m * 2048 + k * 1024); } while (0)
#define PG8_LDB(dst, b, h) do { _Pragma("unroll") for (int n = 0; n < 2; ++n) _Pragma("unroll") for (int k = 0; k < 2; ++k) dst[n][k] = *(const PG8_LAS bf16x8*)(lds + PG8_SB(b, h) + boff + n * 2048 + k * 1024); } while (0)
#define PG8_MMA(ai, bj, At, Bt) do { __builtin_amdgcn_s_setprio(1); _Pragma("unroll") for (int m = 0; m < 4; ++m) _Pragma("unroll") for (int n = 0; n < 2; ++n) _Pragma("unroll") for (int k = 0; k < 2; ++k) \
        acc[ai][bj][m][n] = __builtin_amdgcn_mfma_f32_16x16x32_bf16(Bt[n][k], At[m][k], acc[ai][bj][m][n], 0, 0, 0); __builtin_amdgcn_s_setprio(0); } while (0)
#define PG8_WAIT_V(n) asm volatile("s_waitcnt vmcnt(" #n ")" ::: "memory")
#define PG8_WAIT_L(n) asm volatile("s_waitcnt lgkmcnt(" #n ")" ::: "memory")
#define PG8_BAR __builtin_amdgcn_s_barrier()
#define PG8_SCHED __builtin_amdgcn_sched_barrier(0)
    Unit cur, nxt; int ui = 0;
    if (!S.next(0, cur)) return;
    f32x4 acc[2][2][4][2];
#pragma unroll
    for (int a = 0; a < 2; ++a)
#pragma unroll
        for (int b = 0; b < 2; ++b)
#pragma unroll
            for (int m = 0; m < 4; ++m)
#pragma unroll
                for (int n = 0; n < 2; ++n) acc[a][b][m][n] = (f32x4){0.f, 0.f, 0.f, 0.f};
    bf16x8 At[4][2], B0[2][2], B1[2][2];
    const char* cA = (const char*)g.A + (size_t)cur.pm * tstep; const char* cB = (const char*)g.Bt + (size_t)cur.pn * tstep;
    S.a_ready(cur);
    if constexpr (SP2) {
        PG8_STAGE(PG8_SB(0, 0), cB, voffB); PG8_STAGE(PG8_SB(0, 1), cB + hstep, voffB); PG8_STAGE(PG8_SA(0, 0), cA, voffA); PG8_STAGE(PG8_SA(0, 1), cA + hstep, voffA);
        if (wr == 1) PG8_BAR;
        PG8_WAIT_V(2); PG8_BAR;
        PG8_STAGE(PG8_SB(1, 0), cB + kstep, voffB); PG8_STAGE(PG8_SA(1, 0), cA + kstep, voffA); PG8_STAGE(PG8_SB(1, 1), cB + hstep + kstep, voffB);
        PG8_WAIT_V(6); PG8_BAR;
    } else {
        PG8_STAGE(PG8_SB(0, 0), cB, voffB); PG8_STAGE(PG8_SA(0, 0), cA, voffA); PG8_STAGE(PG8_SB(0, 1), cB + hstep, voffB); PG8_STAGE(PG8_SA(0, 1), cA + hstep, voffA);
        if (wr == 1) PG8_BAR;
        PG8_WAIT_V(4); PG8_BAR;
        PG8_STAGE(PG8_SB(1, 0), cB + kstep, voffB); PG8_STAGE(PG8_SA(1, 0), cA + kstep, voffA); PG8_STAGE(PG8_SB(1, 1), cB + hstep + kstep, voffB);
        PG8_WAIT_V(6); PG8_BAR;
    }
    for (;;) {
        const bool has_next = S.next(ui + 1, nxt);
        const char* nA = has_next ? (const char*)g.A + (size_t)nxt.pm * tstep : cA; const char* nB = has_next ? (const char*)g.Bt + (size_t)nxt.pn * tstep : cB;
        for (int t = 0; t < nt; t += 2) {
            const bool last = (t == nt - 2);
            const char* a1 = cA + (size_t)(t + 1) * kstep;
            const char* a2 = last ? nA : cA + (size_t)(t + 2) * kstep; const char* b2 = last ? nB : cB + (size_t)(t + 2) * kstep;
            const char* a3 = a2 + kstep; const char* b3 = b2 + kstep;
            if (last && has_next) S.a_ready(nxt);
            if constexpr (SP2) {
            PG8_LDB(B0, 0, 0); PG8_LDB(B1, 0, 1); PG8_SCHED; PG8_LDA(At, 0, 0); PG8_STAGE(PG8_SA(1, 1), a1 + hstep, voffA);
            PG8_WAIT_V(8); PG8_WAIT_L(0); PG8_BAR; PG8_MMA(0, 0, At, B0); PG8_MMA(0, 1, At, B1); PG8_BAR; PG8_SCHED;
            PG8_LDA(At, 0, 1); PG8_STAGE(PG8_SB(0, 0), b2, voffB); PG8_STAGE(PG8_SB(0, 1), b2 + hstep, voffB); PG8_STAGE(PG8_SA(0, 0), a2, voffA);
            PG8_WAIT_V(8); PG8_WAIT_L(0); PG8_BAR; PG8_MMA(1, 0, At, B0); PG8_MMA(1, 1, At, B1); PG8_BAR; PG8_SCHED;
            PG8_LDB(B0, 1, 0); PG8_LDB(B1, 1, 1); PG8_SCHED; PG8_LDA(At, 1, 0); PG8_STAGE(PG8_SA(0, 1), a2 + hstep, voffA);
            PG8_WAIT_V(8); PG8_WAIT_L(0); PG8_BAR; PG8_MMA(0, 0, At, B0); PG8_MMA(0, 1, At, B1); PG8_BAR; PG8_SCHED;
            PG8_LDA(At, 1, 1); PG8_STAGE(PG8_SB(1, 0), b3, voffB); PG8_STAGE(PG8_SB(1, 1), b3 + hstep, voffB); PG8_STAGE(PG8_SA(1, 0), a3, voffA);
            PG8_WAIT_V(8); PG8_WAIT_L(0); PG8_BAR; PG8_MMA(1, 0, At, B0); PG8_MMA(1, 1, At, B1); PG8_BAR; PG8_SCHED;
            } else {
            PG8_LDB(B0, 0, 0); PG8_SCHED; PG8_LDA(At, 0, 0); PG8_STAGE(PG8_SA(1, 1), a1 + hstep, voffA);
            PG8_WAIT_L(8); PG8_BAR; PG8_WAIT_L(0); PG8_MMA(0, 0, At, B0); PG8_BAR; PG8_SCHED;
            PG8_LDB(B1, 0, 1); PG8_STAGE(PG8_SB(0, 0), b2, voffB);
            PG8_BAR; PG8_WAIT_L(0); PG8_MMA(0, 1, At, B1); PG8_BAR;
            PG8_LDA(At, 0, 1); PG8_STAGE(PG8_SA(0, 0), a2, voffA);
            PG8_BAR; PG8_WAIT_L(0); PG8_MMA(1, 0, At, B0); PG8_BAR; PG8_SCHED;
            PG8_STAGE(PG8_SB(0, 1), b2 + hstep, voffB);
            PG8_WAIT_V(6); PG8_BAR; PG8_MMA(1, 1, At, B1); PG8_BAR;
            PG8_LDB(B0, 1, 0); PG8_SCHED; PG8_LDA(At, 1, 0); PG8_STAGE(PG8_SA(0, 1), a2 + hstep, voffA);
            PG8_WAIT_L(8); PG8_BAR; PG8_WAIT_L(0); PG8_MMA(0, 0, At, B0); PG8_BAR; PG8_SCHED;
            PG8_LDB(B1, 1, 1); PG8_STAGE(PG8_SB(1, 0), b3, voffB);
            PG8_BAR; PG8_WAIT_L(0); PG8_MMA(0, 1, At, B1); PG8_BAR;
            PG8_LDA(At, 1, 1); PG8_STAGE(PG8_SA(1, 0), a3, voffA);
            PG8_BAR; PG8_WAIT_L(0); PG8_MMA(1, 0, At, B0); PG8_BAR; PG8_SCHED;
            PG8_STAGE(PG8_SB(1, 1), b3 + hstep, voffB);
            PG8_WAIT_V(6); PG8_BAR; PG8_MMA(1, 1, At, B1); PG8_BAR;
            }
        }
        if constexpr (ALIGN_EPI) { if (wr == 0) PG8_BAR; }
        if constexpr (!Epi::AFTER_DRAIN) { E(acc, cur, wr, wc, fr, fq); S.done(cur); }
        if (!has_next) break;
#pragma unroll
        for (int a = 0; a < 2; ++a)
#pragma unroll
            for (int b = 0; b < 2; ++b)
#pragma unroll
                for (int m = 0; m < 4; ++m)
#pragma unroll
                    for (int n = 0; n < 2; ++n) acc[a][b][m][n] = (f32x4){0.f, 0.f, 0.f, 0.f};
        cur = nxt; cA = nA; cB = nB; ++ui;
        if constexpr (ALIGN_EPI) { if (wr == 1) PG8_BAR; }
    }
    PG8_WAIT_V(0);
    if constexpr (!ALIGN_EPI) { if (wr == 0) PG8_BAR; }
    PG8_BAR;
    if constexpr (Epi::AFTER_DRAIN) { E.fused(acc, cur, wr, wc, fr, fq, lds, wid, lane); S.done(cur); }
#undef PG8_SA
#undef PG8_SB
#undef PG8_STAGE
#undef PG8_LDA
#undef PG8_LDB
#undef PG8_MMA
#undef PG8_WAIT_V
#undef PG8_WAIT_L
#undef PG8_BAR
#undef PG8_SCHED
}
}

#define LAS __attribute__((address_space(3)))
typedef unsigned short bf16_t;
using pg8::f32x4; using pg8::u32x4; using pg8::Unit; using pg8::cvt_pk_bf16;
typedef float f32x2v __attribute__((ext_vector_type(2)));
typedef unsigned u32x2v __attribute__((ext_vector_type(2)));

constexpr int T_ = 65536, DM = 1024, NIN = 4096, DFF = 2816, ROWS_P = 32768;
constexpr size_t MiB = 1u << 20;
constexpr float EPS = 1e-6f;
constexpr int LDS_BYTES = 147456;
constexpr size_t DO_XN = 0, DO_MIXIN = 0, DO_WIN = 128 * MiB, DO_ROPE = 136 * MiB, DO_WOUT = 137 * MiB;
constexpr size_t WS_U = 0;
constexpr size_t WS_MIX = 0;
constexpr size_t WS_WGU = 128 * MiB, WS_WDN = 139 * MiB, WS_SS1 = 145 * MiB, WS_SS2 = 149 * MiB, WS_HFF = 160 * MiB;
constexpr int UP = 2560;
constexpr int UC_QH = 0, UC_ZF = 512, UC_ZB = 1024, UC_IH = 1536, UC_GH = 2048;
constexpr size_t WS_QB = 320 * MiB, WS_KB = 384 * MiB, WS_VB = 448 * MiB;
__device__ __forceinline__ int perm_row(int row) {
    if (row < ROWS_P) { const int pos = row & 16383; return (row & ~16383) + ((pos & 15) << 10) + (pos >> 4); }
    const int pos = row & 4095; return (row & ~4095) + ((pos & 15) << 8) + (pos >> 4);
}

__device__ __forceinline__ float bf2f(unsigned short h) { return __uint_as_float((unsigned)h << 16); }
__device__ __forceinline__ unsigned short f2bf(float f) { unsigned u = __float_as_uint(f); return (unsigned short)((u + 0x7fffu + ((u >> 16) & 1u)) >> 16); }
__device__ __forceinline__ unsigned pk2(float lo, float hi) { return cvt_pk_bf16(lo, hi); }
__device__ __forceinline__ float silu_f(float x) { return x * __builtin_amdgcn_rcpf(1.f + __expf(-x)); }
__device__ __forceinline__ float sigmoid_f(float x) { return __builtin_amdgcn_rcpf(1.f + __expf(-x)); }
__device__ __forceinline__ int row_pos(int row) { return row < ROWS_P ? (row & 16383) : (row & 4095); }
__device__ __forceinline__ int row_S(int row) { return row < ROWS_P ? 16384 : 4096; }
__device__ __forceinline__ float wave_sum(float v) {
#pragma unroll
    for (int o = 1; o < 64; o <<= 1) v += __shfl_xor(v, o);
    return v;
}
__device__ __forceinline__ float wave_max(float v) {
#pragma unroll
    for (int o = 1; o < 64; o <<= 1) v = fmaxf(v, __shfl_xor(v, o));
    return v;
}
#define LDS_WAIT() asm volatile("s_waitcnt lgkmcnt(0)" ::: "memory")
__device__ __forceinline__ int otid() { int t; asm volatile("v_mov_b32 %0, %1" : "=v"(t) : "v"((int)threadIdx.x)); return t; }


__device__ unsigned g_bar[3456];
struct XcdBarrier { unsigned* bar; unsigned x; volatile LAS unsigned* st; };
#define XB_TMO      128
#define XB_XCNT(j)  (256  + 64 * (j))
#define XB_XSUB(j)  (1280 + 64 * (j))
#define XB_XGEN(j)  (2304 + 64 * (j))
#define XB_TOP      3328
#define XB_TOPGEN   3392
#define XCD_BAR_WORDS 3456
#define XB_SPIN_CAP (1u << 18)

__device__ __forceinline__ unsigned xb_ld(unsigned* p)              { return __hip_atomic_load(p, __ATOMIC_RELAXED, __HIP_MEMORY_SCOPE_AGENT); }
__device__ __forceinline__ unsigned xb_add(unsigned* p, unsigned v) { return __hip_atomic_fetch_add(p, v, __ATOMIC_RELAXED, __HIP_MEMORY_SCOPE_AGENT); }
__device__ __forceinline__ unsigned xb_xcc_id() { return (unsigned)__builtin_amdgcn_s_getreg((3 << 11) | 20) & 0xFu; }
#define XB_SPIN(cond, bar) do { unsigned _sp = 0; while (cond) { __builtin_amdgcn_s_sleep(1); \
    if ((++_sp & 255u) == 0u) { if (xb_ld(&(bar)[XB_TMO])) break; if (_sp > XB_SPIN_CAP) { atomicAdd(&(bar)[XB_TMO], 1u); break; } } } } while (0)
__device__ __forceinline__ XcdBarrier xcd_barrier_post(unsigned* bar, volatile LAS unsigned* st) {
    XcdBarrier b; b.bar = bar; b.x = xb_xcc_id(); b.st = st;
    if (threadIdx.x == 0) (void)xb_add(&bar[XB_XCNT(b.x)], 1u);
    return b;
}
__device__ __forceinline__ void xcd_barrier_complete(unsigned* bar, unsigned x, unsigned& nloc, unsigned& nx) {
    const unsigned G = gridDim.x * gridDim.y * gridDim.z;
    unsigned sum, cnt, mine, sp = 0u;
    for (;;) {
        sum = 0u; cnt = 0u; mine = 0u;
#pragma unroll
        for (unsigned j = 0; j < 16; ++j) { const unsigned c = xb_ld(&bar[XB_XCNT(j)]); sum += c; cnt += (c > 0u) ? 1u : 0u; mine = (j == x) ? c : mine; }
        if (sum == G) break;
        __builtin_amdgcn_s_sleep(1);
        if ((++sp & 255u) == 0u) { if (xb_ld(&bar[XB_TMO])) break; if (sp > XB_SPIN_CAP) { atomicAdd(&bar[XB_TMO], 1u); break; } }
    }
    nloc = mine > 0u ? mine : 1u; nx = cnt > 0u ? cnt : 1u;
}

__device__ __forceinline__ void xcd_barrier(const XcdBarrier& b) {
    asm volatile("s_waitcnt vmcnt(0)" ::: "memory");
    __syncthreads();
    if (threadIdx.x == 0) {
        unsigned* bar = b.bar;
        __builtin_amdgcn_s_waitcnt(0);
        unsigned nloc = b.st[0], nx = b.st[1];
        if (nloc == 0u) { xcd_barrier_complete(bar, b.x, nloc, nx); b.st[0] = nloc; b.st[1] = nx; }
        const unsigned old = xb_add(&bar[XB_XSUB(b.x)], 1u);
        const unsigned gen = old / nloc;
        if (old + 1u == (gen + 1u) * nloc) {
            __builtin_amdgcn_fence(__ATOMIC_RELEASE, "agent");
            asm volatile("s_waitcnt vmcnt(0)" ::: "memory");
            const unsigned og = xb_add(&bar[XB_TOP], 1u);
            const unsigned tg = og / nx;
            if (og + 1u == (tg + 1u) * nx) xb_add(&bar[XB_TOPGEN], 1u);
            else XB_SPIN(xb_ld(&bar[XB_TOPGEN]) == tg, bar);
            __builtin_amdgcn_fence(__ATOMIC_ACQUIRE, "agent");
            xb_add(&bar[XB_XGEN(b.x)], 1u);
            asm volatile("s_waitcnt vmcnt(0)" ::: "memory");
        } else {
            XB_SPIN(xb_ld(&bar[XB_XGEN(b.x)]) == gen, bar);
            __builtin_amdgcn_fence(__ATOMIC_ACQUIRE, "agent");
            asm volatile("s_waitcnt vmcnt(0)" ::: "memory");
        }
    }
    __syncthreads();
}

struct EpiU {
    static constexpr bool PERM = true, AFTER_DRAIN = false;
    bf16_t* UH; bf16_t* XB; const float* rope;
    __device__ __forceinline__ void operator()(const f32x4 (&acc)[2][2][4][2], const Unit& u, int wr, int wc, int fr, int fq) const {
        const int row0 = u.pm * 256 + wr * 64 + fr;
        const bool attn = u.pn < 6;
        const bool rope_tile = (u.pn < 4) && ((wc & 1) == 0);
        const float sc = (u.pn < 2) ? 0.125f : 1.0f;
        const float sgn = (fq == 0) ? -1.f : 1.f;
#pragma unroll
        for (int ai = 0; ai < 2; ++ai)
#pragma unroll
            for (int m = 0; m < 4; ++m) {
                const int row = row0 + ai * 128 + m * 16;
                f32x4 r0 = {1.f, 0.f, 1.f, 0.f}, r1 = r0, r2 = r0, r3 = r0;
                if (rope_tile) { const f32x4* rp = (const f32x4*)(rope + (size_t)row_pos(row) * 16); r0 = rp[0]; r1 = rp[1]; r2 = rp[2]; r3 = rp[3]; }
                const size_t prow = attn ? (size_t)perm_row(row) : 0;
#pragma unroll
                for (int bj = 0; bj < 2; ++bj) {
                    f32x4 v0 = acc[ai][bj][m][0], v1 = acc[ai][bj][m][1];
                    if (rope_tile) {
                        f32x4 p0, p1;
#pragma unroll
                        for (int j = 0; j < 4; ++j) { p0[j] = __shfl_xor(v0[j], 16); p1[j] = __shfl_xor(v1[j], 16); }
                        if (fq < 2) {
                            v0[0] = v0[0] * r0[0] + sgn * p0[0] * r0[1]; v0[1] = v0[1] * r0[2] + sgn * p0[1] * r0[3];
                            v0[2] = v0[2] * r1[0] + sgn * p0[2] * r1[1]; v0[3] = v0[3] * r1[2] + sgn * p0[3] * r1[3];
                            v1[0] = v1[0] * r2[0] + sgn * p1[0] * r2[1]; v1[1] = v1[1] * r2[2] + sgn * p1[1] * r2[3];
                            v1[2] = v1[2] * r3[0] + sgn * p1[2] * r3[1]; v1[3] = v1[3] * r3[2] + sgn * p1[3] * r3[3];
                        }
                    }
                    v0 = v0 * sc; v1 = v1 * sc;
                    u32x4 w; w.x = cvt_pk_bf16(v0[0], v0[1]); w.y = cvt_pk_bf16(v0[2], v0[3]); w.z = cvt_pk_bf16(v1[0], v1[1]); w.w = cvt_pk_bf16(v1[2], v1[3]);
                    bf16_t* dst;
                    if (attn) {
                        const int cs = (u.pn & 1) * 256 + bj * 128 + wc * 32 + 8 * fq;
                        dst = XB + (size_t)(u.pn >> 1) * ((size_t)T_ * 512) + ((size_t)(cs >> 6) * T_ + prow) * 64 + (cs & 63);
                    } else dst = UH + (size_t)row * UP + (u.pn * 256 - 1536) + bj * 128 + wc * 32 + 8 * fq;
                    *(u32x4*)dst = w;
                }
            }
    }
};
struct EpiRowSS {
    static constexpr bool PERM = true, AFTER_DRAIN = false;
    bf16_t* O; float* SS;
    __device__ __forceinline__ void operator()(const f32x4 (&acc)[2][2][4][2], const Unit& u, int wr, int wc, int fr, int fq) const {
        const int row0 = u.pm * 256 + wr * 64 + fr, col0 = u.pn * 256 + wc * 32 + 8 * fq;
#pragma unroll
        for (int ai = 0; ai < 2; ++ai)
#pragma unroll
            for (int m = 0; m < 4; ++m) {
                const int row = row0 + ai * 128 + m * 16;
                bf16_t* rowp = O + (size_t)row * DM + col0;
                float s = 0.f;
#pragma unroll
                for (int bj = 0; bj < 2; ++bj) {
                    const f32x4 v0 = acc[ai][bj][m][0], v1 = acc[ai][bj][m][1];
                    s += (v0[0] * v0[0] + v0[1] * v0[1]) + (v0[2] * v0[2] + v0[3] * v0[3]) + (v1[0] * v1[0] + v1[1] * v1[1]) + (v1[2] * v1[2] + v1[3] * v1[3]);
                    u32x4 w; w.x = cvt_pk_bf16(v0[0], v0[1]); w.y = cvt_pk_bf16(v0[2], v0[3]); w.z = cvt_pk_bf16(v1[0], v1[1]); w.w = cvt_pk_bf16(v1[2], v1[3]);
                    *(u32x4*)(rowp + bj * 128) = w;
                }
                s += __shfl_xor(s, 16); s += __shfl_xor(s, 32);
                if (fq == 0) SS[(size_t)row * 16 + u.pn * 4 + wc] = s;
            }
    }
};
struct EpiSwiGLU {
    static constexpr bool PERM = true, AFTER_DRAIN = false;
    bf16_t* H;
    __device__ __forceinline__ void operator()(const f32x4 (&acc)[2][2][4][2], const Unit& u, int wr, int wc, int fr, int fq) const {
        const int row0 = u.pm * 256 + wr * 64 + fr, col0 = u.pn * 128 + wc * 32 + 8 * fq;
#pragma unroll
        for (int ai = 0; ai < 2; ++ai)
#pragma unroll
            for (int m = 0; m < 4; ++m) {
                const int row = row0 + ai * 128 + m * 16;
                const f32x4 g0 = acc[ai][0][m][0], g1 = acc[ai][0][m][1], u0 = acc[ai][1][m][0], u1 = acc[ai][1][m][1];
                f32x4 h0, h1;
#pragma unroll
                for (int j = 0; j < 4; ++j) { h0[j] = silu_f(g0[j]) * u0[j]; h1[j] = silu_f(g1[j]) * u1[j]; }
                u32x4 w; w.x = cvt_pk_bf16(h0[0], h0[1]); w.y = cvt_pk_bf16(h0[2], h0[3]); w.z = cvt_pk_bf16(h1[0], h1[1]); w.w = cvt_pk_bf16(h1[2], h1[3]);
                *(u32x4*)(H + (size_t)row * DFF + col0) = w;
            }
    }
};

template <class RowMap>
__device__ __forceinline__ void transpose_item(const float* W, int N, int k0, int n0, const float* kscale, bf16_t* WT, int K, RowMap rowmap, LAS float* scr, int lane) {
    float wv[32];
#pragma unroll
    for (int i = 0; i < 32; ++i) wv[i] = W[(size_t)(k0 + 2 * i + (lane >> 5)) * N + n0 + (lane & 31)];
#pragma unroll
    for (int i = 0; i < 32; ++i) { const int kk = 2 * i + (lane >> 5); float w = wv[i]; if (kscale) w *= kscale[k0 + kk]; scr[kk * 33 + (lane & 31)] = w; }
    LDS_WAIT();
    const int c = lane & 7;
#pragma unroll
    for (int j = 0; j < 4; ++j) { const int n = (lane >> 3) + 8 * j; const LAS float* s = scr + (8 * c) * 33 + n;
        u32x4 o; o.x = pk2(s[0 * 33], s[1 * 33]); o.y = pk2(s[2 * 33], s[3 * 33]); o.z = pk2(s[4 * 33], s[5 * 33]); o.w = pk2(s[6 * 33], s[7 * 33]);
        *(u32x4*)(WT + (size_t)rowmap(n0 + n) * K + k0 + 8 * c) = o; }
    LDS_WAIT();
}
struct RowId { __device__ __forceinline__ int operator()(int n) const { return n; } };
struct RowGU { int half; __device__ __forceinline__ int operator()(int n) const { return (n >> 7) * 256 + half * 128 + (n & 127); } };

struct Params {
    const float* xp; const float* xs; const float* w_in; const float* w_out; const float* lb_fwd; const float* lb_bwd; const float* g_hgrn;
    const float* g_pre_mix; const float* g_post_mix; const float* g_pre_ffn; const float* g_post_ffn; const float* w_gate; const float* w_up; const float* w_down;
    float* out; unsigned char* ws;
};
__device__ __forceinline__ const float* xrow_ptr(const Params& p, int row) { return row < ROWS_P ? p.xp + (size_t)row * DM : p.xs + (size_t)(row - ROWS_P) * DM; }

__device__ __forceinline__ void p0_prologue(const Params& p, LAS unsigned char* lds, int gw, int ngw, int wave, int lane) {
    unsigned char* dob = (unsigned char*)p.out;
    bf16_t* WIN = (bf16_t*)(dob + DO_WIN); bf16_t* WOUT = (bf16_t*)(dob + DO_WOUT); float* rope = (float*)(dob + DO_ROPE); bf16_t* XN = (bf16_t*)(dob + DO_XN);
    LAS float* scr = (LAS float*)(lds + wave * 16384);
    constexpr int I_IN = 16 * 128, I_OUT = 16 * 32;
    for (int it = gw; it < I_IN + I_OUT; it += ngw) {
        if (it < I_IN) transpose_item(p.w_in, NIN, 64 * (it / 128), 32 * (it % 128), p.g_pre_mix, WIN, DM, RowId{}, scr, lane);
        else { const int r = it - I_IN; transpose_item(p.w_out, DM, 64 * (r / 32), 32 * (r % 32), nullptr, WOUT, DM, RowId{}, scr, lane); }
    }
    {
        const int gt = gw * 64 + lane, ngt = ngw * 64;
        for (int e = gt; e < 16384 * 8; e += ngt) {
            const int pos = e >> 3, i = e & 7;
            const double rv = i == 0 ? 0.15915494309189535 : i == 1 ? 0.03086376340470123 : i == 2 ? 0.005985185712713705 : i == 3 ? 0.001160663641240061
                            : i == 4 ? 0.00022507907903927653 : i == 5 ? 4.364795279280289e-05 : i == 6 ? 8.464330808241401e-06 : 1.6414262627950345e-06;
            double a = (double)pos * rv; a -= floor(a);
            const float af = (float)a;
            rope[2 * e] = __builtin_amdgcn_cosf(af); rope[2 * e + 1] = __builtin_amdgcn_sinf(af);
        }
    }
    for (int m0 = gw * 4; m0 < T_; m0 += ngw * 4) {
        f32x4 v[4][4]; float s[4];
#pragma unroll
        for (int k = 0; k < 4; ++k) { const f32x4* xr = (const f32x4*)xrow_ptr(p, m0 + k) + lane;
#pragma unroll
            for (int j = 0; j < 4; ++j) v[k][j] = __builtin_nontemporal_load(&xr[64 * j]); }
#pragma unroll
        for (int k = 0; k < 4; ++k) { s[k] = 0.f;
#pragma unroll
            for (int j = 0; j < 4; ++j) s[k] += (v[k][j][0] * v[k][j][0] + v[k][j][1] * v[k][j][1]) + (v[k][j][2] * v[k][j][2] + v[k][j][3] * v[k][j][3]); }
#pragma unroll
        for (int k = 0; k < 4; ++k) {
            const float rstd = rsqrtf(wave_sum(s[k]) * (1.f / DM) + EPS);
            u32x2v* o8 = (u32x2v*)(XN + (size_t)(m0 + k) * DM) + lane;
#pragma unroll
            for (int j = 0; j < 4; ++j) { u32x2v w; w.x = cvt_pk_bf16(v[k][j][0] * rstd, v[k][j][1] * rstd); w.y = cvt_pk_bf16(v[k][j][2] * rstd, v[k][j][3] * rstd); __builtin_nontemporal_store(w, &o8[64 * j]); }
        }
    }
}

namespace at {
typedef short bf16x8 __attribute__((ext_vector_type(8)));
typedef short s16x4 __attribute__((ext_vector_type(4)));
constexpr int OS = 68;
constexpr int L_OUT = 0, L_L = 272 * OS * 4, L_VS = L_L + 1024, VS_STRIDE = 144, VS_WAVE = 32 * VS_STRIDE, L_END = L_VS + 8 * VS_WAVE;
static_assert(L_END <= LDS_BYTES, "attention LDS map");

__device__ __forceinline__ void wave_tile(const bf16_t* XBp, LAS unsigned char* lds, int w, int lane, int base, int S, int P0, int h, int idx) {
    const int n = lane & 15, quad = lane >> 4;
    const int br = idx >> 4, sub = idx & 15;
    const int dsh = 2 * br, dil = 1 << dsh;
    const int r = br == 0 ? 0 : (br == 1 ? (sub & 3) : sub);
    const int mt = br == 0 ? sub : (br == 1 ? (sub >> 2) : 0);
    const int Lsub = S >> dsh, m0 = (P0 >> dsh) + 16 * mt;
    const bf16_t* Qb = XBp + ((size_t)h * T_ + base) * 64;
    const bf16_t* Kb = Qb + (size_t)T_ * 512, * Vb = Kb + (size_t)T_ * 512;
    const int sh16 = (S == 16384) ? 10 : 8;
#define AT_ROW(pos) ((((pos) & 15) << sh16) + ((pos) >> 4))
    bf16x8 qf[2];
    { const int pq = (m0 + n) * dil + r; const bf16_t* qp = Qb + (size_t)AT_ROW(pq) * 64 + 8 * quad; qf[0] = *(const bf16x8*)qp; qf[1] = *(const bf16x8*)(qp + 32); }
    bf16x8 kf[9][2];
#pragma unroll
    for (int kt = 0; kt < 9; ++kt) {
        int mk = m0 - 64 + 16 * kt + n; mk = mk < 0 ? 0 : (mk >= Lsub ? Lsub - 1 : mk);
        const int pk = mk * dil + r;
        const bf16_t* kp = Kb + (size_t)AT_ROW(pk) * 64 + 8 * quad; kf[kt][0] = *(const bf16x8*)kp; kf[kt][1] = *(const bf16x8*)(kp + 32);
    }
    u32x4 vr[5][4];
#pragma unroll
    for (int t = 0; t < 5; ++t)
#pragma unroll
        for (int e = 0; e < 4; ++e) {
            const int id = lane + 64 * e, rho = id >> 3, ch = id & 7;
            int mk = m0 - 64 + 32 * t + rho; mk = mk < 0 ? 0 : (mk >= Lsub ? Lsub - 1 : mk);
            const int pv = mk * dil + r;
            vr[t][e] = *(const u32x4*)(Vb + (size_t)AT_ROW(pv) * 64 + 8 * ch);
        }
    unsigned pk[10][2];
    float lsum = 0.f;
#pragma unroll
    for (int kt = 0; kt < 9; ++kt) {
        f32x4 sc = {0.f, 0.f, 0.f, 0.f};
        sc = __builtin_amdgcn_mfma_f32_16x16x32_bf16(kf[kt][0], qf[0], sc, 0, 0, 0);
        sc = __builtin_amdgcn_mfma_f32_16x16x32_bf16(kf[kt][1], qf[1], sc, 0, 0, 0);
        float pv[4];
#pragma unroll
        for (int j = 0; j < 4; ++j) {
            const int ko = 16 * kt + 4 * quad + j, mk = m0 - 64 + ko;
            const bool valid = (ko >= n) && (ko <= n + 128) && (mk >= 0) && (mk < Lsub);
            const float e = __expf(fminf(sc[j], 80.f));
            pv[j] = valid ? e : 0.f; lsum += pv[j];
        }
        pk[kt][0] = cvt_pk_bf16(pv[0], pv[1]); pk[kt][1] = cvt_pk_bf16(pv[2], pv[3]);
    }
    pk[9][0] = 0u; pk[9][1] = 0u;
    lsum += __shfl_xor(lsum, 16); lsum += __shfl_xor(lsum, 32);
    f32x4 ot[4];
#pragma unroll
    for (int dt = 0; dt < 4; ++dt) ot[dt] = (f32x4){0.f, 0.f, 0.f, 0.f};
    LAS unsigned char* vs = lds + L_VS + w * VS_WAVE;
#pragma unroll
    for (int t = 0; t < 5; ++t) {
#pragma unroll
        for (int e = 0; e < 4; ++e) { const int id = lane + 64 * e, rho = id >> 3, ch = id & 7; *(LAS u32x4*)(vs + rho * VS_STRIDE + ch * 16) = vr[t][e]; }
        bf16x8 pf; { u32x4 pw = {pk[2 * t][0], pk[2 * t][1], pk[2 * t + 1][0], pk[2 * t + 1][1]}; pf = __builtin_bit_cast(bf16x8, pw); }
#pragma unroll
        for (int dt = 0; dt < 4; ++dt) {
            const int q = (lane & 15) >> 2, pp = lane & 3;
            const s16x4 lo = __builtin_amdgcn_ds_read_tr16_b64_v4i16((LAS s16x4*)(vs + (4 * quad + q) * VS_STRIDE + (16 * dt + 4 * pp) * 2));
            const s16x4 hi = __builtin_amdgcn_ds_read_tr16_b64_v4i16((LAS s16x4*)(vs + (16 + 4 * quad + q) * VS_STRIDE + (16 * dt + 4 * pp) * 2));
            const bf16x8 vf = {lo[0], lo[1], lo[2], lo[3], hi[0], hi[1], hi[2], hi[3]};
            ot[dt] = __builtin_amdgcn_mfma_f32_16x16x32_bf16(vf, pf, ot[dt], 0, 0, 0);
        }
    }
    const int posl = ((m0 + n) * dil + r) - P0;
    LAS float* op = (LAS float*)(lds + L_OUT) + (posl + (posl >> 4)) * OS + 4 * quad;
    LAS float* lp = (LAS float*)(lds + L_L) + posl;
    if (br == 0) {
#pragma unroll
        for (int dt = 0; dt < 4; ++dt) *(LAS f32x4*)(op + 16 * dt) = ot[dt];
        if (quad == 0) *lp = lsum;
    } else {
        f32x4 old[4];
#pragma unroll
        for (int dt = 0; dt < 4; ++dt) old[dt] = *(const LAS f32x4*)(op + 16 * dt);
        const float lo = *lp;
#pragma unroll
        for (int dt = 0; dt < 4; ++dt) *(LAS f32x4*)(op + 16 * dt) = old[dt] + ot[dt];
        if (quad == 0) *lp = lo + lsum;
    }
}
__device__ __forceinline__ void attn_phase(const bf16_t* XBp, bf16_t* MIXIN, LAS unsigned char* lds, int blk, int G) {
    const int tid = otid(), lane = tid & 63, w = __builtin_amdgcn_readfirstlane(tid >> 6);
    __syncthreads();
    for (int u = blk; u < 2048; u += G) {
        int grp = u >> 3, h = u & 7;
        if (G == 256) { const int x = u & 7, j = (u >> 3) & 31, e8 = u >> 8; h = j & 7; grp = 32 * x + 4 * e8 + (j >> 3); }
        const int row0 = grp * 256;
        const int base = row0 < ROWS_P ? (row0 & ~16383) : (ROWS_P + ((row0 - ROWS_P) & ~4095)), S = row0 < ROWS_P ? 16384 : 4096, P0 = row0 - base;
        for (int br = 0; br < 3; ++br) {
            wave_tile(XBp, lds, w, lane, base, S, P0, h, 16 * br + w);
            wave_tile(XBp, lds, w, lane, base, S, P0, h, 16 * br + w + 8);
            __syncthreads();
        }
        {
            const int pos = tid >> 1, half = tid & 1;
            const LAS float* op = (const LAS float*)(lds + L_OUT) + (pos + (pos >> 4)) * OS + 32 * half;
            const float inv = 1.f / ((const LAS float*)(lds + L_L))[pos];
            unsigned wv[16];
#pragma unroll
            for (int d = 0; d < 16; ++d) wv[d] = cvt_pk_bf16(op[2 * d] * inv, op[2 * d + 1] * inv);
            u32x4* gp = (u32x4*)(MIXIN + (size_t)(row0 + pos) * DM + h * 64 + 32 * half);
#pragma unroll
            for (int c = 0; c < 4; ++c) gp[c] = (u32x4){wv[4 * c], wv[4 * c + 1], wv[4 * c + 2], wv[4 * c + 3]};
        }
        __syncthreads();
    }
}
}

namespace hg {
typedef short bf16x8 __attribute__((ext_vector_type(8)));
constexpr int SEG = 1024, NCH = 16, NITEM = 512;
constexpr int RS = 272, TS = 144;
constexpr int L_QT = 0, L_QR = 17408, L_KR = 34816, L_K0 = 52224, L_Q4 = 56576, L_KT = 60928, L_VT = 79360, L_ST = 97792, L_AB = 132608, L_TOT = 141824, L_BV = 143872, L_END = 144384;
static_assert(L_END <= LDS_BYTES, "hgrn LDS map");
constexpr size_t DO_STATE = 140 * MiB, DO_DEC = 172 * MiB, DO_OB = 176 * MiB, DO_INIT = 240 * MiB;

__device__ __forceinline__ int phys_row(int g, int dir, int lt) { return dir ? (g * SEG + SEG - 1 - lt) : (g * SEG + lt); }
__device__ __forceinline__ unsigned short bf1(float x) { __bf16 b = (__bf16)x; return __builtin_bit_cast(unsigned short, b); }
__device__ __forceinline__ bf16x8 ldfrag(LAS unsigned char* lds, int off, int stride, int row0, int kel, int lane) {
    return *(const LAS bf16x8*)(lds + off + (row0 + (lane & 15)) * stride + (kel + 8 * (lane >> 4)) * 2);
}
template <bool FULL>
__device__ __forceinline__ void load_raw(const bf16_t* U, int g, int dir, int ch, int i, int zcol, int qcol, int vcol, unsigned short (&rz)[16], unsigned short (&rq)[16], unsigned short (&rv)[16]) {
#pragma unroll
    for (int r = 0; r < 16; ++r) {
        const bf16_t* pr = U + (size_t)phys_row(g, dir, 64 * ch + 16 * i + r) * UP;
        rz[r] = __builtin_nontemporal_load(pr + zcol); if (FULL) rq[r] = __builtin_nontemporal_load(pr + qcol); rv[r] = __builtin_nontemporal_load(pr + vcol);
    }
}
template <bool FULL>
__device__ __forceinline__ void prep(LAS unsigned char* lds, int i, int c, float lb, const unsigned short (&rz)[16], const unsigned short (&rq)[16], const unsigned short (&rv)[16], float& bdec) {
    float f[16], e1[16], qs[16];
    float run = 1.f;
#pragma unroll
    for (int r = 0; r < 16; ++r) {
        const float fr = lb + (1.f - lb) * sigmoid_f(bf2f(rz[r]));
        f[r] = fr; run *= fr; e1[r] = run;
        if (FULL) qs[r] = silu_f(bf2f(rq[r])); else qs[r] = 0.f;
    }
    ((LAS float*)(lds + L_TOT))[i * 128 + c] = run;
    {
        u32x4 a, b;
        a.x = rv[0] | ((unsigned)rv[1] << 16); a.y = rv[2] | ((unsigned)rv[3] << 16); a.z = rv[4] | ((unsigned)rv[5] << 16); a.w = rv[6] | ((unsigned)rv[7] << 16);
        b.x = rv[8] | ((unsigned)rv[9] << 16); b.y = rv[10] | ((unsigned)rv[11] << 16); b.z = rv[12] | ((unsigned)rv[13] << 16); b.w = rv[14] | ((unsigned)rv[15] << 16);
        LAS u32x4* vp = (LAS u32x4*)(lds + L_VT + c * TS + 32 * i); vp[0] = a; vp[1] = b;
    }
    __syncthreads();
    const LAS float* tp = (const LAS float*)(lds + L_TOT) + c;
    const float p0 = tp[0], p1 = tp[128], p2 = tp[256], p3 = tp[384];
    const float cQT = i == 0 ? 1.f : i == 1 ? p0 : i == 2 ? p0 * p1 : p0 * p1 * p2;
    const float cKT = i == 0 ? p1 * p2 * p3 : i == 1 ? p2 * p3 : i == 2 ? p3 : 1.f;
    const float cQR = i == 0 ? 1.f : i == 1 ? __builtin_amdgcn_rcpf(p1) : i == 2 ? 1.f : p2;
    const float cKR = i == 0 ? p1 : i == 1 ? 1.f : i == 2 ? __builtin_amdgcn_rcpf(p2) : 1.f;
    const float cK0 = __builtin_amdgcn_rcpf(p0), cQ4 = __builtin_amdgcn_rcpf(p3);
    bdec = (p0 * p1) * (p2 * p3);
    if (i == 0) ((LAS float*)(lds + L_BV))[c] = bdec;
    unsigned short kt[16];
    float e2 = 1.f;
#pragma unroll
    for (int r = 15; r >= 0; --r) {
        const float kb = (1.f - f[r]) * e2;
        kt[r] = bf1(kb * cKT);
        if (FULL) {
            *(LAS unsigned short*)(lds + L_KR + (16 * i + r) * RS + c * 2) = bf1(kb * cKR);
            if (i == 0) *(LAS unsigned short*)(lds + L_K0 + r * RS + c * 2) = bf1(kb * cK0);
        }
        e2 *= f[r];
    }
    {
        u32x4 a, b;
        a.x = kt[0] | ((unsigned)kt[1] << 16); a.y = kt[2] | ((unsigned)kt[3] << 16); a.z = kt[4] | ((unsigned)kt[5] << 16); a.w = kt[6] | ((unsigned)kt[7] << 16);
        b.x = kt[8] | ((unsigned)kt[9] << 16); b.y = kt[10] | ((unsigned)kt[11] << 16); b.z = kt[12] | ((unsigned)kt[13] << 16); b.w = kt[14] | ((unsigned)kt[15] << 16);
        LAS u32x4* kp = (LAS u32x4*)(lds + L_KT + c * TS + 32 * i); kp[0] = a; kp[1] = b;
    }
    if (FULL) {
#pragma unroll
        for (int r = 0; r < 16; ++r) {
            const float qe = qs[r] * e1[r];
            *(LAS unsigned short*)(lds + L_QT + (16 * i + r) * RS + c * 2) = bf1(qe * cQT);
            *(LAS unsigned short*)(lds + L_QR + (16 * i + r) * RS + c * 2) = bf1(qe * cQR);
            if (i == 3) *(LAS unsigned short*)(lds + L_Q4 + r * RS + c * 2) = bf1(qe * cQ4);
        }
    }
}
__device__ __forceinline__ void state_update(LAS unsigned char* lds, f32x4 (&S)[8], int w, int gq, int lane) {
    bf16x8 ktf[2];
#pragma unroll
    for (int k2 = 0; k2 < 2; ++k2) ktf[k2] = ldfrag(lds, L_KT, TS, 16 * w, 32 * k2, lane);
    const f32x4 dk = *(const LAS f32x4*)(lds + L_BV + (16 * w + 4 * gq) * 4);
#pragma unroll
    for (int n = 0; n < 8; ++n) {
        S[n] = S[n] * dk;
#pragma unroll
        for (int k2 = 0; k2 < 2; ++k2) S[n] = __builtin_amdgcn_mfma_f32_16x16x32_bf16(ktf[k2], ldfrag(lds, L_VT, TS, 16 * n, 32 * k2, lane), S[n], 0, 0, 0);
    }
}
__device__ __forceinline__ int item_of(int lin, int G) {
    if (G != 256) return lin;
    const int x = lin & 7, j = (lin >> 3) & 31, e = lin >> 8, g = 8 * x + 2 * (j >> 3) + e, hd = j & 7;
    return g * 8 + hd;
}
__device__ __forceinline__ float lb_of(const Params& p, int dir, int col) { const float* lbr = dir ? p.lb_bwd : p.lb_fwd; return 1.f / (1.f + __expf(lbr[512 + col] - lbr[col])); }

__device__ __forceinline__ void pass1(const Params& p, const bf16_t* U, LAS unsigned char* lds, int item) {
    const int tid = otid(), lane = tid & 63, w = __builtin_amdgcn_readfirstlane(tid >> 6), i = w >> 1, c = tid & 127, gq = lane >> 4;
    const int dir = item & 1, hh = (item >> 1) & 3, g = item >> 3;
    float* STATE = (float*)((unsigned char*)p.out + DO_STATE); float* DEC = (float*)((unsigned char*)p.out + DO_DEC);
    const float lb = lb_of(p, dir, hh * 128 + c);
    const int zcol = (dir ? UC_ZB : UC_ZF) + hh * 128 + c, qcol = UC_QH + hh * 128 + c, vcol = UC_IH + hh * 128 + c;
    f32x4 S[8];
#pragma unroll
    for (int n = 0; n < 8; ++n) S[n] = (f32x4){0.f, 0.f, 0.f, 0.f};
    float dtot = 1.f;
    unsigned short rz[16], rq[16], rv[16];
    load_raw<false>(U, g, dir, 0, i, zcol, qcol, vcol, rz, rq, rv);
    for (int ch = 0; ch < NCH; ++ch) {
        float bdec;
        prep<false>(lds, i, c, lb, rz, rq, rv, bdec);
        dtot *= bdec;
        if (ch + 1 < NCH) load_raw<false>(U, g, dir, ch + 1, i, zcol, qcol, vcol, rz, rq, rv);
        __syncthreads();
        state_update(lds, S, w, gq, lane);
        __syncthreads();
    }
    float* sp = STATE + (size_t)item * 16384 + (16 * w + 4 * gq) * 128 + (lane & 15);
#pragma unroll
    for (int n = 0; n < 8; ++n)
#pragma unroll
        for (int jj = 0; jj < 4; ++jj) sp[jj * 128 + 16 * n] = S[n][jj];
    if (i == 0) DEC[item * 128 + c] = dtot;
}
__device__ __forceinline__ void scan(const Params& p, int gt, int ngt) {
    const float* STATE = (const float*)((unsigned char*)p.out + DO_STATE); const float* DEC = (const float*)((unsigned char*)p.out + DO_DEC);
    bf16_t* INIT = (bf16_t*)((unsigned char*)p.out + DO_INIT);
    for (int e = gt; e < 80 * 4096; e += ngt) {
        const int chain = e >> 12, q4 = e & 4095, k = q4 >> 5;
        const int dir = chain & 1, hh = (chain >> 1) & 3, sb = chain >> 3;
        const int nseg = sb < 2 ? 16 : 4, g0 = sb < 2 ? sb * 16 : 32 + (sb - 2) * 4;
        f32x4 s = {0.f, 0.f, 0.f, 0.f};
        for (int j = 0; j < nseg; ++j) {
            const int g = dir ? (g0 + nseg - 1 - j) : (g0 + j), item = (g * 4 + hh) * 2 + dir;
            const f32x4 en = *((const f32x4*)(STATE + (size_t)item * 16384) + q4);
            u32x2v wv; wv.x = cvt_pk_bf16(s[0], s[1]); wv.y = cvt_pk_bf16(s[2], s[3]);
            *((u32x2v*)(INIT + (size_t)item * 16384) + q4) = wv;
            s = s * DEC[item * 128 + k] + en;
        }
    }
}
__device__ __forceinline__ void pass2(const Params& p, const bf16_t* U, bf16_t* MIXIN, LAS unsigned char* lds, int item) {
    const int tid = otid(), lane = tid & 63, w = __builtin_amdgcn_readfirstlane(tid >> 6), i = w >> 1, c = tid & 127, gq = lane >> 4;
    const int dir = item & 1, hh = (item >> 1) & 3, g = item >> 3;
    const bf16_t* INIT = (const bf16_t*)((unsigned char*)p.out + DO_INIT);
    bf16_t* OUT = dir ? (bf16_t*)((unsigned char*)p.out + DO_OB) + hh * 128 : MIXIN + 512 + hh * 128;
    const int opitch = dir ? 512 : DM;
    const float lb = lb_of(p, dir, hh * 128 + c);
    const int zcol = (dir ? UC_ZB : UC_ZF) + hh * 128 + c, qcol = UC_QH + hh * 128 + c, vcol = UC_IH + hh * 128 + c;
    for (int idx = tid; idx < 64 * TS / 4; idx += 512) ((LAS unsigned*)(lds + L_AB))[idx] = 0u;
    f32x4 S[8];
    {
        const bf16_t* sp = INIT + (size_t)item * 16384 + (16 * w + 4 * gq) * 128 + (lane & 15);
#pragma unroll
        for (int n = 0; n < 8; ++n)
#pragma unroll
            for (int jj = 0; jj < 4; ++jj) S[n][jj] = bf2f(sp[jj * 128 + 16 * n]);
    }
#define HG_ST_WRITE() do { _Pragma("unroll") for (int n = 0; n < 8; ++n) { u32x2v wv; wv.x = cvt_pk_bf16(S[n][0], S[n][1]); wv.y = cvt_pk_bf16(S[n][2], S[n][3]); \
        *(LAS u32x2v*)(lds + L_ST + (16 * n + (lane & 15)) * RS + (16 * w + 4 * gq) * 2) = wv; } } while (0)
    HG_ST_WRITE();
    unsigned short rz[16], rq[16], rv[16];
    load_raw<true>(U, g, dir, 0, i, zcol, qcol, vcol, rz, rq, rv);
    for (int ch = 0; ch < NCH; ++ch) {
        float bdec;
        prep<true>(lds, i, c, lb, rz, rq, rv, bdec);
        if (ch + 1 < NCH) load_raw<true>(U, g, dir, ch + 1, i, zcol, qcol, vcol, rz, rq, rv);
        __syncthreads();
        for (int bi = w; bi < 10; bi += 8) {
            const int ti = bi >= 6 ? 3 : bi >= 3 ? 2 : bi >= 1 ? 1 : 0, tj = bi - ti * (ti + 1) / 2;
            const int qoff = (bi == 9) ? L_Q4 : L_QR + 16 * ti * RS, koff = (bi == 0) ? L_K0 : L_KR + 16 * tj * RS;
            f32x4 a = {0.f, 0.f, 0.f, 0.f};
#pragma unroll
            for (int ks = 0; ks < 4; ++ks) a = __builtin_amdgcn_mfma_f32_16x16x32_bf16(ldfrag(lds, qoff, RS, 0, 32 * ks, lane), ldfrag(lds, koff, RS, 0, 32 * ks, lane), a, 0, 0, 0);
#pragma unroll
            for (int jj = 0; jj < 4; ++jj) {
                float val = a[jj];
                if (ti == tj && (lane & 15) > 4 * gq + jj) val = 0.f;
                *(LAS unsigned short*)(lds + L_AB + (16 * ti + 4 * gq + jj) * TS + (16 * tj + (lane & 15)) * 2) = bf1(val);
            }
        }
        __syncthreads();
        {
            bf16x8 stf[4], vtf[2];
#pragma unroll
            for (int ks = 0; ks < 4; ++ks) stf[ks] = ldfrag(lds, L_ST, RS, 16 * w, 32 * ks, lane);
#pragma unroll
            for (int k2 = 0; k2 < 2; ++k2) vtf[k2] = ldfrag(lds, L_VT, TS, 16 * w, 32 * k2, lane);
#pragma unroll
            for (int mt = 0; mt < 4; ++mt) {
                f32x4 o = {0.f, 0.f, 0.f, 0.f};
#pragma unroll
                for (int ks = 0; ks < 4; ++ks) o = __builtin_amdgcn_mfma_f32_16x16x32_bf16(ldfrag(lds, L_QT, RS, 16 * mt, 32 * ks, lane), stf[ks], o, 0, 0, 0);
#pragma unroll
                for (int k2 = 0; k2 < 2; ++k2) o = __builtin_amdgcn_mfma_f32_16x16x32_bf16(ldfrag(lds, L_AB, TS, 16 * mt, 32 * k2, lane), vtf[k2], o, 0, 0, 0);
#pragma unroll
                for (int jj = 0; jj < 4; ++jj) {
                    const int row = phys_row(g, dir, 64 * ch + 16 * mt + 4 * gq + jj);
                    OUT[(size_t)row * opitch + 16 * w + (lane & 15)] = bf1(o[jj]);
                }
            }
        }
        state_update(lds, S, w, gq, lane);
        __syncthreads();
        HG_ST_WRITE();
    }
#undef HG_ST_WRITE
}
}

__device__ __forceinline__ void hg_finalize(const Params& p, const bf16_t* U, bf16_t* MIXIN, int blk, int G, int wave, int lane) {
    const float gn0 = p.g_hgrn[2 * lane], gn1 = p.g_hgrn[2 * lane + 1];
    const bf16_t* OB = (const bf16_t*)((const unsigned char*)p.out + hg::DO_OB);
    const int gw = blk * 8 + wave, ngw = G * 8;
    for (int r0 = gw * 4; r0 < T_; r0 += ngw * 4) {
        unsigned wm[4][4], wg[4][4], wo[4][4];
#pragma unroll
        for (int k = 0; k < 4; ++k)
#pragma unroll
            for (int hh = 0; hh < 4; ++hh) {
                const int row = r0 + k;
                wm[k][hh] = *((const unsigned*)(MIXIN + (size_t)row * DM + 512 + hh * 128) + lane);
                wg[k][hh] = *((const unsigned*)(U + (size_t)row * UP + UC_GH + hh * 128) + lane);
                wo[k][hh] = *((const unsigned*)(OB + (size_t)row * 512 + hh * 128) + lane);
            }
#pragma unroll
        for (int k = 0; k < 4; ++k)
#pragma unroll
            for (int hh = 0; hh < 4; ++hh) {
                const unsigned w = wm[k][hh], gw2 = wg[k][hh], wb = wo[k][hh];
                const float o0 = __uint_as_float(w << 16) + __uint_as_float(wb << 16), o1 = __uint_as_float(w & 0xffff0000u) + __uint_as_float(wb & 0xffff0000u);
                const float g0 = __uint_as_float(gw2 << 16), g1 = __uint_as_float(gw2 & 0xffff0000u);
                const float rs = rsqrtf(wave_sum(o0 * o0 + o1 * o1) * (1.f / 128.f) + EPS);
                *((unsigned*)(MIXIN + (size_t)(r0 + k) * DM + 512 + hh * 128) + lane) = cvt_pk_bf16(o0 * rs * gn0 * silu_f(g0), o1 * rs * gn1 * silu_f(g1));
            }
    }
}

__device__ __forceinline__ void p6_rows(const Params& p, LAS unsigned char* lds, int gw, int ngw, int wave, int lane) {
    bf16_t* WGU = (bf16_t*)(p.ws + WS_WGU); bf16_t* WDN = (bf16_t*)(p.ws + WS_WDN);
    LAS float* scr = (LAS float*)(lds + wave * 16384);
    constexpr int I_G = 16 * 88, I_D = 44 * 32;
    for (int it = gw; it < 2 * I_G + I_D; it += ngw) {
        if (it < I_G) transpose_item(p.w_gate, DFF, 64 * (it / 88), 32 * (it % 88), p.g_pre_ffn, WGU, DM, RowGU{0}, scr, lane);
        else if (it < 2 * I_G) { const int r = it - I_G; transpose_item(p.w_up, DFF, 64 * (r / 88), 32 * (r % 88), p.g_pre_ffn, WGU, DM, RowGU{1}, scr, lane); }
        else { const int r = it - 2 * I_G; transpose_item(p.w_down, DM, 64 * (r / 32), 32 * (r % 32), nullptr, WDN, DFF, RowId{}, scr, lane); }
    }
    bf16_t* MIX = (bf16_t*)(p.ws + WS_MIX); const float* SS = (const float*)(p.ws + WS_SS1);
    f32x4 gp[4];
#pragma unroll
    for (int j = 0; j < 4; ++j) gp[j] = ((const f32x4*)p.g_post_mix)[lane + 64 * j];
    for (int m0 = gw * 4; m0 < T_; m0 += ngw * 4) {
        f32x4 xv[4][4]; u32x2v mw[4][4]; float r1[4];
#pragma unroll
        for (int k = 0; k < 4; ++k) {
            const int m = m0 + k;
            const f32x4* ssp = (const f32x4*)(SS + (size_t)m * 16);
            const f32x4 a = ssp[0], b = ssp[1], c = ssp[2], d = ssp[3];
            const float ss = ((a[0] + a[1]) + (a[2] + a[3])) + ((b[0] + b[1]) + (b[2] + b[3])) + ((c[0] + c[1]) + (c[2] + c[3])) + ((d[0] + d[1]) + (d[2] + d[3]));
            r1[k] = rsqrtf(ss * (1.f / DM) + EPS);
            const f32x4* xr = (const f32x4*)xrow_ptr(p, m) + lane;
            const u32x2v* mx = (const u32x2v*)(MIX + (size_t)m * DM) + lane;
#pragma unroll
            for (int jj = 0; jj < 4; ++jj) { xv[k][jj] = __builtin_nontemporal_load(&xr[64 * jj]); mw[k][jj] = __builtin_nontemporal_load(&mx[64 * jj]); }
        }
        float s2[4];
#pragma unroll
        for (int k = 0; k < 4; ++k) {
            f32x4* xo = (f32x4*)(p.out + (size_t)(m0 + k) * DM) + lane;
            s2[k] = 0.f;
#pragma unroll
            for (int jj = 0; jj < 4; ++jj) {
                const u32x2v w = mw[k][jj];
                f32x4 mv = {__uint_as_float(w.x << 16), __uint_as_float(w.x & 0xffff0000u), __uint_as_float(w.y << 16), __uint_as_float(w.y & 0xffff0000u)};
                xv[k][jj] = xv[k][jj] + mv * r1[k] * gp[jj];
                s2[k] += (xv[k][jj][0] * xv[k][jj][0] + xv[k][jj][1] * xv[k][jj][1]) + (xv[k][jj][2] * xv[k][jj][2] + xv[k][jj][3] * xv[k][jj][3]);
                __builtin_nontemporal_store(xv[k][jj], &xo[64 * jj]);
            }
        }
#pragma unroll
        for (int k = 0; k < 4; ++k) {
            const float r2 = rsqrtf(wave_sum(s2[k]) * (1.f / DM) + EPS);
            u32x2v* mx = (u32x2v*)(MIX + (size_t)(m0 + k) * DM) + lane;
#pragma unroll
            for (int jj = 0; jj < 4; ++jj) { u32x2v w; w.x = cvt_pk_bf16(xv[k][jj][0] * r2, xv[k][jj][1] * r2); w.y = cvt_pk_bf16(xv[k][jj][2] * r2, xv[k][jj][3] * r2); __builtin_nontemporal_store(w, &mx[64 * jj]); }
        }
    }
}
__device__ __forceinline__ void p9_rows(const Params& p, int gw, int ngw, int lane) {
    const bf16_t* FF = (const bf16_t*)(p.ws + WS_MIX); const float* SS = (const float*)(p.ws + WS_SS2);
    f32x4 gp[4];
#pragma unroll
    for (int j = 0; j < 4; ++j) gp[j] = ((const f32x4*)p.g_post_ffn)[lane + 64 * j];
    for (int m0 = gw * 4; m0 < T_; m0 += ngw * 4) {
        f32x4 xv[4][4]; u32x2v fw[4][4]; float r1[4];
#pragma unroll
        for (int k = 0; k < 4; ++k) {
            const int m = m0 + k;
            const f32x4* ssp = (const f32x4*)(SS + (size_t)m * 16);
            const f32x4 a = ssp[0], b = ssp[1], c = ssp[2], d = ssp[3];
            const float ss = ((a[0] + a[1]) + (a[2] + a[3])) + ((b[0] + b[1]) + (b[2] + b[3])) + ((c[0] + c[1]) + (c[2] + c[3])) + ((d[0] + d[1]) + (d[2] + d[3]));
            r1[k] = rsqrtf(ss * (1.f / DM) + EPS);
            const u32x2v* fx = (const u32x2v*)(FF + (size_t)m * DM) + lane;
            const f32x4* xo = (const f32x4*)(p.out + (size_t)m * DM) + lane;
#pragma unroll
            for (int jj = 0; jj < 4; ++jj) { xv[k][jj] = __builtin_nontemporal_load(&xo[64 * jj]); fw[k][jj] = __builtin_nontemporal_load(&fx[64 * jj]); }
        }
#pragma unroll
        for (int k = 0; k < 4; ++k) {
            f32x4* xo = (f32x4*)(p.out + (size_t)(m0 + k) * DM) + lane;
#pragma unroll
            for (int jj = 0; jj < 4; ++jj) {
                const u32x2v w = fw[k][jj];
                f32x4 fv = {__uint_as_float(w.x << 16), __uint_as_float(w.x & 0xffff0000u), __uint_as_float(w.y << 16), __uint_as_float(w.y & 0xffff0000u)};
                __builtin_nontemporal_store(xv[k][jj] + fv * r1[k] * gp[jj], &xo[64 * jj]);
            }
        }
    }
}

__global__ void __launch_bounds__(512, 2) fwd_megakernel(Params p) {
    extern __shared__ __attribute__((aligned(16))) unsigned char lds_raw[];
    LAS unsigned char* lds = (LAS unsigned char*)lds_raw;
    cg::grid_group grid = cg::this_grid();
#define GSYNC() do { asm volatile("s_waitcnt vmcnt(0)" ::: "memory"); grid.sync(); \
        if (wave == 0) { __builtin_amdgcn_fence(__ATOMIC_ACQUIRE, "agent"); asm volatile("s_waitcnt vmcnt(0)" ::: "memory"); } __syncthreads(); } while (0)
    const int tid = otid(), lane = tid & 63, wave = __builtin_amdgcn_readfirstlane(tid >> 6);
    const int G = gridDim.x, blk = blockIdx.x;
    const int gw = blk * 8 + wave, ngw = G * 8;
    unsigned char* dob = (unsigned char*)p.out;
    bf16_t* U = (bf16_t*)(p.ws + WS_U);
    bf16_t* MIXIN = (bf16_t*)(dob + DO_MIXIN);

    volatile LAS unsigned* bst = (volatile LAS unsigned*)(lds + LDS_BYTES - 16);
    if (tid < 2) bst[tid] = 0u;
    if (blk == 0) for (int i2 = tid; i2 < 3456; i2 += 512) __hip_atomic_store(g_bar + i2, 0u, __ATOMIC_RELAXED, __HIP_MEMORY_SCOPE_AGENT);
    p0_prologue(p, lds, gw, ngw, wave, lane);
    GSYNC();
    const XcdBarrier xbar = xcd_barrier_post(g_bar, bst);
#define XSYNC() xcd_barrier(xbar)
    {
        pg8::Gemm g{(const bf16_t*)(dob + DO_XN), (const bf16_t*)(dob + DO_WIN), T_, NIN, DM}; pg8::StaticOrder S; S.init(T_, NIN, G, blk);
        EpiU E{U, (bf16_t*)(p.ws + WS_QB), (const float*)(dob + DO_ROPE)};
        pg8::gemm_phase<EpiU, pg8::StaticOrder, true, true>(lds, g, S, E);
    }
    XSYNC();
    for (int lin = blk; lin < hg::NITEM; lin += G) hg::pass1(p, U, lds, hg::item_of(lin, G));
    at::attn_phase((const bf16_t*)(p.ws + WS_QB), MIXIN, lds, blk, G);
    XSYNC();
    hg::scan(p, blk * 512 + tid, G * 512);
    XSYNC();
    for (int lin = blk; lin < hg::NITEM; lin += G) hg::pass2(p, U, MIXIN, lds, hg::item_of(lin, G));
    XSYNC();
    hg_finalize(p, U, MIXIN, blk, G, wave, lane);
    XSYNC();
    {
        pg8::Gemm g{MIXIN, (const bf16_t*)(dob + DO_WOUT), T_, DM, DM}; pg8::StaticOrder S; S.init(T_, DM, G, blk);
        EpiRowSS E{(bf16_t*)(p.ws + WS_MIX), (float*)(p.ws + WS_SS1)};
        pg8::gemm_phase<EpiRowSS, pg8::StaticOrder, true, true>(lds, g, S, E);
    }
    XSYNC();
    p6_rows(p, lds, gw, ngw, wave, lane);
    XSYNC();
    {
        pg8::Gemm g{(const bf16_t*)(p.ws + WS_MIX), (const bf16_t*)(p.ws + WS_WGU), T_, 2 * DFF, DM}; pg8::StaticOrder S; S.init(T_, 2 * DFF, G, blk);
        EpiSwiGLU E{(bf16_t*)(p.ws + WS_HFF)};
        pg8::gemm_phase<EpiSwiGLU, pg8::StaticOrder, true, true>(lds, g, S, E);
    }
    XSYNC();
    {
        pg8::Gemm g{(const bf16_t*)(p.ws + WS_HFF), (const bf16_t*)(p.ws + WS_WDN), T_, DM, DFF}; pg8::StaticOrder S; S.init(T_, DM, G, blk);
        EpiRowSS E{(bf16_t*)(p.ws + WS_MIX), (float*)(p.ws + WS_SS2)};
        pg8::gemm_phase<EpiRowSS, pg8::StaticOrder, true, true>(lds, g, S, E);
    }
    XSYNC();
    p9_rows(p, gw, ngw, lane);
}

extern "C" void kernel_launch(void* const* d_in, const int* in_sizes, int n_in, void* d_out, int out_size, void* d_ws, size_t ws_size, hipStream_t stream) {
    static int grid_blocks = 0;
    if (grid_blocks == 0) {
        int dev = 0, cus = 0, per_cu = 0;
        hipGetDevice(&dev);
        hipDeviceGetAttribute(&cus, hipDeviceAttributeMultiprocessorCount, dev);
        hipFuncSetAttribute((const void*)fwd_megakernel, hipFuncAttributeMaxDynamicSharedMemorySize, LDS_BYTES);
        hipOccupancyMaxActiveBlocksPerMultiprocessor(&per_cu, (const void*)fwd_megakernel, 512, LDS_BYTES);
        if (per_cu < 1) { fprintf(stderr, "occupancy query reports %d blocks per CU\n", per_cu); per_cu = 1; }
        if (per_cu > 1) per_cu = 1;
        grid_blocks = cus * per_cu;
        if (ws_size < 512 * MiB) fprintf(stderr, "kernel_launch: workspace %zu smaller than the 512 MiB map\n", ws_size);
    }
    Params p{};
    p.xp = (const float*)d_in[0]; p.xs = (const float*)d_in[1]; p.w_in = (const float*)d_in[2]; p.w_out = (const float*)d_in[3];
    p.lb_fwd = (const float*)d_in[4]; p.lb_bwd = (const float*)d_in[5]; p.g_hgrn = (const float*)d_in[6]; p.g_pre_mix = (const float*)d_in[7];
    p.g_post_mix = (const float*)d_in[8]; p.g_pre_ffn = (const float*)d_in[9]; p.g_post_ffn = (const float*)d_in[10];
    p.w_gate = (const float*)d_in[11]; p.w_up = (const float*)d_in[12]; p.w_down = (const float*)d_in[13];
    p.out = (float*)d_out; p.ws = (unsigned char*)d_ws;
    void* args[] = {&p};
    hipError_t e = hipLaunchCooperativeKernel((const void*)fwd_megakernel, dim3(grid_blocks), dim3(512), args, LDS_BYTES, stream);
    if (e != hipSuccess) fprintf(stderr, "cooperative launch failed: %s (grid %d)\n", hipGetErrorString(e), grid_blocks);
}
```

```cpp
#include <hip/hip_runtime.h>
#include <hip/hip_cooperative_groups.h>
#include <cstdio>
#include <cstdint>
namespace cg = cooperative_groups;
namespace pg8 {
#define PG8_LAS __attribute__((address_space(3)))
typedef unsigned short bf16_t;
typedef short bf16x8 __attribute__((ext_vector_type(8)));
typedef float f32x4 __attribute__((ext_vector_type(4)));
typedef unsigned u32x4 __attribute__((ext_vector_type(4)));
constexpr int BM = 256, BK = 64, HALF = 128, HTB = HALF * BK * 2  , STAGE_BYTES = 8 * HTB, NXCD = 8, WGM = 8;

__host__ __device__ __forceinline__ int lds_byte(int r, int c) { const int st = (r >> 4) * 2 + (c >> 5), rr = r & 15, cc = c & 31, ob = rr * 64 + cc * 2; return st * 1024 + (ob ^ (((ob >> 9) & 1) << 5)); }
__host__ __device__ __forceinline__ void stage_rc(int b, int& R, int& C) { const int st = b / 1024, sb = b % 1024, swz = sb ^ (((sb >> 9) & 1) << 5); R = (st >> 1) * 16 + swz / 64; C = (st & 1) * 32 + (swz % 64) / 2; }
__host__ __device__ __forceinline__ int perm32(int rho) { const int n = rho >> 4, i = rho & 15; return 8 * (i >> 2) + 4 * n + (i & 3); }

struct Unit { int pm, pn; };
struct Gemm { const bf16_t* A; const bf16_t* Bt; int M, N, K; };

struct StaticOrder {
    int nM, nN, nwg, G, c;
    __host__ __device__ void init(int M, int N, int G_, int c_) { nM = M / BM; nN = N / BM; nwg = nM * nN; G = G_; c = c_; }
    __host__ __device__ bool next(int i, Unit& u) const {
        const long L = (long)i * G + c; if (L >= nwg) return false;
        int wgid = (int)L; { const int q = nwg / NXCD, r = nwg % NXCD, xcd = wgid % NXCD, off = wgid / NXCD; wgid = (xcd < r ? xcd * (q + 1) : r * (q + 1) + (xcd - r) * q) + off; }
        const int nig = WGM * nN, gid = wgid / nig, fm = gid * WGM, gsz = (nM - fm) < WGM ? (nM - fm) : WGM;
        u.pm = fm + ((wgid % nig) % gsz); u.pn = (wgid % nig) / gsz; return true;
    }
    __device__ __forceinline__ void a_ready(const Unit&) const {}
    __device__ __forceinline__ void done(const Unit&) const {}
};

typedef __bf16 bf16x2_t __attribute__((ext_vector_type(2)));
typedef float f32x2_t __attribute__((ext_vector_type(2)));
__device__ __forceinline__ unsigned cvt_pk_bf16(float lo, float hi) { f32x2_t v = {lo, hi}; bf16x2_t b = __builtin_convertvector(v, bf16x2_t); return __builtin_bit_cast(unsigned, b); }
typedef float f32x2 __attribute__((ext_vector_type(2)));
template <class Epi, class Sched, bool ALIGN_EPI = false, bool SP2 = false>
__device__ __forceinline__ void gemm_phase(PG8_LAS unsigned char* lds, const Gemm g, const Sched& S, const Epi& E) {
    int tid; asm volatile("v_mov_b32 %0, %1" : "=v"(tid) : "v"((int)threadIdx.x));
    const int wid = __builtin_amdgcn_readfirstlane(tid >> 6), lane = tid & 63, wr = wid >> 2, wc = wid & 3, fr = lane & 15, fq = lane >> 4;
    const int K = g.K, nt = K / BK;
    unsigned voffA[2], voffB[2];
#pragma unroll
    for (int i = 0; i < 2; ++i) { int R, C; stage_rc(tid * 16 + i * 8192, R, C); const int Rb = Epi::PERM ? ((R & ~31) + perm32(R & 31)) : R;
        voffA[i] = (unsigned)(R * K + C) * 2u; voffB[i] = (unsigned)(Rb * K + C) * 2u; }
    const size_t kstep = (size_t)(BK * 2);
    const size_t hstep = (size_t)HALF * K * 2;
    const size_t tstep = 2 * hstep;
    const unsigned ldsw = (unsigned)wid * 1024u;
    const int aoff = lds_byte(wr * 64 + fr, fq * 8), boff = lds_byte(wc * 32 + fr, fq * 8);
#define PG8_SA(b, h) (((b) * 2 + (h)) * HTB)
#define PG8_SB(b, h) ((4 + (b) * 2 + (h)) * HTB)
#define PG8_STAGE(bufoff, gbase, voff) do { _Pragma("unroll") for (int _i = 0; _i < 2; ++_i) \
        __builtin_amdgcn_global_load_lds((const unsigned*)((const char*)(gbase) + (voff)[_i]), (PG8_LAS unsigned*)(lds + (bufoff) + ldsw + _i * 8192), 16, 0, 0); } while (0)
#define PG8_LDA(dst, b, h) do { _Pragma("unroll") for (int m = 0; m < 4; ++m) _Pragma("unroll") for (int k = 0; k < 2; ++k) dst[m][k] = *(const PG8_LAS bf16x8*)(lds + PG8_SA(b, h) + aoff + m * 2048 + k * 1024); } while (0)
#define PG8_LDB(dst, b, h) do { _Pragma("unroll") for (int n = 0; n < 2; ++n) _Pragma("unroll") for (int k = 0; k < 2; ++k) dst[n][k] = *(const PG8_LAS bf16x8*)(lds + PG8_SB(b, h) + boff + n * 2048 + k * 1024); } while (0)
#define PG8_MMA(ai, bj, At, Bt) do { __builtin_amdgcn_s_setprio(1); _Pragma("unroll") for (int m = 0; m < 4; ++m) _Pragma("unroll") for (int n = 0; n < 2; ++n) _Pragma("unroll") for (int k = 0; k < 2; ++k) \
        acc[ai][bj][m][n] = __builtin_amdgcn_mfma_f32_16x16x32_bf16(Bt[n][k], At[m][k], acc[ai][bj][m][n], 0, 0, 0); __builtin_amdgcn_s_setprio(0); } while (0)
#define PG8_WAIT_V(n) asm volatile("s_waitcnt vmcnt(" #n ")" ::: "memory")
#define PG8_WAIT_L(n) asm volatile("s_waitcnt lgkmcnt(" #n ")" ::: "memory")
#define PG8_BAR __builtin_amdgcn_s_barrier()
#define PG8_SCHED __builtin_amdgcn_sched_barrier(0)
    Unit cur, nxt; int ui = 0;
    if (!S.next(0, cur)) return;
    f32x4 acc[2][2][4][2];
#pragma unroll
    for (int a = 0; a < 2; ++a)
#pragma unroll
        for (int b = 0; b < 2; ++b)
#pragma unroll
            for (int m = 0; m < 4; ++m)
#pragma unroll
                for (int n = 0; n < 2; ++n) acc[a][b][m][n] = (f32x4){0.f, 0.f, 0.f, 0.f};
    bf16x8 At[4][2], B0[2][2], B1[2][2];
    const char* cA = (const char*)g.A + (size_t)cur.pm * tstep; const char* cB = (const char*)g.Bt + (size_t)cur.pn * tstep;
    S.a_ready(cur);
    if constexpr (SP2) {
        PG8_STAGE(PG8_SB(0, 0), cB, voffB); PG8_STAGE(PG8_SB(0, 1), cB + hstep, voffB); PG8_STAGE(PG8_SA(0, 0), cA, voffA); PG8_STAGE(PG8_SA(0, 1), cA + hstep, voffA);
        if (wr == 1) PG8_BAR;
        PG8_WAIT_V(2); PG8_BAR;
        PG8_STAGE(PG8_SB(1, 0), cB + kstep, voffB); PG8_STAGE(PG8_SA(1, 0), cA + kstep, voffA); PG8_STAGE(PG8_SB(1, 1), cB + hstep + kstep, voffB);
        PG8_WAIT_V(6); PG8_BAR;
    } else {
        PG8_STAGE(PG8_SB(0, 0), cB, voffB); PG8_STAGE(PG8_SA(0, 0), cA, voffA); PG8_STAGE(PG8_SB(0, 1), cB + hstep, voffB); PG8_STAGE(PG8_SA(0, 1), cA + hstep, voffA);
        if (wr == 1) PG8_BAR;
        PG8_WAIT_V(4); PG8_BAR;
        PG8_STAGE(PG8_SB(1, 0), cB + kstep, voffB); PG8_STAGE(PG8_SA(1, 0), cA + kstep, voffA); PG8_STAGE(PG8_SB(1, 1), cB + hstep + kstep, voffB);
        PG8_WAIT_V(6); PG8_BAR;
    }
    for (;;) {
        const bool has_next = S.next(ui + 1, nxt);
        const char* nA = has_next ? (const char*)g.A + (size_t)nxt.pm * tstep : cA; const char* nB = has_next ? (const char*)g.Bt + (size_t)nxt.pn * tstep : cB;
        for (int t = 0; t < nt; t += 2) {
            const bool last = (t == nt - 2);
            const char* a1 = cA + (size_t)(t + 1) * kstep;
            const char* a2 = last ? nA : cA + (size_t)(t + 2) * kstep; const char* b2 = last ? nB : cB + (size_t)(t + 2) * kstep;
            const char* a3 = a2 + kstep; const char* b3 = b2 + kstep;
            if (last && has_next) S.a_ready(nxt);
            if constexpr (SP2) {
            PG8_LDB(B0, 0, 0); PG8_LDB(B1, 0, 1); PG8_SCHED; PG8_LDA(At, 0, 0); PG8_STAGE(PG8_SA(1, 1), a1 + hstep, voffA);
            PG8_WAIT_V(8); PG8_WAIT_L(0); PG8_BAR; PG8_MMA(0, 0, At, B0); PG8_MMA(0, 1, At, B1); PG8_BAR; PG8_SCHED;
            PG8_LDA(At, 0, 1); PG8_STAGE(PG8_SB(0, 0), b2, voffB); PG8_STAGE(PG8_SB(0, 1), b2 + hstep, voffB); PG8_STAGE(PG8_SA(0, 0), a2, voffA);
            PG8_WAIT_V(8); PG8_WAIT_L(0); PG8_BAR; PG8_MMA(1, 0, At, B0); PG8_MMA(1, 1, At, B1); PG8_BAR; PG8_SCHED;
            PG8_LDB(B0, 1, 0); PG8_LDB(B1, 1, 1); PG8_SCHED; PG8_LDA(At, 1, 0); PG8_STAGE(PG8_SA(0, 1), a2 + hstep, voffA);
            PG8_WAIT_V(8); PG8_WAIT_L(0); PG8_BAR; PG8_MMA(0, 0, At, B0); PG8_MMA(0, 1, At, B1); PG8_BAR; PG8_SCHED;
            PG8_LDA(At, 1, 1); PG8_STAGE(PG8_SB(1, 0), b3, voffB); PG8_STAGE(PG8_SB(1, 1), b3 + hstep, voffB); PG8_STAGE(PG8_SA(1, 0), a3, voffA);
            PG8_WAIT_V(8); PG8_WAIT_L(0); PG8_BAR; PG8_MMA(1, 0, At, B0); PG8_MMA(1, 1, At, B1); PG8_BAR; PG8_SCHED;
            } else {
            PG8_LDB(B0, 0, 0); PG8_SCHED; PG8_LDA(At, 0, 0); PG8_STAGE(PG8_SA(1, 1), a1 + hstep, voffA);
            PG8_WAIT_L(8); PG8_BAR; PG8_WAIT_L(0); PG8_MMA(0, 0, At, B0); PG8_BAR; PG8_SCHED;
            PG8_LDB(B1, 0, 1); PG8_STAGE(PG8_SB(0, 0), b2, voffB);
            PG8_BAR; PG8_WAIT_L(0); PG8_MMA(0, 1, At, B1); PG8_BAR;
            PG8_LDA(At, 0, 1); PG8_STAGE(PG8_SA(0, 0), a2, voffA);
            PG8_BAR; PG8_WAIT_L(0); PG8_MMA(1, 0, At, B0); PG8_BAR; PG8_SCHED;
            PG8_STAGE(PG8_SB(0, 1), b2 + hstep, voffB);
            PG8_WAIT_V(6); PG8_BAR; PG8_MMA(1, 1, At, B1); PG8_BAR;
            PG8_LDB(B0, 1, 0); PG8_SCHED; PG8_LDA(At, 1, 0); PG8_STAGE(PG8_SA(0, 1), a2 + hstep, voffA);
            PG8_WAIT_L(8); PG8_BAR; PG8_WAIT_L(0); PG8_MMA(0, 0, At, B0); PG8_BAR; PG8_SCHED;
            PG8_LDB(B1, 1, 1); PG8_STAGE(PG8_SB(1, 0), b3, voffB);
            PG8_BAR; PG8_WAIT_L(0); PG8_MMA(0, 1, At, B1); PG8_BAR;
            PG8_LDA(At, 1, 1); PG8_STAGE(PG8_SA(1, 0), a3, voffA);
            PG8_BAR; PG8_WAIT_L(0); PG8_MMA(1, 0, At, B0); PG8_BAR; PG8_SCHED;
            PG8_STAGE(PG8_SB(1, 1), b3 + hstep, voffB);
            PG8_WAIT_V(6); PG8_BAR; PG8_MMA(1, 1, At, B1); PG8_BAR;
            }
        }
        if constexpr (ALIGN_EPI) { if (wr == 0) PG8_BAR; }
        if constexpr (!Epi::AFTER_DRAIN) { E(acc, cur, wr, wc, fr, fq); S.done(cur); }
        if (!has_next) break;
#pragma unroll
        for (int a = 0; a < 2; ++a)
#pragma unroll
            for (int b = 0; b < 2; ++b)
#pragma unroll
                for (int m = 0; m < 4; ++m)
#pragma unroll
                    for (int n = 0; n < 2; ++n) acc[a][b][m][n] = (f32x4){0.f, 0.f, 0.f, 0.f};
        cur = nxt; cA = nA; cB = nB; ++ui;
        if constexpr (ALIGN_EPI) { if (wr == 1) PG8_BAR; }
    }
    PG8_WAIT_V(0);
    if constexpr (!ALIGN_EPI) { if (wr == 0) PG8_BAR; }
    PG8_BAR;
    if constexpr (Epi::AFTER_DRAIN) { E.fused(acc, cur, wr, wc, fr, fq, lds, wid, lane); S.done(cur); }
#undef PG8_SA
#undef PG8_SB
#undef PG8_STAGE
#undef PG8_LDA
#undef PG8_LDB
#undef PG8_MMA
#undef PG8_WAIT_V
#undef PG8_WAIT_L
#undef PG8_BAR
#undef PG8_SCHED
}
}

#define LAS __attribute__((address_space(3)))
typedef unsigned short bf16_t;
using pg8::f32x4; using pg8::u32x4; using pg8::Unit; using pg8::cvt_pk_bf16;
typedef float f32x2v __attribute__((ext_vector_type(2)));
typedef unsigned u32x2v __attribute__((ext_vector_type(2)));

constexpr int T_ = 65536, DM = 1024, NIN = 4096, DFF = 2816, ROWS_P = 32768;
constexpr size_t MiB = 1u << 20;
constexpr float EPS = 1e-6f;
constexpr int LDS_BYTES = 147456;
constexpr size_t DO_XN = 0, DO_MIXIN = 0, DO_WIN = 128 * MiB, DO_ROPE = 136 * MiB, DO_WOUT = 137 * MiB;
constexpr size_t WS_U = 0;
constexpr size_t WS_MIX = 0;
constexpr size_t WS_WGU = 128 * MiB, WS_WDN = 139 * MiB, WS_SS1 = 145 * MiB, WS_SS2 = 149 * MiB, WS_HFF = 160 * MiB;
constexpr int UP = 2560;
constexpr int UC_QH = 0, UC_ZF = 512, UC_ZB = 1024, UC_IH = 1536, UC_GH = 2048;
constexpr size_t WS_QB = 320 * MiB, WS_KB = 384 * MiB, WS_VB = 448 * MiB;
__device__ __forceinline__ int perm_row(int row) {
    if (row < ROWS_P) { const int pos = row & 16383; return (row & ~16383) + ((pos & 15) << 10) + (pos >> 4); }
    const int pos = row & 4095; return (row & ~4095) + ((pos & 15) << 8) + (pos >> 4);
}

__device__ __forceinline__ float bf2f(unsigned short h) { return __uint_as_float((unsigned)h << 16); }
__device__ __forceinline__ unsigned short f2bf(float f) { unsigned u = __float_as_uint(f); return (unsigned short)((u + 0x7fffu + ((u >> 16) & 1u)) >> 16); }
__device__ __forceinline__ unsigned pk2(float lo, float hi) { return cvt_pk_bf16(lo, hi); }
__device__ __forceinline__ float silu_f(float x) { return x * __builtin_amdgcn_rcpf(1.f + __expf(-x)); }
__device__ __forceinline__ float sigmoid_f(float x) { return __builtin_amdgcn_rcpf(1.f + __expf(-x)); }
__device__ __forceinline__ int row_pos(int row) { return row < ROWS_P ? (row & 16383) : (row & 4095); }
__device__ __forceinline__ int row_S(int row) { return row < ROWS_P ? 16384 : 4096; }
__device__ __forceinline__ float wave_sum(float v) {
#pragma unroll
    for (int o = 1; o < 64; o <<= 1) v += __shfl_xor(v, o);
    return v;
}
__device__ __forceinline__ float wave_max(float v) {
#pragma unroll
    for (int o = 1; o < 64; o <<= 1) v = fmaxf(v, __shfl_xor(v, o));
    return v;
}
#define LDS_WAIT() asm volatile("s_waitcnt lgkmcnt(0)" ::: "memory")
__device__ __forceinline__ int otid() { int t; asm volatile("v_mov_b32 %0, %1" : "=v"(t) : "v"((int)threadIdx.x)); return t; }


__device__ unsigned g_bar[3456];
struct XcdBarrier { unsigned* bar; unsigned x; volatile LAS unsigned* st; };
#define XB_TMO      128
#define XB_XCNT(j)  (256  + 64 * (j))
#define XB_XSUB(j)  (1280 + 64 * (j))
#define XB_XGEN(j)  (2304 + 64 * (j))
#define XB_TOP      3328
#define XB_TOPGEN   3392
#define XCD_BAR_WORDS 3456
#define XB_SPIN_CAP (1u << 18)

__device__ __forceinline__ unsigned xb_ld(unsigned* p)              { return __hip_atomic_load(p, __ATOMIC_RELAXED, __HIP_MEMORY_SCOPE_AGENT); }
__device__ __forceinline__ unsigned xb_add(unsigned* p, unsigned v) { return __hip_atomic_fetch_add(p, v, __ATOMIC_RELAXED, __HIP_MEMORY_SCOPE_AGENT); }
__device__ __forceinline__ unsigned xb_xcc_id() { return (unsigned)__builtin_amdgcn_s_getreg((3 << 11) | 20) & 0xFu; }
#define XB_SPIN(cond, bar) do { unsigned _sp = 0; while (cond) { __builtin_amdgcn_s_sleep(1); \
    if ((++_sp & 255u) == 0u) { if (xb_ld(&(bar)[XB_TMO])) break; if (_sp > XB_SPIN_CAP) { atomicAdd(&(bar)[XB_TMO], 1u); break; } } } } while (0)
__device__ __forceinline__ XcdBarrier xcd_barrier_post(unsigned* bar, volatile LAS unsigned* st) {
    XcdBarrier b; b.bar = bar; b.x = xb_xcc_id(); b.st = st;
    if (threadIdx.x == 0) (void)xb_add(&bar[XB_XCNT(b.x)], 1u);
    return b;
}
__device__ __forceinline__ void xcd_barrier_complete(unsigned* bar, unsigned x, unsigned& nloc, unsigned& nx) {
    const unsigned G = gridDim.x * gridDim.y * gridDim.z;
    unsigned sum, cnt, mine, sp = 0u;
    for (;;) {
        sum = 0u; cnt = 0u; mine = 0u;
#pragma unroll
        for (unsigned j = 0; j < 16; ++j) { const unsigned c = xb_ld(&bar[XB_XCNT(j)]); sum += c; cnt += (c > 0u) ? 1u : 0u; mine = (j == x) ? c : mine; }
        if (sum == G) break;
        __builtin_amdgcn_s_sleep(1);
        if ((++sp & 255u) == 0u) { if (xb_ld(&bar[XB_TMO])) break; if (sp > XB_SPIN_CAP) { atomicAdd(&bar[XB_TMO], 1u); break; } }
    }
    nloc = mine > 0u ? mine : 1u; nx = cnt > 0u ? cnt : 1u;
}

__device__ __forceinline__ void xcd_barrier(const XcdBarrier& b) {
    asm volatile("s_waitcnt vmcnt(0)" ::: "memory");
    __syncthreads();
    if (threadIdx.x == 0) {
        unsigned* bar = b.bar;
        __builtin_amdgcn_s_waitcnt(0);
        unsigned nloc = b.st[0], nx = b.st[1];
        if (nloc == 0u) { xcd_barrier_complete(bar, b.x, nloc, nx); b.st[0] = nloc; b.st[1] = nx; }
        const unsigned old = xb_add(&bar[XB_XSUB(b.x)], 1u);
        const unsigned gen = old / nloc;
        if (old + 1u == (gen + 1u) * nloc) {
            __builtin_amdgcn_fence(__ATOMIC_RELEASE, "agent");
            asm volatile("s_waitcnt vmcnt(0)" ::: "memory");
            const unsigned og = xb_add(&bar[XB_TOP], 1u);
            const unsigned tg = og / nx;
            if (og + 1u == (tg + 1u) * nx) xb_add(&bar[XB_TOPGEN], 1u);
            else XB_SPIN(xb_ld(&bar[XB_TOPGEN]) == tg, bar);
            __builtin_amdgcn_fence(__ATOMIC_ACQUIRE, "agent");
            xb_add(&bar[XB_XGEN(b.x)], 1u);
            asm volatile("s_waitcnt vmcnt(0)" ::: "memory");
        } else {
            XB_SPIN(xb_ld(&bar[XB_XGEN(b.x)]) == gen, bar);
            __builtin_amdgcn_fence(__ATOMIC_ACQUIRE, "agent");
            asm volatile("s_waitcnt vmcnt(0)" ::: "memory");
        }
    }
    __syncthreads();
}

struct EpiU {
    static constexpr bool PERM = true, AFTER_DRAIN = false;
    bf16_t* UH; bf16_t* XB; const float* rope;
    __device__ __forceinline__ void operator()(const f32x4 (&acc)[2][2][4][2], const Unit& u, int wr, int wc, int fr, int fq) const {
        const int row0 = u.pm * 256 + wr * 64 + fr;
        const bool attn = u.pn < 6;
        const bool rope_tile = (u.pn < 4) && ((wc & 1) == 0);
        const float sc = (u.pn < 2) ? 0.125f : 1.0f;
        const float sgn = (fq == 0) ? -1.f : 1.f;
#pragma unroll
        for (int ai = 0; ai < 2; ++ai)
#pragma unroll
            for (int m = 0; m < 4; ++m) {
                const int row = row0 + ai * 128 + m * 16;
                f32x4 r0 = {1.f, 0.f, 1.f, 0.f}, r1 = r0, r2 = r0, r3 = r0;
                if (rope_tile) { const f32x4* rp = (const f32x4*)(rope + (size_t)row_pos(row) * 16); r0 = rp[0]; r1 = rp[1]; r2 = rp[2]; r3 = rp[3]; }
                const size_t prow = attn ? (size_t)perm_row(row) : 0;
#pragma unroll
                for (int bj = 0; bj < 2; ++bj) {
                    f32x4 v0 = acc[ai][bj][m][0], v1 = acc[ai][bj][m][1];
                    if (rope_tile) {
                        f32x4 p0, p1;
#pragma unroll
                        for (int j = 0; j < 4; ++j) { p0[j] = __shfl_xor(v0[j], 16); p1[j] = __shfl_xor(v1[j], 16); }
                        if (fq < 2) {
                            v0[0] = v0[0] * r0[0] + sgn * p0[0] * r0[1]; v0[1] = v0[1] * r0[2] + sgn * p0[1] * r0[3];
                            v0[2] = v0[2] * r1[0] + sgn * p0[2] * r1[1]; v0[3] = v0[3] * r1[2] + sgn * p0[3] * r1[3];
                            v1[0] = v1[0] * r2[0] + sgn * p1[0] * r2[1]; v1[1] = v1[1] * r2[2] + sgn * p1[1] * r2[3];
                            v1[2] = v1[2] * r3[0] + sgn * p1[2] * r3[1]; v1[3] = v1[3] * r3[2] + sgn * p1[3] * r3[3];
                        }
                    }
                    v0 = v0 * sc; v1 = v1 * sc;
                    u32x4 w; w.x = cvt_pk_bf16(v0[0], v0[1]); w.y = cvt_pk_bf16(v0[2], v0[3]); w.z = cvt_pk_bf16(v1[0], v1[1]); w.w = cvt_pk_bf16(v1[2], v1[3]);
                    bf16_t* dst;
                    if (attn) {
                        const int cs = (u.pn & 1) * 256 + bj * 128 + wc * 32 + 8 * fq;
                        dst = XB + (size_t)(u.pn >> 1) * ((size_t)T_ * 512) + ((size_t)(cs >> 6) * T_ + prow) * 64 + (cs & 63);
                    } else dst = UH + (size_t)row * UP + (u.pn * 256 - 1536) + bj * 128 + wc * 32 + 8 * fq;
                    *(u32x4*)dst = w;
                }
            }
    }
};
struct EpiRowSS {
    static constexpr bool PERM = true, AFTER_DRAIN = false;
    bf16_t* O; float* SS;
    __device__ __forceinline__ void operator()(const f32x4 (&acc)[2][2][4][2], const Unit& u, int wr, int wc, int fr, int fq) const {
        const int row0 = u.pm * 256 + wr * 64 + fr, col0 = u.pn * 256 + wc * 32 + 8 * fq;
#pragma unroll
        for (int ai = 0; ai < 2; ++ai)
#pragma unroll
            for (int m = 0; m < 4; ++m) {
                const int row = row0 + ai * 128 + m * 16;
                bf16_t* rowp = O + (size_t)row * DM + col0;
                float s = 0.f;
#pragma unroll
                for (int bj = 0; bj < 2; ++bj) {
                    const f32x4 v0 = acc[ai][bj][m][0], v1 = acc[ai][bj][m][1];
                    s += (v0[0] * v0[0] + v0[1] * v0[1]) + (v0[2] * v0[2] + v0[3] * v0[3]) + (v1[0] * v1[0] + v1[1] * v1[1]) + (v1[2] * v1[2] + v1[3] * v1[3]);
                    u32x4 w; w.x = cvt_pk_bf16(v0[0], v0[1]); w.y = cvt_pk_bf16(v0[2], v0[3]); w.z = cvt_pk_bf16(v1[0], v1[1]); w.w = cvt_pk_bf16(v1[2], v1[3]);
                    *(u32x4*)(rowp + bj * 128) = w;
                }
                s += __shfl_xor(s, 16); s += __shfl_xor(s, 32);
                if (fq == 0) SS[(size_t)row * 16 + u.pn * 4 + wc] = s;
            }
    }
};
struct EpiSwiGLU {
    static constexpr bool PERM = true, AFTER_DRAIN = false;
    bf16_t* H;
    __device__ __forceinline__ void operator()(const f32x4 (&acc)[2][2][4][2], const Unit& u, int wr, int wc, int fr, int fq) const {
        const int row0 = u.pm * 256 + wr * 64 + fr, col0 = u.pn * 128 + wc * 32 + 8 * fq;
#pragma unroll
        for (int ai = 0; ai < 2; ++ai)
#pragma unroll
            for (int m = 0; m < 4; ++m) {
                const int row = row0 + ai * 128 + m * 16;
                const f32x4 g0 = acc[ai][0][m][0], g1 = acc[ai][0][m][1], u0 = acc[ai][1][m][0], u1 = acc[ai][1][m][1];
                f32x4 h0, h1;
#pragma unroll
                for (int j = 0; j < 4; ++j) { h0[j] = silu_f(g0[j]) * u0[j]; h1[j] = silu_f(g1[j]) * u1[j]; }
                u32x4 w; w.x = cvt_pk_bf16(h0[0], h0[1]); w.y = cvt_pk_bf16(h0[2], h0[3]); w.z = cvt_pk_bf16(h1[0], h1[1]); w.w = cvt_pk_bf16(h1[2], h1[3]);
                *(u32x4*)(H + (size_t)row * DFF + col0) = w;
            }
    }
};

template <class RowMap>
__device__ __forceinline__ void transpose_item(const float* W, int N, int k0, int n0, const float* kscale, bf16_t* WT, int K, RowMap rowmap, LAS float* scr, int lane) {
    float wv[32];
#pragma unroll
    for (int i = 0; i < 32; ++i) wv[i] = W[(size_t)(k0 + 2 * i + (lane >> 5)) * N + n0 + (lane & 31)];
#pragma unroll
    for (int i = 0; i < 32; ++i) { const int kk = 2 * i + (lane >> 5); float w = wv[i]; if (kscale) w *= kscale[k0 + kk]; scr[kk * 33 + (lane & 31)] = w; }
    LDS_WAIT();
    const int c = lane & 7;
#pragma unroll
    for (int j = 0; j < 4; ++j) { const int n = (lane >> 3) + 8 * j; const LAS float* s = scr + (8 * c) * 33 + n;
        u32x4 o; o.x = pk2(s[0 * 33], s[1 * 33]); o.y = pk2(s[2 * 33], s[3 * 33]); o.z = pk2(s[4 * 33], s[5 * 33]); o.w = pk2(s[6 * 33], s[7 * 33]);
        *(u32x4*)(WT + (size_t)rowmap(n0 + n) * K + k0 + 8 * c) = o; }
    LDS_WAIT();
}
struct RowId { __device__ __forceinline__ int operator()(int n) const { return n; } };
struct RowGU { int half; __device__ __forceinline__ int operator()(int n) const { return (n >> 7) * 256 + half * 128 + (n & 127); } };

struct Params {
    const float* xp; const float* xs; const float* w_in; const float* w_out; const float* lb_fwd; const float* lb_bwd; const float* g_hgrn;
    const float* g_pre_mix; const float* g_post_mix; const float* g_pre_ffn; const float* g_post_ffn; const float* w_gate; const float* w_up; const float* w_down;
    float* out; unsigned char* ws;
};
__device__ __forceinline__ const float* xrow_ptr(const Params& p, int row) { return row < ROWS_P ? p.xp + (size_t)row * DM : p.xs + (size_t)(row - ROWS_P) * DM; }

__device__ __forceinline__ void p0_prologue(const Params& p, LAS unsigned char* lds, int gw, int ngw, int wave, int lane) {
    unsigned char* dob = (unsigned char*)p.out;
    bf16_t* WIN = (bf16_t*)(dob + DO_WIN); bf16_t* WOUT = (bf16_t*)(dob + DO_WOUT); float* rope = (float*)(dob + DO_ROPE); bf16_t* XN = (bf16_t*)(dob + DO_XN);
    LAS float* scr = (LAS float*)(lds + wave * 16384);
    constexpr int I_IN = 16 * 128, I_OUT = 16 * 32;
    for (int it = gw; it < I_IN + I_OUT; it += ngw) {
        if (it < I_IN) transpose_item(p.w_in, NIN, 64 * (it / 128), 32 * (it % 128), p.g_pre_mix, WIN, DM, RowId{}, scr, lane);
        else { const int r = it - I_IN; transpose_item(p.w_out, DM, 64 * (r / 32), 32 * (r % 32), nullptr, WOUT, DM, RowId{}, scr, lane); }
    }
    {
        const int gt = gw * 64 + lane, ngt = ngw * 64;
        for (int e = gt; e < 16384 * 8; e += ngt) {
            const int pos = e >> 3, i = e & 7;
            const double rv = i == 0 ? 0.15915494309189535 : i == 1 ? 0.03086376340470123 : i == 2 ? 0.005985185712713705 : i == 3 ? 0.001160663641240061
                            : i == 4 ? 0.00022507907903927653 : i == 5 ? 4.364795279280289e-05 : i == 6 ? 8.464330808241401e-06 : 1.6414262627950345e-06;
            double a = (double)pos * rv; a -= floor(a);
            const float af = (float)a;
            rope[2 * e] = __builtin_amdgcn_cosf(af); rope[2 * e + 1] = __builtin_amdgcn_sinf(af);
        }
    }
    for (int m0 = gw * 4; m0 < T_; m0 += ngw * 4) {
        f32x4 v[4][4]; float s[4];
#pragma unroll
        for (int k = 0; k < 4; ++k) { const f32x4* xr = (const f32x4*)xrow_ptr(p, m0 + k) + lane;
#pragma unroll
            for (int j = 0; j < 4; ++j) v[k][j] = __builtin_nontemporal_load(&xr[64 * j]); }
#pragma unroll
        for (int k = 0; k < 4; ++k) { s[k] = 0.f;
#pragma unroll
            for (int j = 0; j < 4; ++j) s[k] += (v[k][j][0] * v[k][j][0] + v[k][j][1] * v[k][j][1]) + (v[k][j][2] * v[k][j][2] + v[k][j][3] * v[k][j][3]); }
#pragma unroll
        for (int k = 0; k < 4; ++k) {
            const float rstd = rsqrtf(wave_sum(s[k]) * (1.f / DM) + EPS);
            u32x2v* o8 = (u32x2v*)(XN + (size_t)(m0 + k) * DM) + lane;
#pragma unroll
            for (int j = 0; j < 4; ++j) { u32x2v w; w.x = cvt_pk_bf16(v[k][j][0] * rstd, v[k][j][1] * rstd); w.y = cvt_pk_bf16(v[k][j][2] * rstd, v[k][j][3] * rstd); __builtin_nontemporal_store(w, &o8[64 * j]); }
        }
    }
}

namespace at {
typedef short bf16x8 __attribute__((ext_vector_type(8)));
typedef short s16x4 __attribute__((ext_vector_type(4)));
constexpr int OS = 68;
constexpr int L_OUT = 0, L_L = 272 * OS * 4, L_VS = L_L + 1024, VS_STRIDE = 144, VS_WAVE = 32 * VS_STRIDE, L_END = L_VS + 8 * VS_WAVE;
static_assert(L_END <= LDS_BYTES, "attention LDS map");

__device__ __forceinline__ void wave_tile(const bf16_t* XBp, LAS unsigned char* lds, int w, int lane, int base, int S, int P0, int h, int idx) {
    const int n = lane & 15, quad = lane >> 4;
    const int br = idx >> 4, sub = idx & 15;
    const int dsh = 2 * br, dil = 1 << dsh;
    const int r = br == 0 ? 0 : (br == 1 ? (sub & 3) : sub);
    const int mt = br == 0 ? sub : (br == 1 ? (sub >> 2) : 0);
    const int Lsub = S >> dsh, m0 = (P0 >> dsh) + 16 * mt;
    const bf16_t* Qb = XBp + ((size_t)h * T_ + base) * 64;
    const bf16_t* Kb = Qb + (size_t)T_ * 512, * Vb = Kb + (size_t)T_ * 512;
    const int sh16 = (S == 16384) ? 10 : 8;
#define AT_ROW(pos) ((((pos) & 15) << sh16) + ((pos) >> 4))
    bf16x8 qf[2];
    { const int pq = (m0 + n) * dil + r; const bf16_t* qp = Qb + (size_t)AT_ROW(pq) * 64 + 8 * quad; qf[0] = *(const bf16x8*)qp; qf[1] = *(const bf16x8*)(qp + 32); }
    bf16x8 kf[9][2];
#pragma unroll
    for (int kt = 0; kt < 9; ++kt) {
        int mk = m0 - 64 + 16 * kt + n; mk = mk < 0 ? 0 : (mk >= Lsub ? Lsub - 1 : mk);
        const int pk = mk * dil + r;
        const bf16_t* kp = Kb + (size_t)AT_ROW(pk) * 64 + 8 * quad; kf[kt][0] = *(const bf16x8*)kp; kf[kt][1] = *(const bf16x8*)(kp + 32);
    }
    u32x4 vr[5][4];
#pragma unroll
    for (int t = 0; t < 5; ++t)
#pragma unroll
        for (int e = 0; e < 4; ++e) {
            const int id = lane + 64 * e, rho = id >> 3, ch = id & 7;
            int mk = m0 - 64 + 32 * t + rho; mk = mk < 0 ? 0 : (mk >= Lsub ? Lsub - 1 : mk);
            const int pv = mk * dil + r;
            vr[t][e] = *(const u32x4*)(Vb + (size_t)AT_ROW(pv) * 64 + 8 * ch);
        }
    unsigned pk[10][2];
    float lsum = 0.f;
#pragma unroll
    for (int kt = 0; kt < 9; ++kt) {
        f32x4 sc = {0.f, 0.f, 0.f, 0.f};
        sc = __builtin_amdgcn_mfma_f32_16x16x32_bf16(kf[kt][0], qf[0], sc, 0, 0, 0);
        sc = __builtin_amdgcn_mfma_f32_16x16x32_bf16(kf[kt][1], qf[1], sc, 0, 0, 0);
        float pv[4];
#pragma unroll
        for (int j = 0; j < 4; ++j) {
            const int ko = 16 * kt + 4 * quad + j, mk = m0 - 64 + ko;
            const bool valid = (ko >= n) && (ko <= n + 128) && (mk >= 0) && (mk < Lsub);
            const float e = __expf(fminf(sc[j], 80.f));
            pv[j] = valid ? e : 0.f; lsum += pv[j];
        }
        pk[kt][0] = cvt_pk_bf16(pv[0], pv[1]); pk[kt][1] = cvt_pk_bf16(pv[2], pv[3]);
    }
    pk[9][0] = 0u; pk[9][1] = 0u;
    lsum += __shfl_xor(lsum, 16); lsum += __shfl_xor(lsum, 32);
    f32x4 ot[4];
#pragma unroll
    for (int dt = 0; dt < 4; ++dt) ot[dt] = (f32x4){0.f, 0.f, 0.f, 0.f};
    LAS unsigned char* vs = lds + L_VS + w * VS_WAVE;
#pragma unroll
    for (int t = 0; t < 5; ++t) {
#pragma unroll
        for (int e = 0; e < 4; ++e) { const int id = lane + 64 * e, rho = id >> 3, ch = id & 7; *(LAS u32x4*)(vs + rho * VS_STRIDE + ch * 16) = vr[t][e]; }
        bf16x8 pf; { u32x4 pw = {pk[2 * t][0], pk[2 * t][1], pk[2 * t + 1][0], pk[2 * t + 1][1]}; pf = __builtin_bit_cast(bf16x8, pw); }
#pragma unroll
        for (int dt = 0; dt < 4; ++dt) {
            const int q = (lane & 15) >> 2, pp = lane & 3;
            const s16x4 lo = __builtin_amdgcn_ds_read_tr16_b64_v4i16((LAS s16x4*)(vs + (4 * quad + q) * VS_STRIDE + (16 * dt + 4 * pp) * 2));
            const s16x4 hi = __builtin_amdgcn_ds_read_tr16_b64_v4i16((LAS s16x4*)(vs + (16 + 4 * quad + q) * VS_STRIDE + (16 * dt + 4 * pp) * 2));
            const bf16x8 vf = {lo[0], lo[1], lo[2], lo[3], hi[0], hi[1], hi[2], hi[3]};
            ot[dt] = __builtin_amdgcn_mfma_f32_16x16x32_bf16(vf, pf, ot[dt], 0, 0, 0);
        }
    }
    const int posl = ((m0 + n) * dil + r) - P0;
    LAS float* op = (LAS float*)(lds + L_OUT) + (posl + (posl >> 4)) * OS + 4 * quad;
    LAS float* lp = (LAS float*)(lds + L_L) + posl;
    if (br == 0) {
#pragma unroll
        for (int dt = 0; dt < 4; ++dt) *(LAS f32x4*)(op + 16 * dt) = ot[dt];
        if (quad == 0) *lp = lsum;
    } else {
        f32x4 old[4];
#pragma unroll
        for (int dt = 0; dt < 4; ++dt) old[dt] = *(const LAS f32x4*)(op + 16 * dt);
        const float lo = *lp;
#pragma unroll
        for (int dt = 0; dt < 4; ++dt) *(LAS f32x4*)(op + 16 * dt) = old[dt] + ot[dt];
        if (quad == 0) *lp = lo + lsum;
    }
}
__device__ __forceinline__ void attn_phase(const bf16_t* XBp, bf16_t* MIXIN, LAS unsigned char* lds, int blk, int G) {
    const int tid = otid(), lane = tid & 63, w = __builtin_amdgcn_readfirstlane(tid >> 6);
    __syncthreads();
    for (int u = blk; u < 2048; u += G) {
        int grp = u >> 3, h = u & 7;
        if (G == 256) { const int x = u & 7, j = (u >> 3) & 31, e8 = u >> 8; h = e8; grp = 32 * x + j; }
        const int row0 = grp * 256;
        const int base = row0 < ROWS_P ? (row0 & ~16383) : (ROWS_P + ((row0 - ROWS_P) & ~4095)), S = row0 < ROWS_P ? 16384 : 4096, P0 = row0 - base;
        for (int br = 0; br < 3; ++br) {
            wave_tile(XBp, lds, w, lane, base, S, P0, h, 16 * br + w);
            wave_tile(XBp, lds, w, lane, base, S, P0, h, 16 * br + w + 8);
            __syncthreads();
        }
        {
            const int pos = tid >> 1, half = tid & 1;
            const LAS float* op = (const LAS float*)(lds + L_OUT) + (pos + (pos >> 4)) * OS + 32 * half;
            const float inv = 1.f / ((const LAS float*)(lds + L_L))[pos];
            unsigned wv[16];
#pragma unroll
            for (int d = 0; d < 16; ++d) wv[d] = cvt_pk_bf16(op[2 * d] * inv, op[2 * d + 1] * inv);
            u32x4* gp = (u32x4*)(MIXIN + (size_t)(row0 + pos) * DM + h * 64 + 32 * half);
#pragma unroll
            for (int c = 0; c < 4; ++c) gp[c] = (u32x4){wv[4 * c], wv[4 * c + 1], wv[4 * c + 2], wv[4 * c + 3]};
        }
        __syncthreads();
    }
}
}

namespace hg {
typedef short bf16x8 __attribute__((ext_vector_type(8)));
constexpr int SEG = 1024, NCH = 16, NITEM = 512;
constexpr int RS = 272, TS = 144;
constexpr int L_QT = 0, L_QR = 17408, L_KR = 34816, L_K0 = 52224, L_Q4 = 56576, L_KT = 60928, L_VT = 79360, L_ST = 97792, L_AB = 132608, L_TOT = 141824, L_BV = 143872, L_END = 144384;
static_assert(L_END <= LDS_BYTES, "hgrn LDS map");
constexpr size_t DO_STATE = 140 * MiB, DO_DEC = 172 * MiB, DO_OB = 176 * MiB, DO_INIT = 240 * MiB;

__device__ __forceinline__ int phys_row(int g, int dir, int lt) { return dir ? (g * SEG + SEG - 1 - lt) : (g * SEG + lt); }
__device__ __forceinline__ unsigned short bf1(float x) { __bf16 b = (__bf16)x; return __builtin_bit_cast(unsigned short, b); }
__device__ __forceinline__ bf16x8 ldfrag(LAS unsigned char* lds, int off, int stride, int row0, int kel, int lane) {
    return *(const LAS bf16x8*)(lds + off + (row0 + (lane & 15)) * stride + (kel + 8 * (lane >> 4)) * 2);
}
template <bool FULL>
__device__ __forceinline__ void load_raw(const bf16_t* U, int g, int dir, int ch, int i, int zcol, int qcol, int vcol, unsigned short (&rz)[16], unsigned short (&rq)[16], unsigned short (&rv)[16]) {
#pragma unroll
    for (int r = 0; r < 16; ++r) {
        const bf16_t* pr = U + (size_t)phys_row(g, dir, 64 * ch + 16 * i + r) * UP;
        rz[r] = __builtin_nontemporal_load(pr + zcol); if (FULL) rq[r] = __builtin_nontemporal_load(pr + qcol); rv[r] = __builtin_nontemporal_load(pr + vcol);
    }
}
template <bool FULL>
__device__ __forceinline__ void prep(LAS unsigned char* lds, int i, int c, float lb, const unsigned short (&rz)[16], const unsigned short (&rq)[16], const unsigned short (&rv)[16], float& bdec) {
    float f[16], e1[16], qs[16];
    float run = 1.f;
#pragma unroll
    for (int r = 0; r < 16; ++r) {
        const float fr = lb + (1.f - lb) * sigmoid_f(bf2f(rz[r]));
        f[r] = fr; run *= fr; e1[r] = run;
        if (FULL) qs[r] = silu_f(bf2f(rq[r])); else qs[r] = 0.f;
    }
    ((LAS float*)(lds + L_TOT))[i * 128 + c] = run;
    {
        u32x4 a, b;
        a.x = rv[0] | ((unsigned)rv[1] << 16); a.y = rv[2] | ((unsigned)rv[3] << 16); a.z = rv[4] | ((unsigned)rv[5] << 16); a.w = rv[6] | ((unsigned)rv[7] << 16);
        b.x = rv[8] | ((unsigned)rv[9] << 16); b.y = rv[10] | ((unsigned)rv[11] << 16); b.z = rv[12] | ((unsigned)rv[13] << 16); b.w = rv[14] | ((unsigned)rv[15] << 16);
        LAS u32x4* vp = (LAS u32x4*)(lds + L_VT + c * TS + 32 * i); vp[0] = a; vp[1] = b;
    }
    __syncthreads();
    const LAS float* tp = (const LAS float*)(lds + L_TOT) + c;
    const float p0 = tp[0], p1 = tp[128], p2 = tp[256], p3 = tp[384];
    const float cQT = i == 0 ? 1.f : i == 1 ? p0 : i == 2 ? p0 * p1 : p0 * p1 * p2;
    const float cKT = i == 0 ? p1 * p2 * p3 : i == 1 ? p2 * p3 : i == 2 ? p3 : 1.f;
    const float cQR = i == 0 ? 1.f : i == 1 ? __builtin_amdgcn_rcpf(p1) : i == 2 ? 1.f : p2;
    const float cKR = i == 0 ? p1 : i == 1 ? 1.f : i == 2 ? __builtin_amdgcn_rcpf(p2) : 1.f;
    const float cK0 = __builtin_amdgcn_rcpf(p0), cQ4 = __builtin_amdgcn_rcpf(p3);
    bdec = (p0 * p1) * (p2 * p3);
    if (i == 0) ((LAS float*)(lds + L_BV))[c] = bdec;
    unsigned short kt[16];
    float e2 = 1.f;
#pragma unroll
    for (int r = 15; r >= 0; --r) {
        const float kb = (1.f - f[r]) * e2;
        kt[r] = bf1(kb * cKT);
        if (FULL) {
            *(LAS unsigned short*)(lds + L_KR + (16 * i + r) * RS + c * 2) = bf1(kb * cKR);
            if (i == 0) *(LAS unsigned short*)(lds + L_K0 + r * RS + c * 2) = bf1(kb * cK0);
        }
        e2 *= f[r];
    }
    {
        u32x4 a, b;
        a.x = kt[0] | ((unsigned)kt[1] << 16); a.y = kt[2] | ((unsigned)kt[3] << 16); a.z = kt[4] | ((unsigned)kt[5] << 16); a.w = kt[6] | ((unsigned)kt[7] << 16);
        b.x = kt[8] | ((unsigned)kt[9] << 16); b.y = kt[10] | ((unsigned)kt[11] << 16); b.z = kt[12] | ((unsigned)kt[13] << 16); b.w = kt[14] | ((unsigned)kt[15] << 16);
        LAS u32x4* kp = (LAS u32x4*)(lds + L_KT + c * TS + 32 * i); kp[0] = a; kp[1] = b;
    }
    if (FULL) {
#pragma unroll
        for (int r = 0; r < 16; ++r) {
            const float qe = qs[r] * e1[r];
            *(LAS unsigned short*)(lds + L_QT + (16 * i + r) * RS + c * 2) = bf1(qe * cQT);
            *(LAS unsigned short*)(lds + L_QR + (16 * i + r) * RS + c * 2) = bf1(qe * cQR);
            if (i == 3) *(LAS unsigned short*)(lds + L_Q4 + r * RS + c * 2) = bf1(qe * cQ4);
        }
    }
}
__device__ __forceinline__ void state_update(LAS unsigned char* lds, f32x4 (&S)[8], int w, int gq, int lane) {
    bf16x8 ktf[2];
#pragma unroll
    for (int k2 = 0; k2 < 2; ++k2) ktf[k2] = ldfrag(lds, L_KT, TS, 16 * w, 32 * k2, lane);
    const f32x4 dk = *(const LAS f32x4*)(lds + L_BV + (16 * w + 4 * gq) * 4);
#pragma unroll
    for (int n = 0; n < 8; ++n) {
        S[n] = S[n] * dk;
#pragma unroll
        for (int k2 = 0; k2 < 2; ++k2) S[n] = __builtin_amdgcn_mfma_f32_16x16x32_bf16(ktf[k2], ldfrag(lds, L_VT, TS, 16 * n, 32 * k2, lane), S[n], 0, 0, 0);
    }
}
__device__ __forceinline__ int item_of(int lin, int G) {
    if (G != 256) return lin;
    const int x = lin & 7, j = (lin >> 3) & 31, e = lin >> 8, g = 8 * x + 2 * (j >> 3) + e, hd = j & 7;
    return g * 8 + hd;
}
__device__ __forceinline__ float lb_of(const Params& p, int dir, int col) { const float* lbr = dir ? p.lb_bwd : p.lb_fwd; return 1.f / (1.f + __expf(lbr[512 + col] - lbr[col])); }

__device__ __forceinline__ void pass1(const Params& p, const bf16_t* U, LAS unsigned char* lds, int item) {
    const int tid = otid(), lane = tid & 63, w = __builtin_amdgcn_readfirstlane(tid >> 6), i = w >> 1, c = tid & 127, gq = lane >> 4;
    const int dir = item & 1, hh = (item >> 1) & 3, g = item >> 3;
    float* STATE = (float*)((unsigned char*)p.out + DO_STATE); float* DEC = (float*)((unsigned char*)p.out + DO_DEC);
    const float lb = lb_of(p, dir, hh * 128 + c);
    const int zcol = (dir ? UC_ZB : UC_ZF) + hh * 128 + c, qcol = UC_QH + hh * 128 + c, vcol = UC_IH + hh * 128 + c;
    f32x4 S[8];
#pragma unroll
    for (int n = 0; n < 8; ++n) S[n] = (f32x4){0.f, 0.f, 0.f, 0.f};
    float dtot = 1.f;
    unsigned short rz[16], rq[16], rv[16];
    load_raw<false>(U, g, dir, 0, i, zcol, qcol, vcol, rz, rq, rv);
    for (int ch = 0; ch < NCH; ++ch) {
        float bdec;
        prep<false>(lds, i, c, lb, rz, rq, rv, bdec);
        dtot *= bdec;
        if (ch + 1 < NCH) load_raw<false>(U, g, dir, ch + 1, i, zcol, qcol, vcol, rz, rq, rv);
        __syncthreads();
        state_update(lds, S, w, gq, lane);
        __syncthreads();
    }
    float* sp = STATE + (size_t)item * 16384 + (16 * w + 4 * gq) * 128 + (lane & 15);
#pragma unroll
    for (int n = 0; n < 8; ++n)
#pragma unroll
        for (int jj = 0; jj < 4; ++jj) sp[jj * 128 + 16 * n] = S[n][jj];
    if (i == 0) DEC[item * 128 + c] = dtot;
}
__device__ __forceinline__ void scan(const Params& p, int gt, int ngt) {
    const float* STATE = (const float*)((unsigned char*)p.out + DO_STATE); const float* DEC = (const float*)((unsigned char*)p.out + DO_DEC);
    bf16_t* INIT = (bf16_t*)((unsigned char*)p.out + DO_INIT);
    for (int e = gt; e < 80 * 4096; e += ngt) {
        const int chain = e >> 12, q4 = e & 4095, k = q4 >> 5;
        const int dir = chain & 1, hh = (chain >> 1) & 3, sb = chain >> 3;
        const int nseg = sb < 2 ? 16 : 4, g0 = sb < 2 ? sb * 16 : 32 + (sb - 2) * 4;
        f32x4 s = {0.f, 0.f, 0.f, 0.f};
        for (int j = 0; j < nseg; ++j) {
            const int g = dir ? (g0 + nseg - 1 - j) : (g0 + j), item = (g * 4 + hh) * 2 + dir;
            const f32x4 en = *((const f32x4*)(STATE + (size_t)item * 16384) + q4);
            u32x2v wv; wv.x = cvt_pk_bf16(s[0], s[1]); wv.y = cvt_pk_bf16(s[2], s[3]);
            *((u32x2v*)(INIT + (size_t)item * 16384) + q4) = wv;
            s = s * DEC[item * 128 + k] + en;
        }
    }
}
__device__ __forceinline__ void pass2(const Params& p, const bf16_t* U, bf16_t* MIXIN, LAS unsigned char* lds, int item) {
    const int tid = otid(), lane = tid & 63, w = __builtin_amdgcn_readfirstlane(tid >> 6), i = w >> 1, c = tid & 127, gq = lane >> 4;
    const int dir = item & 1, hh = (item >> 1) & 3, g = item >> 3;
    const bf16_t* INIT = (const bf16_t*)((unsigned char*)p.out + DO_INIT);
    bf16_t* OUT = dir ? (bf16_t*)((unsigned char*)p.out + DO_OB) + hh * 128 : MIXIN + 512 + hh * 128;
    const int opitch = dir ? 512 : DM;
    const float lb = lb_of(p, dir, hh * 128 + c);
    const int zcol = (dir ? UC_ZB : UC_ZF) + hh * 128 + c, qcol = UC_QH + hh * 128 + c, vcol = UC_IH + hh * 128 + c;
    for (int idx = tid; idx < 64 * TS / 4; idx += 512) ((LAS unsigned*)(lds + L_AB))[idx] = 0u;
    f32x4 S[8];
    {
        const bf16_t* sp = INIT + (size_t)item * 16384 + (16 * w + 4 * gq) * 128 + (lane & 15);
#pragma unroll
        for (int n = 0; n < 8; ++n)
#pragma unroll
            for (int jj = 0; jj < 4; ++jj) S[n][jj] = bf2f(sp[jj * 128 + 16 * n]);
    }
#define HG_ST_WRITE() do { _Pragma("unroll") for (int n = 0; n < 8; ++n) { u32x2v wv; wv.x = cvt_pk_bf16(S[n][0], S[n][1]); wv.y = cvt_pk_bf16(S[n][2], S[n][3]); \
        *(LAS u32x2v*)(lds + L_ST + (16 * n + (lane & 15)) * RS + (16 * w + 4 * gq) * 2) = wv; } } while (0)
    HG_ST_WRITE();
    unsigned short rz[16], rq[16], rv[16];
    load_raw<true>(U, g, dir, 0, i, zcol, qcol, vcol, rz, rq, rv);
    for (int ch = 0; ch < NCH; ++ch) {
        float bdec;
        prep<true>(lds, i, c, lb, rz, rq, rv, bdec);
        if (ch + 1 < NCH) load_raw<true>(U, g, dir, ch + 1, i, zcol, qcol, vcol, rz, rq, rv);
        __syncthreads();
        for (int bi = w; bi < 10; bi += 8) {
            const int ti = bi >= 6 ? 3 : bi >= 3 ? 2 : bi >= 1 ? 1 : 0, tj = bi - ti * (ti + 1) / 2;
            const int qoff = (bi == 9) ? L_Q4 : L_QR + 16 * ti * RS, koff = (bi == 0) ? L_K0 : L_KR + 16 * tj * RS;
            f32x4 a = {0.f, 0.f, 0.f, 0.f};
#pragma unroll
            for (int ks = 0; ks < 4; ++ks) a = __builtin_amdgcn_mfma_f32_16x16x32_bf16(ldfrag(lds, qoff, RS, 0, 32 * ks, lane), ldfrag(lds, koff, RS, 0, 32 * ks, lane), a, 0, 0, 0);
#pragma unroll
            for (int jj = 0; jj < 4; ++jj) {
                float val = a[jj];
                if (ti == tj && (lane & 15) > 4 * gq + jj) val = 0.f;
                *(LAS unsigned short*)(lds + L_AB + (16 * ti + 4 * gq + jj) * TS + (16 * tj + (lane & 15)) * 2) = bf1(val);
            }
        }
        __syncthreads();
        {
            bf16x8 stf[4], vtf[2];
#pragma unroll
            for (int ks = 0; ks < 4; ++ks) stf[ks] = ldfrag(lds, L_ST, RS, 16 * w, 32 * ks, lane);
#pragma unroll
            for (int k2 = 0; k2 < 2; ++k2) vtf[k2] = ldfrag(lds, L_VT, TS, 16 * w, 32 * k2, lane);
#pragma unroll
            for (int mt = 0; mt < 4; ++mt) {
                f32x4 o = {0.f, 0.f, 0.f, 0.f};
#pragma unroll
                for (int ks = 0; ks < 4; ++ks) o = __builtin_amdgcn_mfma_f32_16x16x32_bf16(ldfrag(lds, L_QT, RS, 16 * mt, 32 * ks, lane), stf[ks], o, 0, 0, 0);
#pragma unroll
                for (int k2 = 0; k2 < 2; ++k2) o = __builtin_amdgcn_mfma_f32_16x16x32_bf16(ldfrag(lds, L_AB, TS, 16 * mt, 32 * k2, lane), vtf[k2], o, 0, 0, 0);
#pragma unroll
                for (int jj = 0; jj < 4; ++jj) {
                    const int row = phys_row(g, dir, 64 * ch + 16 * mt + 4 * gq + jj);
                    OUT[(size_t)row * opitch + 16 * w + (lane & 15)] = bf1(o[jj]);
                }
            }
        }
        state_update(lds, S, w, gq, lane);
        __syncthreads();
        HG_ST_WRITE();
    }
#undef HG_ST_WRITE
}
}

__device__ __forceinline__ void hg_finalize(const Params& p, const bf16_t* U, bf16_t* MIXIN, int blk, int G, int wave, int lane) {
    const float gn0 = p.g_hgrn[2 * lane], gn1 = p.g_hgrn[2 * lane + 1];
    const bf16_t* OB = (const bf16_t*)((const unsigned char*)p.out + hg::DO_OB);
    const int gw = blk * 8 + wave, ngw = G * 8;
    for (int r0 = gw * 4; r0 < T_; r0 += ngw * 4) {
        unsigned wm[4][4], wg[4][4], wo[4][4];
#pragma unroll
        for (int k = 0; k < 4; ++k)
#pragma unroll
            for (int hh = 0; hh < 4; ++hh) {
                const int row = r0 + k;
                wm[k][hh] = *((const unsigned*)(MIXIN + (size_t)row * DM + 512 + hh * 128) + lane);
                wg[k][hh] = *((const unsigned*)(U + (size_t)row * UP + UC_GH + hh * 128) + lane);
                wo[k][hh] = *((const unsigned*)(OB + (size_t)row * 512 + hh * 128) + lane);
            }
#pragma unroll
        for (int k = 0; k < 4; ++k)
#pragma unroll
            for (int hh = 0; hh < 4; ++hh) {
                const unsigned w = wm[k][hh], gw2 = wg[k][hh], wb = wo[k][hh];
                const float o0 = __uint_as_float(w << 16) + __uint_as_float(wb << 16), o1 = __uint_as_float(w & 0xffff0000u) + __uint_as_float(wb & 0xffff0000u);
                const float g0 = __uint_as_float(gw2 << 16), g1 = __uint_as_float(gw2 & 0xffff0000u);
                const float rs = rsqrtf(wave_sum(o0 * o0 + o1 * o1) * (1.f / 128.f) + EPS);
                *((unsigned*)(MIXIN + (size_t)(r0 + k) * DM + 512 + hh * 128) + lane) = cvt_pk_bf16(o0 * rs * gn0 * silu_f(g0), o1 * rs * gn1 * silu_f(g1));
            }
    }
}

__device__ __forceinline__ void p6_rows(const Params& p, LAS unsigned char* lds, int gw, int ngw, int wave, int lane) {
    bf16_t* WGU = (bf16_t*)(p.ws + WS_WGU); bf16_t* WDN = (bf16_t*)(p.ws + WS_WDN);
    LAS float* scr = (LAS float*)(lds + wave * 16384);
    constexpr int I_G = 16 * 88, I_D = 44 * 32;
    for (int it = gw; it < 2 * I_G + I_D; it += ngw) {
        if (it < I_G) transpose_item(p.w_gate, DFF, 64 * (it / 88), 32 * (it % 88), p.g_pre_ffn, WGU, DM, RowGU{0}, scr, lane);
        else if (it < 2 * I_G) { const int r = it - I_G; transpose_item(p.w_up, DFF, 64 * (r / 88), 32 * (r % 88), p.g_pre_ffn, WGU, DM, RowGU{1}, scr, lane); }
        else { const int r = it - 2 * I_G; transpose_item(p.w_down, DM, 64 * (r / 32), 32 * (r % 32), nullptr, WDN, DFF, RowId{}, scr, lane); }
    }
    bf16_t* MIX = (bf16_t*)(p.ws + WS_MIX); const float* SS = (const float*)(p.ws + WS_SS1);
    f32x4 gp[4];
#pragma unroll
    for (int j = 0; j < 4; ++j) gp[j] = ((const f32x4*)p.g_post_mix)[lane + 64 * j];
    for (int m0 = gw * 4; m0 < T_; m0 += ngw * 4) {
        f32x4 xv[4][4]; u32x2v mw[4][4]; float r1[4];
#pragma unroll
        for (int k = 0; k < 4; ++k) {
            const int m = m0 + k;
            const f32x4* ssp = (const f32x4*)(SS + (size_t)m * 16);
            const f32x4 a = ssp[0], b = ssp[1], c = ssp[2], d = ssp[3];
            const float ss = ((a[0] + a[1]) + (a[2] + a[3])) + ((b[0] + b[1]) + (b[2] + b[3])) + ((c[0] + c[1]) + (c[2] + c[3])) + ((d[0] + d[1]) + (d[2] + d[3]));
            r1[k] = rsqrtf(ss * (1.f / DM) + EPS);
            const f32x4* xr = (const f32x4*)xrow_ptr(p, m) + lane;
            const u32x2v* mx = (const u32x2v*)(MIX + (size_t)m * DM) + lane;
#pragma unroll
            for (int jj = 0; jj < 4; ++jj) { xv[k][jj] = __builtin_nontemporal_load(&xr[64 * jj]); mw[k][jj] = __builtin_nontemporal_load(&mx[64 * jj]); }
        }
        float s2[4];
#pragma unroll
        for (int k = 0; k < 4; ++k) {
            f32x4* xo = (f32x4*)(p.out + (size_t)(m0 + k) * DM) + lane;
            s2[k] = 0.f;
#pragma unroll
            for (int jj = 0; jj < 4; ++jj) {
                const u32x2v w = mw[k][jj];
                f32x4 mv = {__uint_as_float(w.x << 16), __uint_as_float(w.x & 0xffff0000u), __uint_as_float(w.y << 16), __uint_as_float(w.y & 0xffff0000u)};
                xv[k][jj] = xv[k][jj] + mv * r1[k] * gp[jj];
                s2[k] += (xv[k][jj][0] * xv[k][jj][0] + xv[k][jj][1] * xv[k][jj][1]) + (xv[k][jj][2] * xv[k][jj][2] + xv[k][jj][3] * xv[k][jj][3]);
                __builtin_nontemporal_store(xv[k][jj], &xo[64 * jj]);
            }
        }
#pragma unroll
        for (int k = 0; k < 4; ++k) {
            const float r2 = rsqrtf(wave_sum(s2[k]) * (1.f / DM) + EPS);
            u32x2v* mx = (u32x2v*)(MIX + (size_t)(m0 + k) * DM) + lane;
#pragma unroll
            for (int jj = 0; jj < 4; ++jj) { u32x2v w; w.x = cvt_pk_bf16(xv[k][jj][0] * r2, xv[k][jj][1] * r2); w.y = cvt_pk_bf16(xv[k][jj][2] * r2, xv[k][jj][3] * r2); __builtin_nontemporal_store(w, &mx[64 * jj]); }
        }
    }
}
__device__ __forceinline__ void p9_rows(const Params& p, int gw, int ngw, int lane) {
    const bf16_t* FF = (const bf16_t*)(p.ws + WS_MIX); const float* SS = (const float*)(p.ws + WS_SS2);
    f32x4 gp[4];
#pragma unroll
    for (int j = 0; j < 4; ++j) gp[j] = ((const f32x4*)p.g_post_ffn)[lane + 64 * j];
    for (int m0 = gw * 4; m0 < T_; m0 += ngw * 4) {
        f32x4 xv[4][4]; u32x2v fw[4][4]; float r1[4];
#pragma unroll
        for (int k = 0; k < 4; ++k) {
            const int m = m0 + k;
            const f32x4* ssp = (const f32x4*)(SS + (size_t)m * 16);
            const f32x4 a = ssp[0], b = ssp[1], c = ssp[2], d = ssp[3];
            const float ss = ((a[0] + a[1]) + (a[2] + a[3])) + ((b[0] + b[1]) + (b[2] + b[3])) + ((c[0] + c[1]) + (c[2] + c[3])) + ((d[0] + d[1]) + (d[2] + d[3]));
            r1[k] = rsqrtf(ss * (1.f / DM) + EPS);
            const u32x2v* fx = (const u32x2v*)(FF + (size_t)m * DM) + lane;
            const f32x4* xo = (const f32x4*)(p.out + (size_t)m * DM) + lane;
#pragma unroll
            for (int jj = 0; jj < 4; ++jj) { xv[k][jj] = __builtin_nontemporal_load(&xo[64 * jj]); fw[k][jj] = __builtin_nontemporal_load(&fx[64 * jj]); }
        }
#pragma unroll
        for (int k = 0; k < 4; ++k) {
            f32x4* xo = (f32x4*)(p.out + (size_t)(m0 + k) * DM) + lane;
#pragma unroll
            for (int jj = 0; jj < 4; ++jj) {
                const u32x2v w = fw[k][jj];
                f32x4 fv = {__uint_as_float(w.x << 16), __uint_as_float(w.x & 0xffff0000u), __uint_as_float(w.y << 16), __uint_as_float(w.y & 0xffff0000u)};
                __builtin_nontemporal_store(xv[k][jj] + fv * r1[k] * gp[jj], &xo[64 * jj]);
            }
        }
    }
}

__global__ void __launch_bounds__(512, 2) fwd_megakernel(Params p) {
    extern __shared__ __attribute__((aligned(16))) unsigned char lds_raw[];
    LAS unsigned char* lds = (LAS unsigned char*)lds_raw;
    cg::grid_group grid = cg::this_grid();
#define GSYNC() do { asm volatile("s_waitcnt vmcnt(0)" ::: "memory"); grid.sync(); \
        if (wave == 0) { __builtin_amdgcn_fence(__ATOMIC_ACQUIRE, "agent"); asm volatile("s_waitcnt vmcnt(0)" ::: "memory"); } __syncthreads(); } while (0)
    const int tid = otid(), lane = tid & 63, wave = __builtin_amdgcn_readfirstlane(tid >> 6);
    const int G = gridDim.x, blk = blockIdx.x;
    const int gw = blk * 8 + wave, ngw = G * 8;
    unsigned char* dob = (unsigned char*)p.out;
    bf16_t* U = (bf16_t*)(p.ws + WS_U);
    bf16_t* MIXIN = (bf16_t*)(dob + DO_MIXIN);

    volatile LAS unsigned* bst = (volatile LAS unsigned*)(lds + LDS_BYTES - 16);
    if (tid < 2) bst[tid] = 0u;
    if (blk == 0) for (int i2 = tid; i2 < 3456; i2 += 512) __hip_atomic_store(g_bar + i2, 0u, __ATOMIC_RELAXED, __HIP_MEMORY_SCOPE_AGENT);
    p0_prologue(p, lds, gw, ngw, wave, lane);
    GSYNC();
    const XcdBarrier xbar = xcd_barrier_post(g_bar, bst);
#define XSYNC() xcd_barrier(xbar)
    {
        pg8::Gemm g{(const bf16_t*)(dob + DO_XN), (const bf16_t*)(dob + DO_WIN), T_, NIN, DM}; pg8::StaticOrder S; S.init(T_, NIN, G, blk);
        EpiU E{U, (bf16_t*)(p.ws + WS_QB), (const float*)(dob + DO_ROPE)};
        pg8::gemm_phase<EpiU, pg8::StaticOrder, true, true>(lds, g, S, E);
    }
    XSYNC();
    for (int lin = blk; lin < hg::NITEM; lin += G) hg::pass1(p, U, lds, hg::item_of(lin, G));
    at::attn_phase((const bf16_t*)(p.ws + WS_QB), MIXIN, lds, blk, G);
    XSYNC();
    hg::scan(p, blk * 512 + tid, G * 512);
    XSYNC();
    for (int lin = blk; lin < hg::NITEM; lin += G) hg::pass2(p, U, MIXIN, lds, hg::item_of(lin, G));
    XSYNC();
    hg_finalize(p, U, MIXIN, blk, G, wave, lane);
    XSYNC();
    {
        pg8::Gemm g{MIXIN, (const bf16_t*)(dob + DO_WOUT), T_, DM, DM}; pg8::StaticOrder S; S.init(T_, DM, G, blk);
        EpiRowSS E{(bf16_t*)(p.ws + WS_MIX), (float*)(p.ws + WS_SS1)};
        pg8::gemm_phase<EpiRowSS, pg8::StaticOrder, true, true>(lds, g, S, E);
    }
    XSYNC();
    p6_rows(p, lds, gw, ngw, wave, lane);
    XSYNC();
    {
        pg8::Gemm g{(const bf16_t*)(p.ws + WS_MIX), (const bf16_t*)(p.ws + WS_WGU), T_, 2 * DFF, DM}; pg8::StaticOrder S; S.init(T_, 2 * DFF, G, blk);
        EpiSwiGLU E{(bf16_t*)(p.ws + WS_HFF)};
        pg8::gemm_phase<EpiSwiGLU, pg8::StaticOrder, true, true>(lds, g, S, E);
    }
    XSYNC();
    {
        pg8::Gemm g{(const bf16_t*)(p.ws + WS_HFF), (const bf16_t*)(p.ws + WS_WDN), T_, DM, DFF}; pg8::StaticOrder S; S.init(T_, DM, G, blk);
        EpiRowSS E{(bf16_t*)(p.ws + WS_MIX), (float*)(p.ws + WS_SS2)};
        pg8::gemm_phase<EpiRowSS, pg8::StaticOrder, true, true>(lds, g, S, E);
    }
    XSYNC();
    p9_rows(p, gw, ngw, lane);
}

extern "C" void kernel_launch(void* const* d_in, const int* in_sizes, int n_in, void* d_out, int out_size, void* d_ws, size_t ws_size, hipStream_t stream) {
    static int grid_blocks = 0;
    if (grid_blocks == 0) {
        int dev = 0, cus = 0, per_cu = 0;
        hipGetDevice(&dev);
        hipDeviceGetAttribute(&cus, hipDeviceAttributeMultiprocessorCount, dev);
        hipFuncSetAttribute((const void*)fwd_megakernel, hipFuncAttributeMaxDynamicSharedMemorySize, LDS_BYTES);
        hipOccupancyMaxActiveBlocksPerMultiprocessor(&per_cu, (const void*)fwd_megakernel, 512, LDS_BYTES);
        if (per_cu < 1) { fprintf(stderr, "occupancy query reports %d blocks per CU\n", per_cu); per_cu = 1; }
        if (per_cu > 1) per_cu = 1;
        grid_blocks = cus * per_cu;
        if (ws_size < 512 * MiB) fprintf(stderr, "kernel_launch: workspace %zu smaller than the 512 MiB map\n", ws_size);
    }
    Params p{};
    p.xp = (const float*)d_in[0]; p.xs = (const float*)d_in[1]; p.w_in = (const float*)d_in[2]; p.w_out = (const float*)d_in[3];
    p.lb_fwd = (const float*)d_in[4]; p.lb_bwd = (const float*)d_in[5]; p.g_hgrn = (const float*)d_in[6]; p.g_pre_mix = (const float*)d_in[7];
    p.g_post_mix = (const float*)d_in[8]; p.g_pre_ffn = (const float*)d_in[9]; p.g_post_ffn = (const float*)d_in[10];
    p.w_gate = (const float*)d_in[11]; p.w_up = (const float*)d_in[12]; p.w_down = (const float*)d_in[13];
    p.out = (float*)d_out; p.ws = (unsigned char*)d_ws;
    void* args[] = {&p};
    hipError_t e = hipLaunchCooperativeKernel((const void*)fwd_megakernel, dim3(grid_blocks), dim3(512), args, LDS_BYTES, stream);
    if (e != hipSuccess) fprintf(stderr, "cooperative launch failed: %s (grid %d)\n", hipGetErrorString(e), grid_blocks);
}
```

```cpp
#include <hip/hip_runtime.h>
#include <hip/hip_cooperative_groups.h>
#include <cstdio>
#include <cstdint>
namespace cg = cooperative_groups;
namespace pg8 {
#define PG8_LAS __attribute__((address_space(3)))
typedef unsigned short bf16_t;
typedef short bf16x8 __attribute__((ext_vector_type(8)));
typedef float f32x4 __attribute__((ext_vector_type(4)));
typedef unsigned u32x4 __attribute__((ext_vector_type(4)));
constexpr int BM = 256, BK = 64, HALF = 128, HTB = HALF * BK * 2  , STAGE_BYTES = 8 * HTB, NXCD = 8, WGM = 8;

__host__ __device__ __forceinline__ int lds_byte(int r, int c) { const int st = (r >> 4) * 2 + (c >> 5), rr = r & 15, cc = c & 31, ob = rr * 64 + cc * 2; return st * 1024 + (ob ^ (((ob >> 9) & 1) << 5)); }
__host__ __device__ __forceinline__ void stage_rc(int b, int& R, int& C) { const int st = b / 1024, sb = b % 1024, swz = sb ^ (((sb >> 9) & 1) << 5); R = (st >> 1) * 16 + swz / 64; C = (st & 1) * 32 + (swz % 64) / 2; }
__host__ __device__ __forceinline__ int perm32(int rho) { const int n = rho >> 4, i = rho & 15; return 8 * (i >> 2) + 4 * n + (i & 3); }

struct Unit { int pm, pn; };
struct Gemm { const bf16_t* A; const bf16_t* Bt; int M, N, K; };

struct StaticOrder {
    int nM, nN, nwg, G, c;
    __host__ __device__ void init(int M, int N, int G_, int c_) { nM = M / BM; nN = N / BM; nwg = nM * nN; G = G_; c = c_; }
    __host__ __device__ bool next(int i, Unit& u) const {
        const long L = (long)i * G + c; if (L >= nwg) return false;
        int wgid = (int)L; { const int q = nwg / NXCD, r = nwg % NXCD, xcd = wgid % NXCD, off = wgid / NXCD; wgid = (xcd < r ? xcd * (q + 1) : r * (q + 1) + (xcd - r) * q) + off; }
        const int nig = WGM * nN, gid = wgid / nig, fm = gid * WGM, gsz = (nM - fm) < WGM ? (nM - fm) : WGM;
        u.pm = fm + ((wgid % nig) % gsz); u.pn = (wgid % nig) / gsz; return true;
    }
    __device__ __forceinline__ void a_ready(const Unit&) const {}
    __device__ __forceinline__ void done(const Unit&) const {}
};

typedef __bf16 bf16x2_t __attribute__((ext_vector_type(2)));
typedef float f32x2_t __attribute__((ext_vector_type(2)));
__device__ __forceinline__ unsigned cvt_pk_bf16(float lo, float hi) { f32x2_t v = {lo, hi}; bf16x2_t b = __builtin_convertvector(v, bf16x2_t); return __builtin_bit_cast(unsigned, b); }
typedef float f32x2 __attribute__((ext_vector_type(2)));
template <class Epi, class Sched, bool ALIGN_EPI = false, bool SP2 = false>
__device__ __forceinline__ void gemm_phase(PG8_LAS unsigned char* lds, const Gemm g, const Sched& S, const Epi& E) {
    int tid; asm volatile("v_mov_b32 %0, %1" : "=v"(tid) : "v"((int)threadIdx.x));
    const int wid = __builtin_amdgcn_readfirstlane(tid >> 6), lane = tid & 63, wr = wid >> 2, wc = wid & 3, fr = lane & 15, fq = lane >> 4;
    const int K = g.K, nt = K / BK;
    unsigned voffA[2], voffB[2];
#pragma unroll
    for (int i = 0; i < 2; ++i) { int R, C; stage_rc(tid * 16 + i * 8192, R, C); const int Rb = Epi::PERM ? ((R & ~31) + perm32(R & 31)) : R;
        voffA[i] = (unsigned)(R * K + C) * 2u; voffB[i] = (unsigned)(Rb * K + C) * 2u; }
    const size_t kstep = (size_t)(BK * 2);
    const size_t hstep = (size_t)HALF * K * 2;
    const size_t tstep = 2 * hstep;
    const unsigned ldsw = (unsigned)wid * 1024u;
    const int aoff = lds_byte(wr * 64 + fr, fq * 8), boff = lds_byte(wc * 32 + fr, fq * 8);
#define PG8_SA(b, h) (((b) * 2 + (h)) * HTB)
#define PG8_SB(b, h) ((4 + (b) * 2 + (h)) * HTB)
#define PG8_STAGE(bufoff, gbase, voff) do { _Pragma("unroll") for (int _i = 0; _i < 2; ++_i) \
        __builtin_amdgcn_global_load_lds((const unsigned*)((const char*)(gbase) + (voff)[_i]), (PG8_LAS unsigned*)(lds + (bufoff) + ldsw + _i * 8192), 16, 0, 0); } while (0)
#define PG8_LDA(dst, b, h) do { _Pragma("unroll") for (int m = 0; m < 4; ++m) _Pragma("unroll") for (int k = 0; k < 2; ++k) dst[m][k] = *(const PG8_LAS bf16x8*)(lds + PG8_SA(b, h) + aoff + m * 2048 + k * 1024); } while (0)
#define PG8_LDB(dst, b, h) do { _Pragma("unroll") for (int n = 0; n < 2; ++n) _Pragma("unroll") for (int k = 0; k < 2; ++k) dst[n][k] = *(const PG8_LAS bf16x8*)(lds + PG8_SB(b, h) + boff + n * 2048 + k * 1024); } while (0)
#define PG8_MMA(ai, bj, At, Bt) do { __builtin_amdgcn_s_setprio(1); _Pragma("unroll") for (int m = 0; m < 4; ++m) _Pragma("unroll") for (int n = 0; n < 2; ++n) _Pragma("unroll") for (int k = 0; k < 2; ++k) \
        acc[ai][bj][m][n] = __builtin_amdgcn_mfma_f32_16x16x32_bf16(Bt[n][k], At[m][k], acc[ai][bj][m][n], 0, 0, 0); __builtin_amdgcn_s_setprio(0); } while (0)
#define PG8_WAIT_V(n) asm volatile("s_waitcnt vmcnt(" #n ")" ::: "memory")
#define PG8_WAIT_L(n) asm volatile("s_waitcnt lgkmcnt(" #n ")" ::: "memory")
#define PG8_BAR __builtin_amdgcn_s_barrier()
#define PG8_SCHED __builtin_amdgcn_sched_barrier(0)
    Unit cur, nxt; int ui = 0;
    if (!S.next(0, cur)) return;
    f32x4 acc[2][2][4][2];
#pragma unroll
    for (int a = 0; a < 2; ++a)
#pragma unroll
        for (int b = 0; b < 2; ++b)
#pragma unroll
            for (int m = 0; m < 4; ++m)
#pragma unroll
                for (int n = 0; n < 2; ++n) acc[a][b][m][n] = (f32x4){0.f, 0.f, 0.f, 0.f};
    bf16x8 At[4][2], B0[2][2], B1[2][2];
    const char* cA = (const char*)g.A + (size_t)cur.pm * tstep; const char* cB = (const char*)g.Bt + (size_t)cur.pn * tstep;
    S.a_ready(cur);
    if constexpr (SP2) {
        PG8_STAGE(PG8_SB(0, 0), cB, voffB); PG8_STAGE(PG8_SB(0, 1), cB + hstep, voffB); PG8_STAGE(PG8_SA(0, 0), cA, voffA); PG8_STAGE(PG8_SA(0, 1), cA + hstep, voffA);
        if (wr == 1) PG8_BAR;
        PG8_WAIT_V(2); PG8_BAR;
        PG8_STAGE(PG8_SB(1, 0), cB + kstep, voffB); PG8_STAGE(PG8_SA(1, 0), cA + kstep, voffA); PG8_STAGE(PG8_SB(1, 1), cB + hstep + kstep, voffB);
        PG8_WAIT_V(6); PG8_BAR;
    } else {
        PG8_STAGE(PG8_SB(0, 0), cB, voffB); PG8_STAGE(PG8_SA(0, 0), cA, voffA); PG8_STAGE(PG8_SB(0, 1), cB + hstep, voffB); PG8_STAGE(PG8_SA(0, 1), cA + hstep, voffA);
        if (wr == 1) PG8_BAR;
        PG8_WAIT_V(4); PG8_BAR;
        PG8_STAGE(PG8_SB(1, 0), cB + kstep, voffB); PG8_STAGE(PG8_SA(1, 0), cA + kstep, voffA); PG8_STAGE(PG8_SB(1, 1), cB + hstep + kstep, voffB);
        PG8_WAIT_V(6); PG8_BAR;
    }
    for (;;) {
        const bool has_next = S.next(ui + 1, nxt);
        const char* nA = has_next ? (const char*)g.A + (size_t)nxt.pm * tstep : cA; const char* nB = has_next ? (const char*)g.Bt + (size_t)nxt.pn * tstep : cB;
        for (int t = 0; t < nt; t += 2) {
            const bool last = (t == nt - 2);
            const char* a1 = cA + (size_t)(t + 1) * kstep;
            const char* a2 = last ? nA : cA + (size_t)(t + 2) * kstep; const char* b2 = last ? nB : cB + (size_t)(t + 2) * kstep;
            const char* a3 = a2 + kstep; const char* b3 = b2 + kstep;
            if (last && has_next) S.a_ready(nxt);
            if constexpr (SP2) {
            PG8_LDB(B0, 0, 0); PG8_LDB(B1, 0, 1); PG8_SCHED; PG8_LDA(At, 0, 0); PG8_STAGE(PG8_SA(1, 1), a1 + hstep, voffA);
            PG8_WAIT_V(8); PG8_WAIT_L(0); PG8_BAR; PG8_MMA(0, 0, At, B0); PG8_MMA(0, 1, At, B1); PG8_BAR; PG8_SCHED;
            PG8_LDA(At, 0, 1); PG8_STAGE(PG8_SB(0, 0), b2, voffB); PG8_STAGE(PG8_SB(0, 1), b2 + hstep, voffB); PG8_STAGE(PG8_SA(0, 0), a2, voffA);
            PG8_WAIT_V(8); PG8_WAIT_L(0); PG8_BAR; PG8_MMA(1, 0, At, B0); PG8_MMA(1, 1, At, B1); PG8_BAR; PG8_SCHED;
            PG8_LDB(B0, 1, 0); PG8_LDB(B1, 1, 1); PG8_SCHED; PG8_LDA(At, 1, 0); PG8_STAGE(PG8_SA(0, 1), a2 + hstep, voffA);
            PG8_WAIT_V(8); PG8_WAIT_L(0); PG8_BAR; PG8_MMA(0, 0, At, B0); PG8_MMA(0, 1, At, B1); PG8_BAR; PG8_SCHED;
            PG8_LDA(At, 1, 1); PG8_STAGE(PG8_SB(1, 0), b3, voffB); PG8_STAGE(PG8_SB(1, 1), b3 + hstep, voffB); PG8_STAGE(PG8_SA(1, 0), a3, voffA);
            PG8_WAIT_V(8); PG8_WAIT_L(0); PG8_BAR; PG8_MMA(1, 0, At, B0); PG8_MMA(1, 1, At, B1); PG8_BAR; PG8_SCHED;
            } else {
            PG8_LDB(B0, 0, 0); PG8_SCHED; PG8_LDA(At, 0, 0); PG8_STAGE(PG8_SA(1, 1), a1 + hstep, voffA);
            PG8_WAIT_L(8); PG8_BAR; PG8_WAIT_L(0); PG8_MMA(0, 0, At, B0); PG8_BAR; PG8_SCHED;
            PG8_LDB(B1, 0, 1); PG8_STAGE(PG8_SB(0, 0), b2, voffB);
            PG8_BAR; PG8_WAIT_L(0); PG8_MMA(0, 1, At, B1); PG8_BAR;
            PG8_LDA(At, 0, 1); PG8_STAGE(PG8_SA(0, 0), a2, voffA);
            PG8_BAR; PG8_WAIT_L(0); PG8_MMA(1, 0, At, B0); PG8_BAR; PG8_SCHED;
            PG8_STAGE(PG8_SB(0, 1), b2 + hstep, voffB);
            PG8_WAIT_V(6); PG8_BAR; PG8_MMA(1, 1, At, B1); PG8_BAR;
            PG8_LDB(B0, 1, 0); PG8_SCHED; PG8_LDA(At, 1, 0); PG8_STAGE(PG8_SA(0, 1), a2 + hstep, voffA);
            PG8_WAIT_L(8); PG8_BAR; PG8_WAIT_L(0); PG8_MMA(0, 0, At, B0); PG8_BAR; PG8_SCHED;
            PG8_LDB(B1, 1, 1); PG8_STAGE(PG8_SB(1, 0), b3, voffB);
            PG8_BAR; PG8_WAIT_L(0); PG8_MMA(0, 1, At, B1); PG8_BAR;
            PG8_LDA(At, 1, 1); PG8_STAGE(PG8_SA(1, 0), a3, voffA);
            PG8_BAR; PG8_WAIT_L(0); PG8_MMA(1, 0, At, B0); PG8_BAR; PG8_SCHED;
            PG8_STAGE(PG8_SB(1, 1), b3 + hstep, voffB);
            PG8_WAIT_V(6); PG8_BAR; PG8_MMA(1, 1, At, B1); PG8_BAR;
            }
        }
        if constexpr (ALIGN_EPI) { if (wr == 0) PG8_BAR; }
        if constexpr (!Epi::AFTER_DRAIN) { E(acc, cur, wr, wc, fr, fq); S.done(cur); }
        if (!has_next) break;
#pragma unroll
        for (int a = 0; a < 2; ++a)
#pragma unroll
            for (int b = 0; b < 2; ++b)
#pragma unroll
                for (int m = 0; m < 4; ++m)
#pragma unroll
                    for (int n = 0; n < 2; ++n) acc[a][b][m][n] = (f32x4){0.f, 0.f, 0.f, 0.f};
        cur = nxt; cA = nA; cB = nB; ++ui;
        if constexpr (ALIGN_EPI) { if (wr == 1) PG8_BAR; }
    }
    PG8_WAIT_V(0);
    if constexpr (!ALIGN_EPI) { if (wr == 0) PG8_BAR; }
    PG8_BAR;
    if constexpr (Epi::AFTER_DRAIN) { E.fused(acc, cur, wr, wc, fr, fq, lds, wid, lane); S.done(cur); }
#undef PG8_SA
#undef PG8_SB
#undef PG8_STAGE
#undef PG8_LDA
#undef PG8_LDB
#undef PG8_MMA
#undef PG8_WAIT_V
#undef PG8_WAIT_L
#undef PG8_BAR
#undef PG8_SCHED
}
}

#define LAS __attribute__((address_space(3)))
typedef unsigned short bf16_t;
using pg8::f32x4; using pg8::u32x4; using pg8::Unit; using pg8::cvt_pk_bf16;
typedef float f32x2v __attribute__((ext_vector_type(2)));
typedef unsigned u32x2v __attribute__((ext_vector_type(2)));

constexpr int T_ = 65536, DM = 1024, NIN = 4096, DFF = 2816, ROWS_P = 32768;
constexpr size_t MiB = 1u << 20;
constexpr float EPS = 1e-6f;
constexpr int LDS_BYTES = 147456;
constexpr size_t DO_XN = 0, DO_MIXIN = 0, DO_WIN = 128 * MiB, DO_ROPE = 136 * MiB, DO_WOUT = 137 * MiB;
constexpr size_t WS_U = 0;
constexpr size_t WS_MIX = 0;
constexpr size_t WS_WGU = 128 * MiB, WS_WDN = 139 * MiB, WS_SS1 = 145 * MiB, WS_SS2 = 149 * MiB, WS_HFF = 160 * MiB;
constexpr int UP = 2560;
constexpr int UC_QH = 0, UC_ZF = 512, UC_ZB = 1024, UC_IH = 1536, UC_GH = 2048;
constexpr size_t WS_QB = 320 * MiB, WS_KB = 384 * MiB, WS_VB = 448 * MiB;
__device__ __forceinline__ int perm_row(int row) {
    if (row < ROWS_P) { const int pos = row & 16383; return (row & ~16383) + ((pos & 15) << 10) + (pos >> 4); }
    const int pos = row & 4095; return (row & ~4095) + ((pos & 15) << 8) + (pos >> 4);
}

__device__ __forceinline__ float bf2f(unsigned short h) { return __uint_as_float((unsigned)h << 16); }
__device__ __forceinline__ unsigned short f2bf(float f) { unsigned u = __float_as_uint(f); return (unsigned short)((u + 0x7fffu + ((u >> 16) & 1u)) >> 16); }
__device__ __forceinline__ unsigned pk2(float lo, float hi) { return cvt_pk_bf16(lo, hi); }
__device__ __forceinline__ float silu_f(float x) { return x * __builtin_amdgcn_rcpf(1.f + __expf(-x)); }
__device__ __forceinline__ float sigmoid_f(float x) { return __builtin_amdgcn_rcpf(1.f + __expf(-x)); }
__device__ __forceinline__ int row_pos(int row) { return row < ROWS_P ? (row & 16383) : (row & 4095); }
__device__ __forceinline__ int row_S(int row) { return row < ROWS_P ? 16384 : 4096; }
__device__ __forceinline__ float wave_sum(float v) {
#pragma unroll
    for (int o = 1; o < 64; o <<= 1) v += __shfl_xor(v, o);
    return v;
}
__device__ __forceinline__ float wave_max(float v) {
#pragma unroll
    for (int o = 1; o < 64; o <<= 1) v = fmaxf(v, __shfl_xor(v, o));
    return v;
}
#define LDS_WAIT() asm volatile("s_waitcnt lgkmcnt(0)" ::: "memory")
__device__ __forceinline__ int otid() { int t; asm volatile("v_mov_b32 %0, %1" : "=v"(t) : "v"((int)threadIdx.x)); return t; }


__device__ unsigned g_bar[3456];
struct XcdBarrier { unsigned* bar; unsigned x; volatile LAS unsigned* st; };
#define XB_TMO      128
#define XB_XCNT(j)  (256  + 64 * (j))
#define XB_XSUB(j)  (1280 + 64 * (j))
#define XB_XGEN(j)  (2304 + 64 * (j))
#define XB_TOP      3328
#define XB_TOPGEN   3392
#define XCD_BAR_WORDS 3456
#define XB_SPIN_CAP (1u << 18)

__device__ __forceinline__ unsigned xb_ld(unsigned* p)              { return __hip_atomic_load(p, __ATOMIC_RELAXED, __HIP_MEMORY_SCOPE_AGENT); }
__device__ __forceinline__ unsigned xb_add(unsigned* p, unsigned v) { return __hip_atomic_fetch_add(p, v, __ATOMIC_RELAXED, __HIP_MEMORY_SCOPE_AGENT); }
__device__ __forceinline__ unsigned xb_xcc_id() { return (unsigned)__builtin_amdgcn_s_getreg((3 << 11) | 20) & 0xFu; }
#define XB_SPIN(cond, bar) do { unsigned _sp = 0; while (cond) { __builtin_amdgcn_s_sleep(1); \
    if ((++_sp & 255u) == 0u) { if (xb_ld(&(bar)[XB_TMO])) break; if (_sp > XB_SPIN_CAP) { atomicAdd(&(bar)[XB_TMO], 1u); break; } } } } while (0)
__device__ __forceinline__ XcdBarrier xcd_barrier_post(unsigned* bar, volatile LAS unsigned* st) {
    XcdBarrier b; b.bar = bar; b.x = xb_xcc_id(); b.st = st;
    if (threadIdx.x == 0) (void)xb_add(&bar[XB_XCNT(b.x)], 1u);
    return b;
}
__device__ __forceinline__ void xcd_barrier_complete(unsigned* bar, unsigned x, unsigned& nloc, unsigned& nx) {
    const unsigned G = gridDim.x * gridDim.y * gridDim.z;
    unsigned sum, cnt, mine, sp = 0u;
    for (;;) {
        sum = 0u; cnt = 0u; mine = 0u;
#pragma unroll
        for (unsigned j = 0; j < 16; ++j) { const unsigned c = xb_ld(&bar[XB_XCNT(j)]); sum += c; cnt += (c > 0u) ? 1u : 0u; mine = (j == x) ? c : mine; }
        if (sum == G) break;
        __builtin_amdgcn_s_sleep(1);
        if ((++sp & 255u) == 0u) { if (xb_ld(&bar[XB_TMO])) break; if (sp > XB_SPIN_CAP) { atomicAdd(&bar[XB_TMO], 1u); break; } }
    }
    nloc = mine > 0u ? mine : 1u; nx = cnt > 0u ? cnt : 1u;
}

__device__ __forceinline__ void xcd_barrier(const XcdBarrier& b) {
    asm volatile("s_waitcnt vmcnt(0)" ::: "memory");
    __syncthreads();
    if (threadIdx.x == 0) {
        unsigned* bar = b.bar;
        __builtin_amdgcn_s_waitcnt(0);
        unsigned nloc = b.st[0], nx = b.st[1];
        if (nloc == 0u) { xcd_barrier_complete(bar, b.x, nloc, nx); b.st[0] = nloc; b.st[1] = nx; }
        const unsigned old = xb_add(&bar[XB_XSUB(b.x)], 1u);
        const unsigned gen = old / nloc;
        if (old + 1u == (gen + 1u) * nloc) {
            __builtin_amdgcn_fence(__ATOMIC_RELEASE, "agent");
            asm volatile("s_waitcnt vmcnt(0)" ::: "memory");
            const unsigned og = xb_add(&bar[XB_TOP], 1u);
            const unsigned tg = og / nx;
            if (og + 1u == (tg + 1u) * nx) xb_add(&bar[XB_TOPGEN], 1u);
            else XB_SPIN(xb_ld(&bar[XB_TOPGEN]) == tg, bar);
            __builtin_amdgcn_fence(__ATOMIC_ACQUIRE, "agent");
            xb_add(&bar[XB_XGEN(b.x)], 1u);
            asm volatile("s_waitcnt vmcnt(0)" ::: "memory");
        } else {
            XB_SPIN(xb_ld(&bar[XB_XGEN(b.x)]) == gen, bar);
            __builtin_amdgcn_fence(__ATOMIC_ACQUIRE, "agent");
            asm volatile("s_waitcnt vmcnt(0)" ::: "memory");
        }
    }
    __syncthreads();
}

struct EpiU {
    static constexpr bool PERM = true, AFTER_DRAIN = false;
    bf16_t* UH; bf16_t* XB; const float* rope;
    __device__ __forceinline__ void operator()(const f32x4 (&acc)[2][2][4][2], const Unit& u, int wr, int wc, int fr, int fq) const {
        const int row0 = u.pm * 256 + wr * 64 + fr;
        const bool attn = u.pn < 6;
        const bool rope_tile = (u.pn < 4) && ((wc & 1) == 0);
        const float sc = (u.pn < 2) ? 0.125f : 1.0f;
        const float sgn = (fq == 0) ? -1.f : 1.f;
#pragma unroll
        for (int ai = 0; ai < 2; ++ai)
#pragma unroll
            for (int m = 0; m < 4; ++m) {
                const int row = row0 + ai * 128 + m * 16;
                f32x4 r0 = {1.f, 0.f, 1.f, 0.f}, r1 = r0, r2 = r0, r3 = r0;
                if (rope_tile) { const f32x4* rp = (const f32x4*)(rope + (size_t)row_pos(row) * 16); r0 = rp[0]; r1 = rp[1]; r2 = rp[2]; r3 = rp[3]; }
                const size_t prow = attn ? (size_t)perm_row(row) : 0;
#pragma unroll
                for (int bj = 0; bj < 2; ++bj) {
                    f32x4 v0 = acc[ai][bj][m][0], v1 = acc[ai][bj][m][1];
                    if (rope_tile) {
                        f32x4 p0, p1;
#pragma unroll
                        for (int j = 0; j < 4; ++j) { p0[j] = __shfl_xor(v0[j], 16); p1[j] = __shfl_xor(v1[j], 16); }
                        if (fq < 2) {
                            v0[0] = v0[0] * r0[0] + sgn * p0[0] * r0[1]; v0[1] = v0[1] * r0[2] + sgn * p0[1] * r0[3];
                            v0[2] = v0[2] * r1[0] + sgn * p0[2] * r1[1]; v0[3] = v0[3] * r1[2] + sgn * p0[3] * r1[3];
                            v1[0] = v1[0] * r2[0] + sgn * p1[0] * r2[1]; v1[1] = v1[1] * r2[2] + sgn * p1[1] * r2[3];
                            v1[2] = v1[2] * r3[0] + sgn * p1[2] * r3[1]; v1[3] = v1[3] * r3[2] + sgn * p1[3] * r3[3];
                        }
                    }
                    v0 = v0 * sc; v1 = v1 * sc;
                    u32x4 w; w.x = cvt_pk_bf16(v0[0], v0[1]); w.y = cvt_pk_bf16(v0[2], v0[3]); w.z = cvt_pk_bf16(v1[0], v1[1]); w.w = cvt_pk_bf16(v1[2], v1[3]);
                    bf16_t* dst;
                    if (attn) {
                        const int cs = (u.pn & 1) * 256 + bj * 128 + wc * 32 + 8 * fq;
                        dst = XB + (size_t)(u.pn >> 1) * ((size_t)T_ * 512) + ((size_t)(cs >> 6) * T_ + prow) * 64 + (cs & 63);
                    } else dst = UH + (size_t)row * UP + (u.pn * 256 - 1536) + bj * 128 + wc * 32 + 8 * fq;
                    *(u32x4*)dst = w;
                }
            }
    }
};
struct EpiRowSS {
    static constexpr bool PERM = true, AFTER_DRAIN = false;
    bf16_t* O; float* SS;
    __device__ __forceinline__ void operator()(const f32x4 (&acc)[2][2][4][2], const Unit& u, int wr, int wc, int fr, int fq) const {
        const int row0 = u.pm * 256 + wr * 64 + fr, col0 = u.pn * 256 + wc * 32 + 8 * fq;
#pragma unroll
        for (int ai = 0; ai < 2; ++ai)
#pragma unroll
            for (int m = 0; m < 4; ++m) {
                const int row = row0 + ai * 128 + m * 16;
                bf16_t* rowp = O + (size_t)row * DM + col0;
                float s = 0.f;
#pragma unroll
                for (int bj = 0; bj < 2; ++bj) {
                    const f32x4 v0 = acc[ai][bj][m][0], v1 = acc[ai][bj][m][1];
                    s += (v0[0] * v0[0] + v0[1] * v0[1]) + (v0[2] * v0[2] + v0[3] * v0[3]) + (v1[0] * v1[0] + v1[1] * v1[1]) + (v1[2] * v1[2] + v1[3] * v1[3]);
                    u32x4 w; w.x = cvt_pk_bf16(v0[0], v0[1]); w.y = cvt_pk_bf16(v0[2], v0[3]); w.z = cvt_pk_bf16(v1[0], v1[1]); w.w = cvt_pk_bf16(v1[2], v1[3]);
                    *(u32x4*)(rowp + bj * 128) = w;
                }
                s += __shfl_xor(s, 16); s += __shfl_xor(s, 32);
                if (fq == 0) SS[(size_t)row * 16 + u.pn * 4 + wc] = s;
            }
    }
};
struct EpiSwiGLU {
    static constexpr bool PERM = true, AFTER_DRAIN = false;
    bf16_t* H;
    __device__ __forceinline__ void operator()(const f32x4 (&acc)[2][2][4][2], const Unit& u, int wr, int wc, int fr, int fq) const {
        const int row0 = u.pm * 256 + wr * 64 + fr, col0 = u.pn * 128 + wc * 32 + 8 * fq;
#pragma unroll
        for (int ai = 0; ai < 2; ++ai)
#pragma unroll
            for (int m = 0; m < 4; ++m) {
                const int row = row0 + ai * 128 + m * 16;
                const f32x4 g0 = acc[ai][0][m][0], g1 = acc[ai][0][m][1], u0 = acc[ai][1][m][0], u1 = acc[ai][1][m][1];
                f32x4 h0, h1;
#pragma unroll
                for (int j = 0; j < 4; ++j) { h0[j] = silu_f(g0[j]) * u0[j]; h1[j] = silu_f(g1[j]) * u1[j]; }
                u32x4 w; w.x = cvt_pk_bf16(h0[0], h0[1]); w.y = cvt_pk_bf16(h0[2], h0[3]); w.z = cvt_pk_bf16(h1[0], h1[1]); w.w = cvt_pk_bf16(h1[2], h1[3]);
                *(u32x4*)(H + (size_t)row * DFF + col0) = w;
            }
    }
};

template <class RowMap>
__device__ __forceinline__ void transpose_item(const float* W, int N, int k0, int n0, const float* kscale, bf16_t* WT, int K, RowMap rowmap, LAS float* scr, int lane) {
    float wv[32];
#pragma unroll
    for (int i = 0; i < 32; ++i) wv[i] = W[(size_t)(k0 + 2 * i + (lane >> 5)) * N + n0 + (lane & 31)];
#pragma unroll
    for (int i = 0; i < 32; ++i) { const int kk = 2 * i + (lane >> 5); float w = wv[i]; if (kscale) w *= kscale[k0 + kk]; scr[kk * 33 + (lane & 31)] = w; }
    LDS_WAIT();
    const int c = lane & 7;
#pragma unroll
    for (int j = 0; j < 4; ++j) { const int n = (lane >> 3) + 8 * j; const LAS float* s = scr + (8 * c) * 33 + n;
        u32x4 o; o.x = pk2(s[0 * 33], s[1 * 33]); o.y = pk2(s[2 * 33], s[3 * 33]); o.z = pk2(s[4 * 33], s[5 * 33]); o.w = pk2(s[6 * 33], s[7 * 33]);
        *(u32x4*)(WT + (size_t)rowmap(n0 + n) * K + k0 + 8 * c) = o; }
    LDS_WAIT();
}
struct RowId { __device__ __forceinline__ int operator()(int n) const { return n; } };
struct RowGU { int half; __device__ __forceinline__ int operator()(int n) const { return (n >> 7) * 256 + half * 128 + (n & 127); } };

struct Params {
    const float* xp; const float* xs; const float* w_in; const float* w_out; const float* lb_fwd; const float* lb_bwd; const float* g_hgrn;
    const float* g_pre_mix; const float* g_post_mix; const float* g_pre_ffn; const float* g_post_ffn; const float* w_gate; const float* w_up; const float* w_down;
    float* out; unsigned char* ws;
};
__device__ __forceinline__ const float* xrow_ptr(const Params& p, int row) { return row < ROWS_P ? p.xp + (size_t)row * DM : p.xs + (size_t)(row - ROWS_P) * DM; }

__device__ __forceinline__ void p0_prologue(const Params& p, LAS unsigned char* lds, int gw, int ngw, int wave, int lane) {
    unsigned char* dob = (unsigned char*)p.out;
    bf16_t* WIN = (bf16_t*)(dob + DO_WIN); bf16_t* WOUT = (bf16_t*)(dob + DO_WOUT); float* rope = (float*)(dob + DO_ROPE); bf16_t* XN = (bf16_t*)(dob + DO_XN);
    LAS float* scr = (LAS float*)(lds + wave * 16384);
    constexpr int I_IN = 16 * 128, I_OUT = 16 * 32;
    for (int it = gw; it < I_IN + I_OUT; it += ngw) {
        if (it < I_IN) transpose_item(p.w_in, NIN, 64 * (it / 128), 32 * (it % 128), p.g_pre_mix, WIN, DM, RowId{}, scr, lane);
        else { const int r = it - I_IN; transpose_item(p.w_out, DM, 64 * (r / 32), 32 * (r % 32), nullptr, WOUT, DM, RowId{}, scr, lane); }
    }
    {
        const int gt = gw * 64 + lane, ngt = ngw * 64;
        for (int e = gt; e < 16384 * 8; e += ngt) {
            const int pos = e >> 3, i = e & 7;
            const double rv = i == 0 ? 0.15915494309189535 : i == 1 ? 0.03086376340470123 : i == 2 ? 0.005985185712713705 : i == 3 ? 0.001160663641240061
                            : i == 4 ? 0.00022507907903927653 : i == 5 ? 4.364795279280289e-05 : i == 6 ? 8.464330808241401e-06 : 1.6414262627950345e-06;
            double a = (double)pos * rv; a -= floor(a);
            const float af = (float)a;
            rope[2 * e] = __builtin_amdgcn_cosf(af); rope[2 * e + 1] = __builtin_amdgcn_sinf(af);
        }
    }
    for (int m0 = gw * 4; m0 < T_; m0 += ngw * 4) {
        f32x4 v[4][4]; float s[4];
#pragma unroll
        for (int k = 0; k < 4; ++k) { const f32x4* xr = (const f32x4*)xrow_ptr(p, m0 + k) + lane;
#pragma unroll
            for (int j = 0; j < 4; ++j) v[k][j] = __builtin_nontemporal_load(&xr[64 * j]); }
#pragma unroll
        for (int k = 0; k < 4; ++k) { s[k] = 0.f;
#pragma unroll
            for (int j = 0; j < 4; ++j) s[k] += (v[k][j][0] * v[k][j][0] + v[k][j][1] * v[k][j][1]) + (v[k][j][2] * v[k][j][2] + v[k][j][3] * v[k][j][3]); }
#pragma unroll
        for (int k = 0; k < 4; ++k) {
            const float rstd = rsqrtf(wave_sum(s[k]) * (1.f / DM) + EPS);
            u32x2v* o8 = (u32x2v*)(XN + (size_t)(m0 + k) * DM) + lane;
#pragma unroll
            for (int j = 0; j < 4; ++j) { u32x2v w; w.x = cvt_pk_bf16(v[k][j][0] * rstd, v[k][j][1] * rstd); w.y = cvt_pk_bf16(v[k][j][2] * rstd, v[k][j][3] * rstd); __builtin_nontemporal_store(w, &o8[64 * j]); }
        }
    }
}

namespace at {
typedef short bf16x8 __attribute__((ext_vector_type(8)));
typedef short s16x4 __attribute__((ext_vector_type(4)));
constexpr int OS = 68;
constexpr int L_OUT = 0, L_L = 272 * OS * 4, L_VS = L_L + 1024, VS_STRIDE = 144, VS_WAVE = 32 * VS_STRIDE, L_END = L_VS + 8 * VS_WAVE;
static_assert(L_END <= LDS_BYTES, "attention LDS map");

__device__ __forceinline__ void wave_tile(const bf16_t* XBp, LAS unsigned char* lds, int w, int lane, int base, int S, int P0, int h, int idx) {
    const int n = lane & 15, quad = lane >> 4;
    const int br = idx >> 4, sub = idx & 15;
    const int dsh = 2 * br, dil = 1 << dsh;
    const int r = br == 0 ? 0 : (br == 1 ? (sub & 3) : sub);
    const int mt = br == 0 ? sub : (br == 1 ? (sub >> 2) : 0);
    const int Lsub = S >> dsh, m0 = (P0 >> dsh) + 16 * mt;
    const bf16_t* Qb = XBp + ((size_t)h * T_ + base) * 64;
    const bf16_t* Kb = Qb + (size_t)T_ * 512, * Vb = Kb + (size_t)T_ * 512;
    const int sh16 = (S == 16384) ? 10 : 8;
#define AT_ROW(pos) ((((pos) & 15) << sh16) + ((pos) >> 4))
    bf16x8 qf[2];
    { const int pq = (m0 + n) * dil + r; const bf16_t* qp = Qb + (size_t)AT_ROW(pq) * 64 + 8 * quad; qf[0] = *(const bf16x8*)qp; qf[1] = *(const bf16x8*)(qp + 32); }
    const int nrun1 = (1 << sh16) - 1;
    bf16x8 kf[9][2];
    {
        const int pk0 = (m0 - 64 + n) * dil + r, idx0 = pk0 >> 4;
        const bf16_t* kb = Kb + ((size_t)((pk0 & 15) << sh16)) * 64 + 8 * quad;
#pragma unroll
        for (int kt = 0; kt < 9; ++kt) {
            int ix = idx0 + kt * dil; ix = ix < 0 ? 0 : (ix > nrun1 ? nrun1 : ix);
            const bf16_t* kp = kb + (size_t)ix * 64; kf[kt][0] = *(const bf16x8*)kp; kf[kt][1] = *(const bf16x8*)(kp + 32);
        }
    }
    u32x4 vr[5][4];
#pragma unroll
    for (int e = 0; e < 4; ++e) {
        const int id = lane + 64 * e, rho = id >> 3, ch = id & 7;
        const int pv0 = (m0 - 64 + rho) * dil + r, idx0 = pv0 >> 4;
        const bf16_t* vb = Vb + ((size_t)((pv0 & 15) << sh16)) * 64 + 8 * ch;
#pragma unroll
        for (int t = 0; t < 5; ++t) {
            int ix = idx0 + 2 * t * dil; ix = ix < 0 ? 0 : (ix > nrun1 ? nrun1 : ix);
            vr[t][e] = *(const u32x4*)(vb + (size_t)ix * 64);
        }
    }
    unsigned pk[10][2];
    float lsum = 0.f;
#pragma unroll
    for (int kt = 0; kt < 9; ++kt) {
        f32x4 sc = {0.f, 0.f, 0.f, 0.f};
        sc = __builtin_amdgcn_mfma_f32_16x16x32_bf16(kf[kt][0], qf[0], sc, 0, 0, 0);
        sc = __builtin_amdgcn_mfma_f32_16x16x32_bf16(kf[kt][1], qf[1], sc, 0, 0, 0);
        float pv[4];
#pragma unroll
        for (int j = 0; j < 4; ++j) {
            const int ko = 16 * kt + 4 * quad + j, mk = m0 - 64 + ko;
            const bool valid = (ko >= n) && (ko <= n + 128) && (mk >= 0) && (mk < Lsub);
            const float e = __expf(fminf(sc[j], 80.f));
            pv[j] = valid ? e : 0.f; lsum += pv[j];
        }
        pk[kt][0] = cvt_pk_bf16(pv[0], pv[1]); pk[kt][1] = cvt_pk_bf16(pv[2], pv[3]);
    }
    pk[9][0] = 0u; pk[9][1] = 0u;
    lsum += __shfl_xor(lsum, 16); lsum += __shfl_xor(lsum, 32);
    f32x4 ot[4];
#pragma unroll
    for (int dt = 0; dt < 4; ++dt) ot[dt] = (f32x4){0.f, 0.f, 0.f, 0.f};
    LAS unsigned char* vs = lds + L_VS + w * VS_WAVE;
#pragma unroll
    for (int t = 0; t < 5; ++t) {
#pragma unroll
        for (int e = 0; e < 4; ++e) { const int id = lane + 64 * e, rho = id >> 3, ch = id & 7; *(LAS u32x4*)(vs + rho * VS_STRIDE + ch * 16) = vr[t][e]; }
        bf16x8 pf; { u32x4 pw = {pk[2 * t][0], pk[2 * t][1], pk[2 * t + 1][0], pk[2 * t + 1][1]}; pf = __builtin_bit_cast(bf16x8, pw); }
#pragma unroll
        for (int dt = 0; dt < 4; ++dt) {
            const int q = (lane & 15) >> 2, pp = lane & 3;
            const s16x4 lo = __builtin_amdgcn_ds_read_tr16_b64_v4i16((LAS s16x4*)(vs + (4 * quad + q) * VS_STRIDE + (16 * dt + 4 * pp) * 2));
            const s16x4 hi = __builtin_amdgcn_ds_read_tr16_b64_v4i16((LAS s16x4*)(vs + (16 + 4 * quad + q) * VS_STRIDE + (16 * dt + 4 * pp) * 2));
            const bf16x8 vf = {lo[0], lo[1], lo[2], lo[3], hi[0], hi[1], hi[2], hi[3]};
            ot[dt] = __builtin_amdgcn_mfma_f32_16x16x32_bf16(vf, pf, ot[dt], 0, 0, 0);
        }
    }
    const int posl = ((m0 + n) * dil + r) - P0;
    LAS float* op = (LAS float*)(lds + L_OUT) + (posl + (posl >> 4)) * OS + 4 * quad;
    LAS float* lp = (LAS float*)(lds + L_L) + posl;
    if (br == 0) {
#pragma unroll
        for (int dt = 0; dt < 4; ++dt) *(LAS f32x4*)(op + 16 * dt) = ot[dt];
        if (quad == 0) *lp = lsum;
    } else {
        f32x4 old[4];
#pragma unroll
        for (int dt = 0; dt < 4; ++dt) old[dt] = *(const LAS f32x4*)(op + 16 * dt);
        const float lo = *lp;
#pragma unroll
        for (int dt = 0; dt < 4; ++dt) *(LAS f32x4*)(op + 16 * dt) = old[dt] + ot[dt];
        if (quad == 0) *lp = lo + lsum;
    }
}
__device__ __forceinline__ void attn_phase(const bf16_t* XBp, bf16_t* MIXIN, LAS unsigned char* lds, int blk, int G) {
    const int tid = otid(), lane = tid & 63, w = __builtin_amdgcn_readfirstlane(tid >> 6);
    __syncthreads();
    for (int u = blk; u < 2048; u += G) {
        int grp = u >> 3, h = u & 7;
        if (G == 256) { const int x = u & 7, j = (u >> 3) & 31, e8 = u >> 8; h = e8; grp = 32 * x + j; }
        const int row0 = grp * 256;
        const int base = row0 < ROWS_P ? (row0 & ~16383) : (ROWS_P + ((row0 - ROWS_P) & ~4095)), S = row0 < ROWS_P ? 16384 : 4096, P0 = row0 - base;
        for (int br = 0; br < 3; ++br) {
            wave_tile(XBp, lds, w, lane, base, S, P0, h, 16 * br + w);
            wave_tile(XBp, lds, w, lane, base, S, P0, h, 16 * br + w + 8);
            __syncthreads();
        }
        {
            const int pos = tid >> 1, half = tid & 1;
            const LAS float* op = (const LAS float*)(lds + L_OUT) + (pos + (pos >> 4)) * OS + 32 * half;
            const float inv = 1.f / ((const LAS float*)(lds + L_L))[pos];
            unsigned wv[16];
#pragma unroll
            for (int d = 0; d < 16; ++d) wv[d] = cvt_pk_bf16(op[2 * d] * inv, op[2 * d + 1] * inv);
            u32x4* gp = (u32x4*)(MIXIN + (size_t)(row0 + pos) * DM + h * 64 + 32 * half);
#pragma unroll
            for (int c = 0; c < 4; ++c) gp[c] = (u32x4){wv[4 * c], wv[4 * c + 1], wv[4 * c + 2], wv[4 * c + 3]};
        }
        __syncthreads();
    }
}
}

namespace hg {
typedef short bf16x8 __attribute__((ext_vector_type(8)));
constexpr int SEG = 1024, NCH = 16, NITEM = 512;
constexpr int RS = 272, TS = 144;
constexpr int L_QT = 0, L_QR = 17408, L_KR = 34816, L_K0 = 52224, L_Q4 = 56576, L_KT = 60928, L_VT = 79360, L_ST = 97792, L_AB = 132608, L_TOT = 141824, L_BV = 143872, L_END = 144384;
static_assert(L_END <= LDS_BYTES, "hgrn LDS map");
constexpr size_t DO_STATE = 140 * MiB, DO_DEC = 172 * MiB, DO_OB = 176 * MiB, DO_INIT = 240 * MiB;

__device__ __forceinline__ int phys_row(int g, int dir, int lt) { return dir ? (g * SEG + SEG - 1 - lt) : (g * SEG + lt); }
__device__ __forceinline__ unsigned short bf1(float x) { __bf16 b = (__bf16)x; return __builtin_bit_cast(unsigned short, b); }
__device__ __forceinline__ bf16x8 ldfrag(LAS unsigned char* lds, int off, int stride, int row0, int kel, int lane) {
    return *(const LAS bf16x8*)(lds + off + (row0 + (lane & 15)) * stride + (kel + 8 * (lane >> 4)) * 2);
}
template <bool FULL>
__device__ __forceinline__ void load_raw(const bf16_t* U, int g, int dir, int ch, int i, int zcol, int qcol, int vcol, unsigned short (&rz)[16], unsigned short (&rq)[16], unsigned short (&rv)[16]) {
#pragma unroll
    for (int r = 0; r < 16; ++r) {
        const bf16_t* pr = U + (size_t)phys_row(g, dir, 64 * ch + 16 * i + r) * UP;
        rz[r] = __builtin_nontemporal_load(pr + zcol); if (FULL) rq[r] = __builtin_nontemporal_load(pr + qcol); rv[r] = __builtin_nontemporal_load(pr + vcol);
    }
}
template <bool FULL>
__device__ __forceinline__ void prep(LAS unsigned char* lds, int i, int c, float lb, const unsigned short (&rz)[16], const unsigned short (&rq)[16], const unsigned short (&rv)[16], float& bdec) {
    float f[16], e1[16], qs[16];
    float run = 1.f;
#pragma unroll
    for (int r = 0; r < 16; ++r) {
        const float fr = lb + (1.f - lb) * sigmoid_f(bf2f(rz[r]));
        f[r] = fr; run *= fr; e1[r] = run;
        if (FULL) qs[r] = silu_f(bf2f(rq[r])); else qs[r] = 0.f;
    }
    ((LAS float*)(lds + L_TOT))[i * 128 + c] = run;
    {
        u32x4 a, b;
        a.x = rv[0] | ((unsigned)rv[1] << 16); a.y = rv[2] | ((unsigned)rv[3] << 16); a.z = rv[4] | ((unsigned)rv[5] << 16); a.w = rv[6] | ((unsigned)rv[7] << 16);
        b.x = rv[8] | ((unsigned)rv[9] << 16); b.y = rv[10] | ((unsigned)rv[11] << 16); b.z = rv[12] | ((unsigned)rv[13] << 16); b.w = rv[14] | ((unsigned)rv[15] << 16);
        LAS u32x4* vp = (LAS u32x4*)(lds + L_VT + c * TS + 32 * i); vp[0] = a; vp[1] = b;
    }
    __syncthreads();
    const LAS float* tp = (const LAS float*)(lds + L_TOT) + c;
    const float p0 = tp[0], p1 = tp[128], p2 = tp[256], p3 = tp[384];
    const float cQT = i == 0 ? 1.f : i == 1 ? p0 : i == 2 ? p0 * p1 : p0 * p1 * p2;
    const float cKT = i == 0 ? p1 * p2 * p3 : i == 1 ? p2 * p3 : i == 2 ? p3 : 1.f;
    const float cQR = i == 0 ? 1.f : i == 1 ? __builtin_amdgcn_rcpf(p1) : i == 2 ? 1.f : p2;
    const float cKR = i == 0 ? p1 : i == 1 ? 1.f : i == 2 ? __builtin_amdgcn_rcpf(p2) : 1.f;
    const float cK0 = __builtin_amdgcn_rcpf(p0), cQ4 = __builtin_amdgcn_rcpf(p3);
    bdec = (p0 * p1) * (p2 * p3);
    if (i == 0) ((LAS float*)(lds + L_BV))[c] = bdec;
    unsigned short kt[16];
    float e2 = 1.f;
#pragma unroll
    for (int r = 15; r >= 0; --r) {
        const float kb = (1.f - f[r]) * e2;
        kt[r] = bf1(kb * cKT);
        if (FULL) {
            *(LAS unsigned short*)(lds + L_KR + (16 * i + r) * RS + c * 2) = bf1(kb * cKR);
            if (i == 0) *(LAS unsigned short*)(lds + L_K0 + r * RS + c * 2) = bf1(kb * cK0);
        }
        e2 *= f[r];
    }
    {
        u32x4 a, b;
        a.x = kt[0] | ((unsigned)kt[1] << 16); a.y = kt[2] | ((unsigned)kt[3] << 16); a.z = kt[4] | ((unsigned)kt[5] << 16); a.w = kt[6] | ((unsigned)kt[7] << 16);
        b.x = kt[8] | ((unsigned)kt[9] << 16); b.y = kt[10] | ((unsigned)kt[11] << 16); b.z = kt[12] | ((unsigned)kt[13] << 16); b.w = kt[14] | ((unsigned)kt[15] << 16);
        LAS u32x4* kp = (LAS u32x4*)(lds + L_KT + c * TS + 32 * i); kp[0] = a; kp[1] = b;
    }
    if (FULL) {
#pragma unroll
        for (int r = 0; r < 16; ++r) {
            const float qe = qs[r] * e1[r];
            *(LAS unsigned short*)(lds + L_QT + (16 * i + r) * RS + c * 2) = bf1(qe * cQT);
            *(LAS unsigned short*)(lds + L_QR + (16 * i + r) * RS + c * 2) = bf1(qe * cQR);
            if (i == 3) *(LAS unsigned short*)(lds + L_Q4 + r * RS + c * 2) = bf1(qe * cQ4);
        }
    }
}
__device__ __forceinline__ void state_update(LAS unsigned char* lds, f32x4 (&S)[8], int w, int gq, int lane) {
    bf16x8 ktf[2];
#pragma unroll
    for (int k2 = 0; k2 < 2; ++k2) ktf[k2] = ldfrag(lds, L_KT, TS, 16 * w, 32 * k2, lane);
    const f32x4 dk = *(const LAS f32x4*)(lds + L_BV + (16 * w + 4 * gq) * 4);
#pragma unroll
    for (int n = 0; n < 8; ++n) {
        S[n] = S[n] * dk;
#pragma unroll
        for (int k2 = 0; k2 < 2; ++k2) S[n] = __builtin_amdgcn_mfma_f32_16x16x32_bf16(ktf[k2], ldfrag(lds, L_VT, TS, 16 * n, 32 * k2, lane), S[n], 0, 0, 0);
    }
}
__device__ __forceinline__ int item_of(int lin, int G) {
    if (G != 256) return lin;
    const int x = lin & 7, j = (lin >> 3) & 31, e = lin >> 8, g = 8 * x + 2 * (j >> 3) + e, hd = j & 7;
    return g * 8 + hd;
}
__device__ __forceinline__ float lb_of(const Params& p, int dir, int col) { const float* lbr = dir ? p.lb_bwd : p.lb_fwd; return 1.f / (1.f + __expf(lbr[512 + col] - lbr[col])); }

__device__ __forceinline__ void pass1(const Params& p, const bf16_t* U, LAS unsigned char* lds, int item) {
    const int tid = otid(), lane = tid & 63, w = __builtin_amdgcn_readfirstlane(tid >> 6), i = w >> 1, c = tid & 127, gq = lane >> 4;
    const int dir = item & 1, hh = (item >> 1) & 3, g = item >> 3;
    float* STATE = (float*)((unsigned char*)p.out + DO_STATE); float* DEC = (float*)((unsigned char*)p.out + DO_DEC);
    const float lb = lb_of(p, dir, hh * 128 + c);
    const int zcol = (dir ? UC_ZB : UC_ZF) + hh * 128 + c, qcol = UC_QH + hh * 128 + c, vcol = UC_IH + hh * 128 + c;
    f32x4 S[8];
#pragma unroll
    for (int n = 0; n < 8; ++n) S[n] = (f32x4){0.f, 0.f, 0.f, 0.f};
    float dtot = 1.f;
    unsigned short rz[16], rq[16], rv[16];
    load_raw<false>(U, g, dir, 0, i, zcol, qcol, vcol, rz, rq, rv);
    for (int ch = 0; ch < NCH; ++ch) {
        float bdec;
        prep<false>(lds, i, c, lb, rz, rq, rv, bdec);
        dtot *= bdec;
        if (ch + 1 < NCH) load_raw<false>(U, g, dir, ch + 1, i, zcol, qcol, vcol, rz, rq, rv);
        __syncthreads();
        state_update(lds, S, w, gq, lane);
        __syncthreads();
    }
    float* sp = STATE + (size_t)item * 16384 + (16 * w + 4 * gq) * 128 + (lane & 15);
#pragma unroll
    for (int n = 0; n < 8; ++n)
#pragma unroll
        for (int jj = 0; jj < 4; ++jj) sp[jj * 128 + 16 * n] = S[n][jj];
    if (i == 0) DEC[item * 128 + c] = dtot;
}
__device__ __forceinline__ void scan(const Params& p, int gt, int ngt) {
    const float* STATE = (const float*)((unsigned char*)p.out + DO_STATE); const float* DEC = (const float*)((unsigned char*)p.out + DO_DEC);
    bf16_t* INIT = (bf16_t*)((unsigned char*)p.out + DO_INIT);
    for (int e = gt; e < 80 * 4096; e += ngt) {
        const int chain = e >> 12, q4 = e & 4095, k = q4 >> 5;
        const int dir = chain & 1, hh = (chain >> 1) & 3, sb = chain >> 3;
        const int nseg = sb < 2 ? 16 : 4, g0 = sb < 2 ? sb * 16 : 32 + (sb - 2) * 4;
        f32x4 s = {0.f, 0.f, 0.f, 0.f};
        for (int j = 0; j < nseg; ++j) {
            const int g = dir ? (g0 + nseg - 1 - j) : (g0 + j), item = (g * 4 + hh) * 2 + dir;
            const f32x4 en = *((const f32x4*)(STATE + (size_t)item * 16384) + q4);
            u32x2v wv; wv.x = cvt_pk_bf16(s[0], s[1]); wv.y = cvt_pk_bf16(s[2], s[3]);
            *((u32x2v*)(INIT + (size_t)item * 16384) + q4) = wv;
            s = s * DEC[item * 128 + k] + en;
        }
    }
}
__device__ __forceinline__ void pass2(const Params& p, const bf16_t* U, bf16_t* MIXIN, LAS unsigned char* lds, int item) {
    const int tid = otid(), lane = tid & 63, w = __builtin_amdgcn_readfirstlane(tid >> 6), i = w >> 1, c = tid & 127, gq = lane >> 4;
    const int dir = item & 1, hh = (item >> 1) & 3, g = item >> 3;
    const bf16_t* INIT = (const bf16_t*)((unsigned char*)p.out + DO_INIT);
    bf16_t* OUT = dir ? (bf16_t*)((unsigned char*)p.out + DO_OB) + hh * 128 : MIXIN + 512 + hh * 128;
    const int opitch = dir ? 512 : DM;
    const float lb = lb_of(p, dir, hh * 128 + c);
    const int zcol = (dir ? UC_ZB : UC_ZF) + hh * 128 + c, qcol = UC_QH + hh * 128 + c, vcol = UC_IH + hh * 128 + c;
    for (int idx = tid; idx < 64 * TS / 4; idx += 512) ((LAS unsigned*)(lds + L_AB))[idx] = 0u;
    f32x4 S[8];
    {
        const bf16_t* sp = INIT + (size_t)item * 16384 + (16 * w + 4 * gq) * 128 + (lane & 15);
#pragma unroll
        for (int n = 0; n < 8; ++n)
#pragma unroll
            for (int jj = 0; jj < 4; ++jj) S[n][jj] = bf2f(sp[jj * 128 + 16 * n]);
    }
#define HG_ST_WRITE() do { _Pragma("unroll") for (int n = 0; n < 8; ++n) { u32x2v wv; wv.x = cvt_pk_bf16(S[n][0], S[n][1]); wv.y = cvt_pk_bf16(S[n][2], S[n][3]); \
        *(LAS u32x2v*)(lds + L_ST + (16 * n + (lane & 15)) * RS + (16 * w + 4 * gq) * 2) = wv; } } while (0)
    HG_ST_WRITE();
    unsigned short rz[16], rq[16], rv[16];
    load_raw<true>(U, g, dir, 0, i, zcol, qcol, vcol, rz, rq, rv);
    for (int ch = 0; ch < NCH; ++ch) {
        float bdec;
        prep<true>(lds, i, c, lb, rz, rq, rv, bdec);
        if (ch + 1 < NCH) load_raw<true>(U, g, dir, ch + 1, i, zcol, qcol, vcol, rz, rq, rv);
        __syncthreads();
        for (int bi = w; bi < 10; bi += 8) {
            const int ti = bi >= 6 ? 3 : bi >= 3 ? 2 : bi >= 1 ? 1 : 0, tj = bi - ti * (ti + 1) / 2;
            const int qoff = (bi == 9) ? L_Q4 : L_QR + 16 * ti * RS, koff = (bi == 0) ? L_K0 : L_KR + 16 * tj * RS;
            f32x4 a = {0.f, 0.f, 0.f, 0.f};
#pragma unroll
            for (int ks = 0; ks < 4; ++ks) a = __builtin_amdgcn_mfma_f32_16x16x32_bf16(ldfrag(lds, qoff, RS, 0, 32 * ks, lane), ldfrag(lds, koff, RS, 0, 32 * ks, lane), a, 0, 0, 0);
#pragma unroll
            for (int jj = 0; jj < 4; ++jj) {
                float val = a[jj];
                if (ti == tj && (lane & 15) > 4 * gq + jj) val = 0.f;
                *(LAS unsigned short*)(lds + L_AB + (16 * ti + 4 * gq + jj) * TS + (16 * tj + (lane & 15)) * 2) = bf1(val);
            }
        }
        __syncthreads();
        {
            bf16x8 stf[4], vtf[2];
#pragma unroll
            for (int ks = 0; ks < 4; ++ks) stf[ks] = ldfrag(lds, L_ST, RS, 16 * w, 32 * ks, lane);
#pragma unroll
            for (int k2 = 0; k2 < 2; ++k2) vtf[k2] = ldfrag(lds, L_VT, TS, 16 * w, 32 * k2, lane);
#pragma unroll
            for (int mt = 0; mt < 4; ++mt) {
                f32x4 o = {0.f, 0.f, 0.f, 0.f};
#pragma unroll
                for (int ks = 0; ks < 4; ++ks) o = __builtin_amdgcn_mfma_f32_16x16x32_bf16(ldfrag(lds, L_QT, RS, 16 * mt, 32 * ks, lane), stf[ks], o, 0, 0, 0);
#pragma unroll
                for (int k2 = 0; k2 < 2; ++k2) o = __builtin_amdgcn_mfma_f32_16x16x32_bf16(ldfrag(lds, L_AB, TS, 16 * mt, 32 * k2, lane), vtf[k2], o, 0, 0, 0);
#pragma unroll
                for (int jj = 0; jj < 4; ++jj) {
                    const int row = phys_row(g, dir, 64 * ch + 16 * mt + 4 * gq + jj);
                    OUT[(size_t)row * opitch + 16 * w + (lane & 15)] = bf1(o[jj]);
                }
            }
        }
        state_update(lds, S, w, gq, lane);
        __syncthreads();
        HG_ST_WRITE();
    }
#undef HG_ST_WRITE
}
}

__device__ __forceinline__ void hg_finalize(const Params& p, const bf16_t* U, bf16_t* MIXIN, int blk, int G, int wave, int lane) {
    const float gn0 = p.g_hgrn[2 * lane], gn1 = p.g_hgrn[2 * lane + 1];
    const bf16_t* OB = (const bf16_t*)((const unsigned char*)p.out + hg::DO_OB);
    const int gw = blk * 8 + wave, ngw = G * 8;
    for (int r0 = gw * 4; r0 < T_; r0 += ngw * 4) {
        unsigned wm[4][4], wg[4][4], wo[4][4];
#pragma unroll
        for (int k = 0; k < 4; ++k)
#pragma unroll
            for (int hh = 0; hh < 4; ++hh) {
                const int row = r0 + k;
                wm[k][hh] = *((const unsigned*)(MIXIN + (size_t)row * DM + 512 + hh * 128) + lane);
                wg[k][hh] = *((const unsigned*)(U + (size_t)row * UP + UC_GH + hh * 128) + lane);
                wo[k][hh] = *((const unsigned*)(OB + (size_t)row * 512 + hh * 128) + lane);
            }
#pragma unroll
        for (int k = 0; k < 4; ++k)
#pragma unroll
            for (int hh = 0; hh < 4; ++hh) {
                const unsigned w = wm[k][hh], gw2 = wg[k][hh], wb = wo[k][hh];
                const float o0 = __uint_as_float(w << 16) + __uint_as_float(wb << 16), o1 = __uint_as_float(w & 0xffff0000u) + __uint_as_float(wb & 0xffff0000u);
                const float g0 = __uint_as_float(gw2 << 16), g1 = __uint_as_float(gw2 & 0xffff0000u);
                const float rs = rsqrtf(wave_sum(o0 * o0 + o1 * o1) * (1.f / 128.f) + EPS);
                *((unsigned*)(MIXIN + (size_t)(r0 + k) * DM + 512 + hh * 128) + lane) = cvt_pk_bf16(o0 * rs * gn0 * silu_f(g0), o1 * rs * gn1 * silu_f(g1));
            }
    }
}

__device__ __forceinline__ void p6_rows(const Params& p, LAS unsigned char* lds, int gw, int ngw, int wave, int lane) {
    bf16_t* WGU = (bf16_t*)(p.ws + WS_WGU); bf16_t* WDN = (bf16_t*)(p.ws + WS_WDN);
    LAS float* scr = (LAS float*)(lds + wave * 16384);
    constexpr int I_G = 16 * 88, I_D = 44 * 32;
    for (int it = gw; it < 2 * I_G + I_D; it += ngw) {
        if (it < I_G) transpose_item(p.w_gate, DFF, 64 * (it / 88), 32 * (it % 88), p.g_pre_ffn, WGU, DM, RowGU{0}, scr, lane);
        else if (it < 2 * I_G) { const int r = it - I_G; transpose_item(p.w_up, DFF, 64 * (r / 88), 32 * (r % 88), p.g_pre_ffn, WGU, DM, RowGU{1}, scr, lane); }
        else { const int r = it - 2 * I_G; transpose_item(p.w_down, DM, 64 * (r / 32), 32 * (r % 32), nullptr, WDN, DFF, RowId{}, scr, lane); }
    }
    bf16_t* MIX = (bf16_t*)(p.ws + WS_MIX); const float* SS = (const float*)(p.ws + WS_SS1);
    f32x4 gp[4];
#pragma unroll
    for (int j = 0; j < 4; ++j) gp[j] = ((const f32x4*)p.g_post_mix)[lane + 64 * j];
    for (int m0 = gw * 4; m0 < T_; m0 += ngw * 4) {
        f32x4 xv[4][4]; u32x2v mw[4][4]; float r1[4];
#pragma unroll
        for (int k = 0; k < 4; ++k) {
            const int m = m0 + k;
            const f32x4* ssp = (const f32x4*)(SS + (size_t)m * 16);
            const f32x4 a = ssp[0], b = ssp[1], c = ssp[2], d = ssp[3];
            const float ss = ((a[0] + a[1]) + (a[2] + a[3])) + ((b[0] + b[1]) + (b[2] + b[3])) + ((c[0] + c[1]) + (c[2] + c[3])) + ((d[0] + d[1]) + (d[2] + d[3]));
            r1[k] = rsqrtf(ss * (1.f / DM) + EPS);
            const f32x4* xr = (const f32x4*)xrow_ptr(p, m) + lane;
            const u32x2v* mx = (const u32x2v*)(MIX + (size_t)m * DM) + lane;
#pragma unroll
            for (int jj = 0; jj < 4; ++jj) { xv[k][jj] = __builtin_nontemporal_load(&xr[64 * jj]); mw[k][jj] = __builtin_nontemporal_load(&mx[64 * jj]); }
        }
        float s2[4];
#pragma unroll
        for (int k = 0; k < 4; ++k) {
            f32x4* xo = (f32x4*)(p.out + (size_t)(m0 + k) * DM) + lane;
            s2[k] = 0.f;
#pragma unroll
            for (int jj = 0; jj < 4; ++jj) {
                const u32x2v w = mw[k][jj];
                f32x4 mv = {__uint_as_float(w.x << 16), __uint_as_float(w.x & 0xffff0000u), __uint_as_float(w.y << 16), __uint_as_float(w.y & 0xffff0000u)};
                xv[k][jj] = xv[k][jj] + mv * r1[k] * gp[jj];
                s2[k] += (xv[k][jj][0] * xv[k][jj][0] + xv[k][jj][1] * xv[k][jj][1]) + (xv[k][jj][2] * xv[k][jj][2] + xv[k][jj][3] * xv[k][jj][3]);
                __builtin_nontemporal_store(xv[k][jj], &xo[64 * jj]);
            }
        }
#pragma unroll
        for (int k = 0; k < 4; ++k) {
            const float r2 = rsqrtf(wave_sum(s2[k]) * (1.f / DM) + EPS);
            u32x2v* mx = (u32x2v*)(MIX + (size_t)(m0 + k) * DM) + lane;
#pragma unroll
            for (int jj = 0; jj < 4; ++jj) { u32x2v w; w.x = cvt_pk_bf16(xv[k][jj][0] * r2, xv[k][jj][1] * r2); w.y = cvt_pk_bf16(xv[k][jj][2] * r2, xv[k][jj][3] * r2); __builtin_nontemporal_store(w, &mx[64 * jj]); }
        }
    }
}
__device__ __forceinline__ void p9_rows(const Params& p, int gw, int ngw, int lane) {
    const bf16_t* FF = (const bf16_t*)(p.ws + WS_MIX); const float* SS = (const float*)(p.ws + WS_SS2);
    f32x4 gp[4];
#pragma unroll
    for (int j = 0; j < 4; ++j) gp[j] = ((const f32x4*)p.g_post_ffn)[lane + 64 * j];
    for (int m0 = gw * 4; m0 < T_; m0 += ngw * 4) {
        f32x4 xv[4][4]; u32x2v fw[4][4]; float r1[4];
#pragma unroll
        for (int k = 0; k < 4; ++k) {
            const int m = m0 + k;
            const f32x4* ssp = (const f32x4*)(SS + (size_t)m * 16);
            const f32x4 a = ssp[0], b = ssp[1], c = ssp[2], d = ssp[3];
            const float ss = ((a[0] + a[1]) + (a[2] + a[3])) + ((b[0] + b[1]) + (b[2] + b[3])) + ((c[0] + c[1]) + (c[2] + c[3])) + ((d[0] + d[1]) + (d[2] + d[3]));
            r1[k] = rsqrtf(ss * (1.f / DM) + EPS);
            const u32x2v* fx = (const u32x2v*)(FF + (size_t)m * DM) + lane;
            const f32x4* xo = (const f32x4*)(p.out + (size_t)m * DM) + lane;
#pragma unroll
            for (int jj = 0; jj < 4; ++jj) { xv[k][jj] = __builtin_nontemporal_load(&xo[64 * jj]); fw[k][jj] = __builtin_nontemporal_load(&fx[64 * jj]); }
        }
#pragma unroll
        for (int k = 0; k < 4; ++k) {
            f32x4* xo = (f32x4*)(p.out + (size_t)(m0 + k) * DM) + lane;
#pragma unroll
            for (int jj = 0; jj < 4; ++jj) {
                const u32x2v w = fw[k][jj];
                f32x4 fv = {__uint_as_float(w.x << 16), __uint_as_float(w.x & 0xffff0000u), __uint_as_float(w.y << 16), __uint_as_float(w.y & 0xffff0000u)};
                __builtin_nontemporal_store(xv[k][jj] + fv * r1[k] * gp[jj], &xo[64 * jj]);
            }
        }
    }
}

__global__ void __launch_bounds__(512, 2) fwd_megakernel(Params p) {
    extern __shared__ __attribute__((aligned(16))) unsigned char lds_raw[];
    LAS unsigned char* lds = (LAS unsigned char*)lds_raw;
    cg::grid_group grid = cg::this_grid();
#define GSYNC() do { asm volatile("s_waitcnt vmcnt(0)" ::: "memory"); grid.sync(); \
        if (wave == 0) { __builtin_amdgcn_fence(__ATOMIC_ACQUIRE, "agent"); asm volatile("s_waitcnt vmcnt(0)" ::: "memory"); } __syncthreads(); } while (0)
    const int tid = otid(), lane = tid & 63, wave = __builtin_amdgcn_readfirstlane(tid >> 6);
    const int G = gridDim.x, blk = blockIdx.x;
    const int gw = blk * 8 + wave, ngw = G * 8;
    unsigned char* dob = (unsigned char*)p.out;
    bf16_t* U = (bf16_t*)(p.ws + WS_U);
    bf16_t* MIXIN = (bf16_t*)(dob + DO_MIXIN);

    volatile LAS unsigned* bst = (volatile LAS unsigned*)(lds + LDS_BYTES - 16);
    if (tid < 2) bst[tid] = 0u;
    if (blk == 0) for (int i2 = tid; i2 < 3456; i2 += 512) __hip_atomic_store(g_bar + i2, 0u, __ATOMIC_RELAXED, __HIP_MEMORY_SCOPE_AGENT);
    p0_prologue(p, lds, gw, ngw, wave, lane);
    GSYNC();
    const XcdBarrier xbar = xcd_barrier_post(g_bar, bst);
#define XSYNC() xcd_barrier(xbar)
    {
        pg8::Gemm g{(const bf16_t*)(dob + DO_XN), (const bf16_t*)(dob + DO_WIN), T_, NIN, DM}; pg8::StaticOrder S; S.init(T_, NIN, G, blk);
        EpiU E{U, (bf16_t*)(p.ws + WS_QB), (const float*)(dob + DO_ROPE)};
        pg8::gemm_phase<EpiU, pg8::StaticOrder, true, true>(lds, g, S, E);
    }
    XSYNC();
    for (int lin = blk; lin < hg::NITEM; lin += G) hg::pass1(p, U, lds, hg::item_of(lin, G));
    at::attn_phase((const bf16_t*)(p.ws + WS_QB), MIXIN, lds, blk, G);
    XSYNC();
    hg::scan(p, blk * 512 + tid, G * 512);
    XSYNC();
    for (int lin = blk; lin < hg::NITEM; lin += G) hg::pass2(p, U, MIXIN, lds, hg::item_of(lin, G));
    XSYNC();
    hg_finalize(p, U, MIXIN, blk, G, wave, lane);
    XSYNC();
    {
        pg8::Gemm g{MIXIN, (const bf16_t*)(dob + DO_WOUT), T_, DM, DM}; pg8::StaticOrder S; S.init(T_, DM, G, blk);
        EpiRowSS E{(bf16_t*)(p.ws + WS_MIX), (float*)(p.ws + WS_SS1)};
        pg8::gemm_phase<EpiRowSS, pg8::StaticOrder, true, true>(lds, g, S, E);
    }
    XSYNC();
    p6_rows(p, lds, gw, ngw, wave, lane);
    XSYNC();
    {
        pg8::Gemm g{(const bf16_t*)(p.ws + WS_MIX), (const bf16_t*)(p.ws + WS_WGU), T_, 2 * DFF, DM}; pg8::StaticOrder S; S.init(T_, 2 * DFF, G, blk);
        EpiSwiGLU E{(bf16_t*)(p.ws + WS_HFF)};
        pg8::gemm_phase<EpiSwiGLU, pg8::StaticOrder, true, true>(lds, g, S, E);
    }
    XSYNC();
    {
        pg8::Gemm g{(const bf16_t*)(p.ws + WS_HFF), (const bf16_t*)(p.ws + WS_WDN), T_, DM, DFF}; pg8::StaticOrder S; S.init(T_, DM, G, blk);
        EpiRowSS E{(bf16_t*)(p.ws + WS_MIX), (float*)(p.ws + WS_SS2)};
        pg8::gemm_phase<EpiRowSS, pg8::StaticOrder, true, true>(lds, g, S, E);
    }
    XSYNC();
    p9_rows(p, gw, ngw, lane);
}

extern "C" void kernel_launch(void* const* d_in, const int* in_sizes, int n_in, void* d_out, int out_size, void* d_ws, size_t ws_size, hipStream_t stream) {
    static int grid_blocks = 0;
    if (grid_blocks == 0) {
        int dev = 0, cus = 0, per_cu = 0;
        hipGetDevice(&dev);
        hipDeviceGetAttribute(&cus, hipDeviceAttributeMultiprocessorCount, dev);
        hipFuncSetAttribute((const void*)fwd_megakernel, hipFuncAttributeMaxDynamicSharedMemorySize, LDS_BYTES);
        hipOccupancyMaxActiveBlocksPerMultiprocessor(&per_cu, (const void*)fwd_megakernel, 512, LDS_BYTES);
        if (per_cu < 1) { fprintf(stderr, "occupancy query reports %d blocks per CU\n", per_cu); per_cu = 1; }
        if (per_cu > 1) per_cu = 1;
        grid_blocks = cus * per_cu;
        if (ws_size < 512 * MiB) fprintf(stderr, "kernel_launch: workspace %zu smaller than the 512 MiB map\n", ws_size);
    }
    Params p{};
    p.xp = (const float*)d_in[0]; p.xs = (const float*)d_in[1]; p.w_in = (const float*)d_in[2]; p.w_out = (const float*)d_in[3];
    p.lb_fwd = (const float*)d_in[4]; p.lb_bwd = (const float*)d_in[5]; p.g_hgrn = (const float*)d_in[6]; p.g_pre_mix = (const float*)d_in[7];
    p.g_post_mix = (const float*)d_in[8]; p.g_pre_ffn = (const float*)d_in[9]; p.g_post_ffn = (const float*)d_in[10];
    p.w_gate = (const float*)d_in[11]; p.w_up = (const float*)d_in[12]; p.w_down = (const float*)d_in[13];
    p.out = (float*)d_out; p.ws = (unsigned char*)d_ws;
    void* args[] = {&p};
    hipError_t e = hipLaunchCooperativeKernel((const void*)fwd_megakernel, dim3(grid_blocks), dim3(512), args, LDS_BYTES, stream);
    if (e != hipSuccess) fprintf(stderr, "cooperative launch failed: %s (grid %d)\n", hipGetErrorString(e), grid_blocks);
}
```
